# Optimizing an MI355X kernel written in HIP

```python
import math
import jax, jax.numpy as jnp
from jax import lax
import numpy as np

D_MODEL = 2048
BATCH = 2
SEQ = 4096
DEPTH = 2

CHUNK = 64
N_A = DEPTH // 2
N_B = DEPTH - N_A
N_SUB = 3
D_FF = 3 * D_MODEL
D_RNN = D_MODEL
LRU_BLOCK = 256
LRU_HEADS = D_RNN // LRU_BLOCK
CONV_WIDTH = 4
LRU_C = 8.0
N_HEADS = 8
HEAD_DIM = D_MODEL // (2 * N_HEADS)
V_DIM = 2 * HEAD_DIM
Q_BLOCK = 128
NORM_EPS = 1e-6

kernel_name = "hybrid_rglru_diffattn_yoco_trunk"


def rmsnorm(x, g):
    xf = x.astype(jnp.float32)
    y = xf * lax.rsqrt(jnp.mean(xf * xf, axis=-1, keepdims=True) + NORM_EPS)
    return (y * g.astype(jnp.float32)).astype(x.dtype)


def swiglu(h, w_in, w_out):
    g, u = jnp.split(h @ w_in, 2, axis=-1)
    return (jax.nn.silu(g) * u) @ w_out


def modulated_sublayer(x, fn, g_pre, g_post, mod_j, weight):
    shift = mod_j[:, None, 0]
    scale = mod_j[:, None, 1]
    gate = mod_j[:, None, 2]
    h = rmsnorm(x, g_pre) * (1.0 + scale) + shift
    return x + weight * gate * rmsnorm(fn(h), g_post)


def causal_depthwise_conv(x, w, b):
    S = x.shape[1]
    xp = jnp.pad(x, ((0, 0), (CONV_WIDTH - 1, 0), (0, 0)))
    y = b
    for k in range(CONV_WIDTH):
        y = y + xp[:, k:k + S] * w[k]
    return y


def rglru(x, w_a, b_a, w_x, b_x, lam):
    B, S, C = x.shape
    xb = x.reshape(B, S, LRU_HEADS, LRU_BLOCK)
    r = jax.nn.sigmoid(jnp.einsum('bshi,hij->bshj', xb, w_a).reshape(B, S, C) + b_a)
    i = jax.nn.sigmoid(jnp.einsum('bshi,hij->bshj', xb, w_x).reshape(B, S, C) + b_x)
    log_a = -LRU_C * r.astype(jnp.float32) * jax.nn.softplus(-lam.astype(jnp.float32))
    a = jnp.exp(log_a)
    u = jnp.sqrt(-jnp.expm1(2.0 * log_a)) * (i * x).astype(jnp.float32)

    def combine(left, right):
        a_l, h_l = left
        a_r, h_r = right
        return a_l * a_r, a_r * h_l + h_r

    _, h = lax.associative_scan(combine, (a, u), axis=1)
    return h.astype(x.dtype)


def recurrent_mixer(h, w_in, conv_w, conv_b, w_a, b_a, w_x, b_x, lam, w_out):
    y, xr = jnp.split(h @ w_in, 2, axis=-1)
    xr = causal_depthwise_conv(xr, conv_w, conv_b)
    xr = rglru(xr, w_a, b_a, w_x, b_x, lam)
    return (jax.nn.gelu(y) * xr) @ w_out


def shared_kv(x, c_act, g_kv, w_kv_mod, b_kv_mod, w_kv):
    B, S, _ = x.shape
    shift, scale = jnp.split(c_act @ w_kv_mod + b_kv_mod, 2, axis=-1)
    h = rmsnorm(x, g_kv) * (1.0 + scale[:, None]) + shift[:, None]
    k, v = jnp.split(h @ w_kv, 2, axis=-1)
    return (k.reshape(B, S, N_HEADS, 2, HEAD_DIM), v.reshape(B, S, N_HEADS, V_DIM))


def diff_attention(h, k, v, w_q, lam_qk, g_sub, w_o, lam_init):
    B, S, _ = h.shape
    q = (h @ w_q).reshape(B, S, N_HEADS, 2, HEAD_DIM)
    lq = lam_qk.astype(jnp.float32)
    lam = jnp.exp(jnp.sum(lq[0] * lq[1])) - jnp.exp(jnp.sum(lq[2] * lq[3])) + lam_init
    key_chunk = jnp.arange(S) // CHUNK
    scale = HEAD_DIM ** -0.5
    vf = v.astype(jnp.float32)

    def block(i):
        q0 = i * Q_BLOCK
        qb = lax.dynamic_slice_in_dim(q, q0, Q_BLOCK, axis=1)
        s = jnp.einsum('bqhcd,bkhcd->bhcqk', qb, k).astype(jnp.float32) * scale
        q_chunk = (q0 + jnp.arange(Q_BLOCK)) // CHUNK
        mask = key_chunk[None, :] <= q_chunk[:, None]
        p = jax.nn.softmax(jnp.where(mask, s, -jnp.inf), axis=-1)
        attn = p[:, :, 0] - lam * p[:, :, 1]
        return jnp.einsum('bhqk,bkhe->bqhe', attn, vf)

    o = lax.map(block, jnp.arange(S // Q_BLOCK))
    o = jnp.moveaxis(o, 0, 1).reshape(B, S, N_HEADS, V_DIM)
    o = rmsnorm(o, g_sub) * (1.0 - lam_init)
    return o.reshape(B, S, N_HEADS * V_DIM).astype(h.dtype) @ w_o


def setup_inputs(seed: int = 0) -> dict:
    key = jax.random.key(seed)
    ks = iter(jax.random.split(key, 32))
    f32 = jnp.float32
    D = D_MODEL

    def nrm(shape, std):
        return jax.random.normal(next(ks), shape, f32) * std

    u = jax.random.uniform(next(ks), (N_A, D_RNN), f32, 0.9, 0.999)
    a0 = u ** (1.0 / LRU_C)
    lru_lambda = jnp.log(a0) - jnp.log1p(-a0)
    return {
        'x': nrm((BATCH, SEQ, D), 1.0),
        'c': nrm((BATCH, D), 1.0),
        'w_mod': nrm((DEPTH, D, 3 * N_SUB * D), 0.5 * D ** -0.5),
        'b_mod': nrm((DEPTH, 3 * N_SUB * D), 0.02),
        'norm_gain': 1.0 + nrm((DEPTH, 2 * N_SUB, D), 0.02),
        'w_ffn_in': nrm((DEPTH, 2, D, 2 * D_FF), D ** -0.5),
        'w_ffn_out': nrm((DEPTH, 2, D_FF, D), D_FF ** -0.5),
        'lru_w_in': nrm((N_A, D, 2 * D_RNN), D ** -0.5),
        'lru_conv_w': nrm((N_A, CONV_WIDTH, D_RNN), CONV_WIDTH ** -0.5),
        'lru_conv_b': nrm((N_A, D_RNN), 0.02),
        'lru_w_a': nrm((N_A, LRU_HEADS, LRU_BLOCK, LRU_BLOCK), LRU_BLOCK ** -0.5),
        'lru_b_a': nrm((N_A, D_RNN), 0.02),
        'lru_w_x': nrm((N_A, LRU_HEADS, LRU_BLOCK, LRU_BLOCK), LRU_BLOCK ** -0.5),
        'lru_b_x': nrm((N_A, D_RNN), 0.02),
        'lru_lambda': lru_lambda,
        'lru_w_out': nrm((N_A, D_RNN, D), D_RNN ** -0.5),
        'kv_gain': 1.0 + nrm((D,), 0.02),
        'kv_w_mod': nrm((D, 2 * D), 0.5 * D ** -0.5),
        'kv_b_mod': nrm((2 * D,), 0.02),
        'w_kv': nrm((D, N_HEADS * 2 * HEAD_DIM + N_HEADS * V_DIM), D ** -0.5),
        'attn_w_q': nrm((N_B, D, N_HEADS * 2 * HEAD_DIM), D ** -0.5),
        'attn_lambda_qk': nrm((N_B, 4, HEAD_DIM), 0.1),
        'attn_sub_gain': 1.0 + nrm((N_B, V_DIM), 0.02),
        'attn_w_o': nrm((N_B, N_HEADS * V_DIM, D), (N_HEADS * V_DIM) ** -0.5),
    }


def reference(x, c, w_mod, b_mod, norm_gain, w_ffn_in, w_ffn_out,
              lru_w_in, lru_conv_w, lru_conv_b, lru_w_a, lru_b_a, lru_w_x, lru_b_x,
              lru_lambda, lru_w_out, kv_gain, kv_w_mod, kv_b_mod, w_kv,
              attn_w_q, attn_lambda_qk, attn_sub_gain, attn_w_o):
    B = x.shape[0]
    c_act = jax.nn.silu(c)
    k = None
    v = None
    for l in range(DEPTH):
        if l == N_A:
            k, v = shared_kv(x, c_act, kv_gain, kv_w_mod, kv_b_mod, w_kv)
        mod = (c_act @ w_mod[l] + b_mod[l]).reshape(B, N_SUB, 3, D_MODEL)
        g = norm_gain[l]
        x = modulated_sublayer(x, lambda h: swiglu(h, w_ffn_in[l, 0], w_ffn_out[l, 0]),
                               g[0], g[1], mod[:, 0], 0.5)
        if l < N_A:
            j = l
            mixer = lambda h: recurrent_mixer(h, lru_w_in[j], lru_conv_w[j], lru_conv_b[j],
                                              lru_w_a[j], lru_b_a[j], lru_w_x[j], lru_b_x[j],
                                              lru_lambda[j], lru_w_out[j])
        else:
            j = l - N_A
            lam_init = 0.8 - 0.6 * math.exp(-0.3 * l)
            mixer = lambda h: diff_attention(h, k, v, attn_w_q[j], attn_lambda_qk[j],
                                             attn_sub_gain[j], attn_w_o[j], lam_init)
        x = modulated_sublayer(x, mixer, g[2], g[3], mod[:, 1], 1.0)
        x = modulated_sublayer(x, lambda h: swiglu(h, w_ffn_in[l, 1], w_ffn_out[l, 1]),
                               g[4], g[5], mod[:, 2], 0.5)
    return x
```

```cpp
#include <hip/hip_runtime.h>
#include <hip/hip_bf16.h>
#include <cstdio>
#include <cstdint>
#define MK_PER_PHASE 0
constexpr int NWAVES = 8;
constexpr int NPH = 21;
#ifndef MK_PER_PHASE
#define MK_PER_PHASE 0
#endif
#ifndef MK_STOP_AFTER
#define MK_STOP_AFTER (NPH - 1)
#endif

constexpr int BATCH = 2, SEQ = 4096, DM = 2048, M = BATCH * SEQ, DFF = 6144, NMOD = 18432, NMODT = 2 * NMOD + 4096;
constexpr int NH = 8, VD = 256, LRUB = 256;
constexpr float NORM_EPS = 1e-6f;
constexpr float LAM_INIT = 0.35550906759096315f;

constexpr size_t MiB = 1u << 20;
constexpr size_t WS_CTL = 0, CTL_ZERO_BYTES = 1 * MiB;
constexpr size_t WS_MODP = 2 * MiB, WS_MOD = 8 * MiB, WS_AGP = 9 * MiB, WS_AGH = 11 * MiB, WS_SAGP = 13 * MiB, WS_SAGH = 14 * MiB, WS_GC = 15 * MiB;
constexpr size_t WS_WG = 16 * MiB, WS_WLIN = 18 * MiB, WS_WLOUT = 34 * MiB, WS_WKV = 42 * MiB, WS_WQ = 58 * MiB, WS_WO = 66 * MiB;
constexpr size_t WS_WFIN = 74 * MiB, WS_WFOUT = 266 * MiB;
constexpr size_t WS_XS = 362 * MiB, WS_Y = 426 * MiB, WS_H = 490 * MiB, WS_HKV = 522 * MiB, WS_ACT = 554 * MiB;
constexpr size_t WS_YG = 650 * MiB, WS_XR = 682 * MiB, WS_XRC = 714 * MiB, WS_A = 746 * MiB, WS_U = 810 * MiB, WS_HG = 874 * MiB;
constexpr size_t WS_Q = 906 * MiB, WS_K = 938 * MiB, WS_V = 970 * MiB, WS_OC = 1002 * MiB, WS_ON = 1066 * MiB, WS_XSLOT = 1098 * MiB, WS_END = 1102 * MiB;
constexpr int CW_BAR = 4096, CW_XCNT = 16384;

constexpr int RING_OFF = 0, RING_BYTES = 131072;
constexpr int LDSCTL_OFF = RING_BYTES, MISC_OFF = LDSCTL_OFF + 320;
constexpr int LDS_BYTES = 147456;

#define GAS __attribute__((address_space(1)))
#define LAS __attribute__((address_space(3)))
typedef unsigned short bf16;
typedef unsigned v4u __attribute__((ext_vector_type(4)));
typedef unsigned v2u __attribute__((ext_vector_type(2)));
typedef float f32x4 __attribute__((ext_vector_type(4)));
#define LDS_WAIT() asm volatile("s_waitcnt lgkmcnt(0)" ::: "memory")
#define VM_WAIT() asm volatile("s_waitcnt vmcnt(0)" ::: "memory")
__device__ __forceinline__ unsigned f2bf(float f) { unsigned u = __builtin_bit_cast(unsigned, f); return (u + 0x7fffu + ((u >> 16) & 1u)) >> 16; }
__device__ __forceinline__ unsigned pk2(float lo, float hi) { return f2bf(lo) | (f2bf(hi) << 16); }
__device__ __forceinline__ float bflo(unsigned w) { return __uint_as_float(w << 16); }
__device__ __forceinline__ float bfhi(unsigned w) { return __uint_as_float(w & 0xffff0000u); }
__device__ __forceinline__ float wave_sum(float v) {
#pragma unroll
    for (int o = 1; o < 64; o <<= 1) v += __shfl_xor(v, o);
    return v;
}
__device__ __forceinline__ float silu_f(float v) { return v / (1.0f + __expf(-v)); }
#define XB_TMO      128
#define XB_XCNT(j)  (256  + 64 * (j))
#define XB_XSUB(j)  (1280 + 64 * (j))
#define XB_XGEN(j)  (2304 + 64 * (j))
#define XB_TOP      3328
#define XB_TOPGEN   3392
#define XCD_BAR_WORDS 3456
#define XB_SPIN_CAP (1u << 18)

__device__ __forceinline__ unsigned xb_ld(unsigned* p)              { return __hip_atomic_load(p, __ATOMIC_RELAXED, __HIP_MEMORY_SCOPE_AGENT); }
__device__ __forceinline__ unsigned xb_add(unsigned* p, unsigned v) { return __hip_atomic_fetch_add(p, v, __ATOMIC_RELAXED, __HIP_MEMORY_SCOPE_AGENT); }
__device__ __forceinline__ unsigned xb_xcc_id() { return (unsigned)__builtin_amdgcn_s_getreg((3 << 11) | 20) & 0xFu; }
#define XB_SPIN(cond, bar) do { unsigned _sp = 0; while (cond) { __builtin_amdgcn_s_sleep(1); \
    if ((++_sp & 255u) == 0u) { if (xb_ld(&(bar)[XB_TMO])) break; if (_sp > XB_SPIN_CAP) { atomicAdd(&(bar)[XB_TMO], 1u); break; } } } } while (0)

struct XcdBarrier {
    unsigned* bar; unsigned x;
    volatile LAS unsigned* st;
};

__device__ __forceinline__ XcdBarrier xcd_barrier_post(unsigned* bar, volatile LAS unsigned* st) {
    XcdBarrier b; b.bar = bar; b.x = xb_xcc_id(); b.st = st;
    if (threadIdx.x == 0) (void)xb_add(&bar[XB_XCNT(b.x)], 1u);
    return b;
}
__device__ __forceinline__ void xcd_barrier_complete(unsigned* bar, unsigned x, unsigned& nloc, unsigned& nx) {
    const unsigned G = gridDim.x * gridDim.y * gridDim.z;
    unsigned sum, cnt, mine, sp = 0u;
    for (;;) {
        sum = 0u; cnt = 0u; mine = 0u;
#pragma unroll
        for (unsigned j = 0; j < 16; ++j) { const unsigned c = xb_ld(&bar[XB_XCNT(j)]); sum += c; cnt += (c > 0u) ? 1u : 0u; mine = (j == x) ? c : mine; }
        if (sum == G) break;
        __builtin_amdgcn_s_sleep(1);
        if ((++sp & 255u) == 0u) { if (xb_ld(&bar[XB_TMO])) break; if (sp > XB_SPIN_CAP) { atomicAdd(&bar[XB_TMO], 1u); break; } }
    }
    nloc = mine > 0u ? mine : 1u; nx = cnt > 0u ? cnt : 1u;
}

__device__ __forceinline__ void xcd_barrier(const XcdBarrier& b) {
    asm volatile("s_waitcnt vmcnt(0)" ::: "memory");
    __syncthreads();
    if (threadIdx.x == 0) {
        unsigned* bar = b.bar;
        __builtin_amdgcn_s_waitcnt(0);
        unsigned nloc = b.st[0], nx = b.st[1];
        if (nloc == 0u) { xcd_barrier_complete(bar, b.x, nloc, nx); b.st[0] = nloc; b.st[1] = nx; }
        const unsigned old = xb_add(&bar[XB_XSUB(b.x)], 1u);
        const unsigned gen = old / nloc;
        if (old + 1u == (gen + 1u) * nloc) {
            __builtin_amdgcn_fence(__ATOMIC_RELEASE, "agent");
            asm volatile("s_waitcnt vmcnt(0)" ::: "memory");
            const unsigned og = xb_add(&bar[XB_TOP], 1u);
            const unsigned tg = og / nx;
            if (og + 1u == (tg + 1u) * nx) xb_add(&bar[XB_TOPGEN], 1u);
            else XB_SPIN(xb_ld(&bar[XB_TOPGEN]) == tg, bar);
            __builtin_amdgcn_fence(__ATOMIC_ACQUIRE, "agent");
            xb_add(&bar[XB_XGEN(b.x)], 1u);
            asm volatile("s_waitcnt vmcnt(0)" ::: "memory");
        } else {
            XB_SPIN(xb_ld(&bar[XB_XGEN(b.x)]) == gen, bar);
            __builtin_amdgcn_fence(__ATOMIC_ACQUIRE, "agent");
            asm volatile("s_waitcnt vmcnt(0)" ::: "memory");
        }
    }
    __syncthreads();
}
namespace pg8 {
#define PG8_LAS __attribute__((address_space(3)))
typedef unsigned short bf16_t;
typedef short bf16x8 __attribute__((ext_vector_type(8)));
typedef float f32x4 __attribute__((ext_vector_type(4)));
typedef float f32x2 __attribute__((ext_vector_type(2)));
typedef unsigned u32x4 __attribute__((ext_vector_type(4)));
constexpr int BM = 256, BK = 64, HALF = 128, HTB = HALF * BK * 2  , STAGE_BYTES = 8 * HTB, NXCD = 8, WGM = 8;

__host__ __device__ __forceinline__ int lds_byte(int r, int c) { const int st = (r >> 4) * 2 + (c >> 5), rr = r & 15, cc = c & 31, ob = rr * 64 + cc * 2; return st * 1024 + (ob ^ (((ob >> 9) & 1) << 5)); }
__host__ __device__ __forceinline__ void stage_rc(int b, int& R, int& C) { const int st = b / 1024, sb = b % 1024, swz = sb ^ (((sb >> 9) & 1) << 5); R = (st >> 1) * 16 + swz / 64; C = (st & 1) * 32 + (swz % 64) / 2; }
__host__ __device__ __forceinline__ int perm32(int rho) { const int n = rho >> 4, i = rho & 15; return 8 * (i >> 2) + 4 * n + (i & 3); }

struct Unit { int pm, pn; };
struct Gemm { const bf16_t* A; const bf16_t* Bt; int M, N, K, lda, agrp; };

struct StaticOrder {
    int nM, nN, nwg, G, c;
    __host__ __device__ __forceinline__ void init(int M, int N, int G_, int c_) { nM = M / BM; nN = N / BM; nwg = nM * nN; G = G_; c = c_; }
    __host__ __device__ __forceinline__ bool next(int i, Unit& u) const {
        const long L = (long)i * G + c; if (L >= nwg) return false;
        int wgid = (int)L; { const int q = nwg / NXCD, r = nwg % NXCD, xcd = wgid % NXCD, off = wgid / NXCD; wgid = (xcd < r ? xcd * (q + 1) : r * (q + 1) + (xcd - r) * q) + off; }
        const int nig = WGM * nN, gid = wgid / nig, fm = gid * WGM, gsz = (nM - fm) < WGM ? (nM - fm) : WGM;
        u.pm = fm + ((wgid % nig) % gsz); u.pn = (wgid % nig) / gsz; return true;
    }
    __device__ __forceinline__ void a_ready(const Unit&) const {}
    __device__ __forceinline__ void done(const Unit&) const {}
};

__device__ __forceinline__ unsigned cvt_pk_bf16(float lo, float hi) { unsigned r; asm volatile("v_cvt_pk_bf16_f32 %0, %1, %2" : "=v"(r) : "v"(lo), "v"(hi)); return r; }
__device__ __forceinline__ float bf_lo(unsigned w) { return __uint_as_float(w << 16); }
__device__ __forceinline__ float bf_hi(unsigned w) { return __uint_as_float(w & 0xffff0000u); }
__device__ __forceinline__ float sigmoidf_(float v) { return __builtin_amdgcn_rcpf(1.0f + __builtin_amdgcn_exp2f(-1.4426950408889634f * v)); }
__device__ __forceinline__ float siluf_(float v) { return v * sigmoidf_(v); }
__device__ __forceinline__ float gelu_tanh_(float v) { const float t = 1.5957691216057308f * (v + 0.044715f * v * v * v); return v * sigmoidf_(t); }

struct EpiF32 {
    static constexpr bool PERM = false, AFTER_DRAIN = false;
    float* C; int ldc;
    __device__ __forceinline__ void operator()(const f32x4 (&acc)[2][2][4][2], const Unit& u, int wr, int wc, int fr, int fq) const {
        const int row0 = u.pm * BM + wr * 64 + fr, col0 = u.pn * BM + wc * 32 + 4 * fq;
#pragma unroll
        for (int ai = 0; ai < 2; ++ai)
#pragma unroll
            for (int m = 0; m < 4; ++m) { float* rowp = C + (size_t)(row0 + ai * HALF + m * 16) * ldc + col0;
#pragma unroll
                for (int bj = 0; bj < 2; ++bj)
#pragma unroll
                    for (int n = 0; n < 2; ++n) *(f32x4*)(rowp + bj * HALF + n * 16) = acc[ai][bj][m][n]; }
    }
};
struct EpiBf16 {
    static constexpr bool PERM = true, AFTER_DRAIN = false;
    bf16_t* O; int ldc; int split_cols; size_t split_stride;
    __device__ __forceinline__ void operator()(const f32x4 (&acc)[2][2][4][2], const Unit& u, int wr, int wc, int fr, int fq) const {
        const int row0 = u.pm * BM + wr * 64 + fr; int colt = u.pn * BM; bf16_t* base = O;
        if (split_cols) { const int t = colt / split_cols; base += (size_t)t * split_stride; colt -= t * split_cols; }
        const int col0 = colt + wc * 32 + 8 * fq;
#pragma unroll
        for (int ai = 0; ai < 2; ++ai)
#pragma unroll
            for (int m = 0; m < 4; ++m) { bf16_t* rowp = base + (size_t)(row0 + ai * HALF + m * 16) * ldc + col0;
#pragma unroll
                for (int bj = 0; bj < 2; ++bj) { const f32x4 v0 = acc[ai][bj][m][0], v1 = acc[ai][bj][m][1];
                    u32x4 w; w.x = cvt_pk_bf16(v0[0], v0[1]); w.y = cvt_pk_bf16(v0[2], v0[3]); w.z = cvt_pk_bf16(v1[0], v1[1]); w.w = cvt_pk_bf16(v1[2], v1[3]);
                    *(u32x4*)(rowp + bj * HALF) = w; } }
    }
};
struct EpiSwiglu {
    static constexpr bool PERM = true, AFTER_DRAIN = false;
    bf16_t* O; int ldc;
    __device__ __forceinline__ void operator()(const f32x4 (&acc)[2][2][4][2], const Unit& u, int wr, int wc, int fr, int fq) const {
        const int row0 = u.pm * BM + wr * 64 + fr, col0 = u.pn * HALF + wc * 32 + 8 * fq;
#pragma unroll
        for (int ai = 0; ai < 2; ++ai)
#pragma unroll
            for (int m = 0; m < 4; ++m) { bf16_t* rowp = O + (size_t)(row0 + ai * HALF + m * 16) * ldc + col0;
                float o[8];
#pragma unroll
                for (int n = 0; n < 2; ++n)
#pragma unroll
                    for (int i = 0; i < 4; ++i) o[4 * n + i] = siluf_(acc[ai][0][m][n][i]) * acc[ai][1][m][n][i];
                u32x4 w; w.x = cvt_pk_bf16(o[0], o[1]); w.y = cvt_pk_bf16(o[2], o[3]); w.z = cvt_pk_bf16(o[4], o[5]); w.w = cvt_pk_bf16(o[6], o[7]);
                *(u32x4*)rowp = w; }
    }
};
struct EpiLruIn {
    static constexpr bool PERM = true, AFTER_DRAIN = false;
    bf16_t* O0; bf16_t* O1; int ldc; int nsplit;
    __device__ __forceinline__ void operator()(const f32x4 (&acc)[2][2][4][2], const Unit& u, int wr, int wc, int fr, int fq) const {
        const bool act = u.pn < nsplit; bf16_t* base = act ? O0 : O1;
        const int row0 = u.pm * BM + wr * 64 + fr, col0 = (act ? u.pn : u.pn - nsplit) * BM + wc * 32 + 8 * fq;
#pragma unroll
        for (int ai = 0; ai < 2; ++ai)
#pragma unroll
            for (int m = 0; m < 4; ++m) { bf16_t* rowp = base + (size_t)(row0 + ai * HALF + m * 16) * ldc + col0;
#pragma unroll
                for (int bj = 0; bj < 2; ++bj) { f32x4 v0 = acc[ai][bj][m][0], v1 = acc[ai][bj][m][1];
                    if (act) {
#pragma unroll
                        for (int i = 0; i < 4; ++i) { v0[i] = gelu_tanh_(v0[i]); v1[i] = gelu_tanh_(v1[i]); } }
                    u32x4 w; w.x = cvt_pk_bf16(v0[0], v0[1]); w.y = cvt_pk_bf16(v0[2], v0[3]); w.z = cvt_pk_bf16(v1[0], v1[1]); w.w = cvt_pk_bf16(v1[2], v1[3]);
                    *(u32x4*)(rowp + bj * HALF) = w; } }
    }
};
__device__ __forceinline__ float neg_expm1_(float z) {
    const float s = -z * (1.0f + z * (0.5f + z * (0.16666667f + z * (0.041666668f + z * (0.008333334f + z * 0.0013888889f)))));
    const float d = 1.0f - __builtin_amdgcn_exp2f(1.4426950408889634f * z);
    return z > -0.5f ? s : d;
}
struct EpiGates {
    static constexpr bool PERM = true, AFTER_DRAIN = false;
    const bf16_t* X; unsigned* AU; int ldc; const float* gc;
    __device__ __forceinline__ void operator()(const f32x4 (&acc)[2][2][4][2], const Unit& u, int wr, int wc, int fr, int fq) const {
        const int row0 = u.pm * BM + wr * 64 + fr, grp0 = (u.pn >> 1) * BM + (u.pn & 1) * HALF + wc * 32, ch0 = grp0 + 8 * fq;
        f32x4 ba[2], bx[2], sp8[2];
#pragma unroll
        for (int n = 0; n < 2; ++n) { ba[n] = *(const f32x4*)(gc + ch0 + 4 * n); bx[n] = *(const f32x4*)(gc + ldc + ch0 + 4 * n); sp8[n] = *(const f32x4*)(gc + 2 * ldc + ch0 + 4 * n); }
#pragma unroll
        for (int ai = 0; ai < 2; ++ai)
#pragma unroll
            for (int m = 0; m < 4; ++m) { const size_t rowoff = (size_t)(row0 + ai * HALF + m * 16) * ldc;
                const u32x4 xw = *(const u32x4*)(X + rowoff + ch0);
#pragma unroll
                for (int n = 0; n < 2; ++n) {
                    const unsigned w0 = n ? xw.z : xw.x, w1 = n ? xw.w : xw.y;
                    const f32x4 xv = {bf_lo(w0), bf_hi(w0), bf_lo(w1), bf_hi(w1)};
                    u32x4 pw;
#pragma unroll
                    for (int e = 0; e < 4; ++e) { const float r = sigmoidf_(acc[ai][0][m][n][e] + ba[n][e]), ig = sigmoidf_(acc[ai][1][m][n][e] + bx[n][e]), la = -sp8[n][e] * r;
                        pw[e] = cvt_pk_bf16(1.4426950408889634f * la, __builtin_sqrtf(neg_expm1_(2.0f * la)) * (ig * xv[e])); }
                    *(u32x4*)(AU + rowoff + grp0 + 16 * n + 4 * fq) = pw; }
                asm volatile("" ::: "memory"); }
    }
};
struct RowStats {
    float* slots; XcdBarrier bar;
    __device__ __forceinline__ void run(const f32x4 (&v)[2][2][4][2], const Unit& u, int wr, int wc, int fr, int fq, PG8_LAS unsigned char* lds, int wid, int lane) const {
        PG8_LAS float* P = (PG8_LAS float*)lds;
        PG8_LAS float* S = (PG8_LAS float*)(lds + 4096);
#pragma unroll
        for (int ai = 0; ai < 2; ++ai)
#pragma unroll
            for (int m = 0; m < 4; ++m) {
                float s = 0.f;
#pragma unroll
                for (int bj = 0; bj < 2; ++bj)
#pragma unroll
                    for (int n = 0; n < 2; ++n) { const f32x4 x = v[ai][bj][m][n]; s += (x[0] * x[0] + x[1] * x[1]) + (x[2] * x[2] + x[3] * x[3]); }
                s += __shfl_xor(s, 16); s += __shfl_xor(s, 32);
                if (fq == 0) P[(ai * HALF + wr * 64 + m * 16 + fr) * 4 + wc] = s;
            }
        asm volatile("s_waitcnt lgkmcnt(0)" ::: "memory"); __builtin_amdgcn_s_barrier(); asm volatile("" ::: "memory");
        const int row = wid * 32 + (lane & 31);
        if (lane < 32) slots[(size_t)(u.pm * BM + row) * 8 + u.pn] = (P[row * 4 + 0] + P[row * 4 + 1]) + (P[row * 4 + 2] + P[row * 4 + 3]);
        xcd_barrier(bar);
        if (lane < 32) {
            const f32x4 s0 = *(const f32x4*)(slots + (size_t)(u.pm * BM + row) * 8), s1 = *(const f32x4*)(slots + (size_t)(u.pm * BM + row) * 8 + 4);
            const float tot = ((s0[0] + s0[1]) + (s0[2] + s0[3])) + ((s1[0] + s1[1]) + (s1[2] + s1[3]));
            S[row] = 1.0f / __builtin_sqrtf(tot * (1.0f / 2048.0f) + 1e-6f);
        }
        asm volatile("s_waitcnt vmcnt(0) lgkmcnt(0)" ::: "memory"); __builtin_amdgcn_s_barrier(); asm volatile("" ::: "memory");
    }
};
typedef unsigned u32x2v __attribute__((ext_vector_type(2)));
__device__ __forceinline__ void store_h8(bf16_t* p  , const u32x2v (&w)[2], int fq) {
    const bool odd = (fq & 1) != 0;
    const u32x2v snd = odd ? w[0] : w[1]; u32x2v rcv; rcv.x = (unsigned)__shfl_xor((int)snd.x, 16); rcv.y = (unsigned)__shfl_xor((int)snd.y, 16);
    u32x4 o; if (odd) { o.x = rcv.x; o.y = rcv.y; o.z = w[1].x; o.w = w[1].y; } else { o.x = w[0].x; o.y = w[0].y; o.z = rcv.x; o.w = rcv.y; }
    *(u32x4*)(p + (odd ? 12 : 0)) = o;
}
struct EpiNorm {
    static constexpr bool PERM = false, AFTER_DRAIN = true;
    const float* xin; float* xout; bf16_t* h1; bf16_t* h2; float wgt;
    const float *gpost, *gate, *gpre1, *scale1, *shift1, *gpre2, *scale2, *shift2;
    RowStats st1, st2;
    __device__ __forceinline__ void fused(f32x4 (&acc)[2][2][4][2], const Unit& u, int wr, int wc, int fr, int fq, PG8_LAS unsigned char* lds, int wid, int lane) const {
        const PG8_LAS float* S = (const PG8_LAS float*)(lds + 4096);
        const int col0 = u.pn * BM + wc * 32 + 4 * fq;
        f32x4 pre[4][2][2];
#pragma unroll
        for (int m = 0; m < 4; ++m) { const size_t off = (size_t)(u.pm * BM + wr * 64 + m * 16 + fr) * 2048 + col0;
#pragma unroll
            for (int bj = 0; bj < 2; ++bj)
#pragma unroll
                for (int n = 0; n < 2; ++n) pre[m][bj][n] = *(const f32x4*)(xin + off + bj * HALF + n * 16); }
        st1.run(acc, u, wr, wc, fr, fq, lds, wid, lane);
        {
            f32x4 ca[2][2];
#pragma unroll
            for (int bj = 0; bj < 2; ++bj)
#pragma unroll
                for (int n = 0; n < 2; ++n) ca[bj][n] = *(const f32x4*)(gate + col0 + bj * HALF + n * 16) * *(const f32x4*)(gpost + col0 + bj * HALF + n * 16) * wgt;
#pragma unroll
            for (int ai = 0; ai < 2; ++ai)
#pragma unroll
                for (int m = 0; m < 4; ++m) { const int r = ai * HALF + wr * 64 + m * 16 + fr; const float rs = S[r]; const size_t off = (size_t)(u.pm * BM + r) * 2048 + col0;
#pragma unroll
                    for (int bj = 0; bj < 2; ++bj)
#pragma unroll
                        for (int n = 0; n < 2; ++n) { const f32x4 bs = ai == 0 ? pre[m][bj][n] : *(const f32x4*)(xin + off + bj * HALF + n * 16); acc[ai][bj][m][n] = bs + ca[bj][n] * (acc[ai][bj][m][n] * rs); }
                    asm volatile("" : "+v"(acc[ai][0][m][0]), "+v"(acc[ai][0][m][1]), "+v"(acc[ai][1][m][0]), "+v"(acc[ai][1][m][1]));
                    if (m & 1) asm volatile("" ::: "memory"); }
        }
        if (h1 == nullptr && h2 == nullptr) {
#pragma unroll
            for (int ai = 0; ai < 2; ++ai)
#pragma unroll
                for (int m = 0; m < 4; ++m) { const int r = ai * HALF + wr * 64 + m * 16 + fr; const size_t off = (size_t)(u.pm * BM + r) * 2048 + col0;
#pragma unroll
                    for (int bj = 0; bj < 2; ++bj)
#pragma unroll
                        for (int n = 0; n < 2; ++n) *(f32x4*)(xout + off + bj * HALF + n * 16) = acc[ai][bj][m][n]; }
            return;
        }
        st2.run(acc, u, wr, wc, fr, fq, lds, wid, lane);
        {
            f32x4 cb[2][2], cc[2][2];
#pragma unroll
            for (int bj = 0; bj < 2; ++bj)
#pragma unroll
                for (int n = 0; n < 2; ++n) { cb[bj][n] = *(const f32x4*)(gpre1 + col0 + bj * HALF + n * 16) * (*(const f32x4*)(scale1 + col0 + bj * HALF + n * 16) + 1.0f); cc[bj][n] = *(const f32x4*)(shift1 + col0 + bj * HALF + n * 16); }
#pragma unroll
            for (int ai = 0; ai < 2; ++ai)
#pragma unroll
                for (int m = 0; m < 4; ++m) { const int r = ai * HALF + wr * 64 + m * 16 + fr; const float rs = S[r]; const size_t off = (size_t)(u.pm * BM + r) * 2048 + col0;
#pragma unroll
                    for (int bj = 0; bj < 2; ++bj) { u32x2v w[2];
#pragma unroll
                        for (int n = 0; n < 2; ++n) { const f32x4 x1 = acc[ai][bj][m][n]; *(f32x4*)(xout + off + bj * HALF + n * 16) = x1;
                            const f32x4 o = (x1 * rs) * cb[bj][n] + cc[bj][n]; w[n].x = cvt_pk_bf16(o[0], o[1]); w[n].y = cvt_pk_bf16(o[2], o[3]); }
                        store_h8(h1 + off + bj * HALF, w, fq); }
                    asm volatile("" ::: "memory"); }
        }
        if (h2 != nullptr) {
            f32x4 cb[2][2], cc[2][2];
#pragma unroll
            for (int bj = 0; bj < 2; ++bj)
#pragma unroll
                for (int n = 0; n < 2; ++n) { cb[bj][n] = *(const f32x4*)(gpre2 + col0 + bj * HALF + n * 16) * (*(const f32x4*)(scale2 + col0 + bj * HALF + n * 16) + 1.0f); cc[bj][n] = *(const f32x4*)(shift2 + col0 + bj * HALF + n * 16); }
#pragma unroll
            for (int ai = 0; ai < 2; ++ai)
#pragma unroll
                for (int m = 0; m < 4; ++m) { const int r = ai * HALF + wr * 64 + m * 16 + fr; const float rs = S[r]; const size_t off = (size_t)(u.pm * BM + r) * 2048 + col0;
#pragma unroll
                    for (int bj = 0; bj < 2; ++bj) { u32x2v w[2];
#pragma unroll
                        for (int n = 0; n < 2; ++n) { const f32x4 o = (acc[ai][bj][m][n] * rs) * cb[bj][n] + cc[bj][n]; w[n].x = cvt_pk_bf16(o[0], o[1]); w[n].y = cvt_pk_bf16(o[2], o[3]); }
                        store_h8(h2 + off + bj * HALF, w, fq); }
                    asm volatile("" ::: "memory"); }
        }
    }
};
template <class Epi, class Sched, bool ALIGN_EPI, bool SP2 = true>
__device__ __forceinline__ void gemm_phase(PG8_LAS unsigned char* lds, const Gemm g, const Sched& S, const Epi& E) {
    int tid = threadIdx.x; asm volatile("" : "+v"(tid)); const int wid = __builtin_amdgcn_readfirstlane(tid >> 6), lane = tid & 63, wr = wid >> 2, wc = wid & 3, fr = lane & 15, fq = lane >> 4;
    const int K = g.K, nt = K / BK, lda = g.lda;
    unsigned voffA[2], voffB[2];
#pragma unroll
    for (int i = 0; i < 2; ++i) { int R, C; stage_rc(tid * 16 + i * 8192, R, C); const int Rb = Epi::PERM ? ((R & ~31) + perm32(R & 31)) : R;
        voffA[i] = (unsigned)(R * lda + C) * 2u; voffB[i] = (unsigned)(Rb * BK + C) * 2u; }
    const size_t kstep = (size_t)(BK * 2), kstepB = (size_t)BM * BK * 2;
    const size_t hstepA = (size_t)HALF * lda * 2, hstepB = (size_t)HALF * BK * 2;
    const size_t tstepA = 2 * hstepA, tstepB = (size_t)BM * K * 2;
    const unsigned ldsw = (unsigned)wid * 1024u;
    const int aoff = lds_byte(wr * 64 + fr, fq * 8), boff = lds_byte(wc * 32 + fr, fq * 8);
#define PG8_SA(b, h) (((b) * 2 + (h)) * HTB)
#define PG8_SB(b, h) ((4 + (b) * 2 + (h)) * HTB)
#define PG8_STAGE(bufoff, gbase, voff) do { _Pragma("unroll") for (int _i = 0; _i < 2; ++_i) \
        __builtin_amdgcn_global_load_lds((const unsigned*)((const char*)(gbase) + (voff)[_i]), (PG8_LAS unsigned*)(lds + (bufoff) + ldsw + _i * 8192), 16, 0, 0); } while (0)
#define PG8_LDA(dst, b, h) do { _Pragma("unroll") for (int m = 0; m < 4; ++m) _Pragma("unroll") for (int k = 0; k < 2; ++k) dst[m][k] = *(const PG8_LAS bf16x8*)(lds + PG8_SA(b, h) + aoff + m * 2048 + k * 1024); } while (0)
#define PG8_LDB(dst, b, h) do { _Pragma("unroll") for (int n = 0; n < 2; ++n) _Pragma("unroll") for (int k = 0; k < 2; ++k) dst[n][k] = *(const PG8_LAS bf16x8*)(lds + PG8_SB(b, h) + boff + n * 2048 + k * 1024); } while (0)
#define PG8_MMA(ai, bj, At, Bt) do { __builtin_amdgcn_s_setprio(1); _Pragma("unroll") for (int m = 0; m < 4; ++m) _Pragma("unroll") for (int n = 0; n < 2; ++n) _Pragma("unroll") for (int k = 0; k < 2; ++k) \
        acc[ai][bj][m][n] = __builtin_amdgcn_mfma_f32_16x16x32_bf16(Bt[n][k], At[m][k], acc[ai][bj][m][n], 0, 0, 0); __builtin_amdgcn_s_setprio(0); } while (0)
#define PG8_WAIT_V(n) asm volatile("s_waitcnt vmcnt(" #n ")" ::: "memory")
#define PG8_WAIT_L(n) asm volatile("s_waitcnt lgkmcnt(" #n ")" ::: "memory")
#define PG8_BAR __builtin_amdgcn_s_barrier()
#define PG8_SCHED __builtin_amdgcn_sched_barrier(0)
#define PG8_APTR(u_) ((const char*)g.A + (size_t)(u_).pm * tstepA + (size_t)(((u_).pn >> 1) * g.agrp) * 2)
#define PG8_BPTR(u_) ((const char*)g.Bt + (size_t)(u_).pn * tstepB)
    Unit cur, nxt; int ui = 0;
    if (!S.next(0, cur)) return;
    f32x4 acc[2][2][4][2];
#pragma unroll
    for (int a = 0; a < 2; ++a)
#pragma unroll
        for (int b = 0; b < 2; ++b)
#pragma unroll
            for (int m = 0; m < 4; ++m)
#pragma unroll
                for (int n = 0; n < 2; ++n) acc[a][b][m][n] = (f32x4){0.f, 0.f, 0.f, 0.f};
    bf16x8 At[4][2], B0[2][2], B1[2][2];
    const char* cA = PG8_APTR(cur); const char* cB = PG8_BPTR(cur);
    S.a_ready(cur);
    if constexpr (SP2) {
    PG8_STAGE(PG8_SB(0, 0), cB, voffB); PG8_STAGE(PG8_SB(0, 1), cB + hstepB, voffB); PG8_STAGE(PG8_SA(0, 0), cA, voffA); PG8_STAGE(PG8_SA(0, 1), cA + hstepA, voffA);
    if (wr == 1) PG8_BAR;
    PG8_WAIT_V(2); PG8_BAR;
    } else {
    PG8_STAGE(PG8_SB(0, 0), cB, voffB); PG8_STAGE(PG8_SA(0, 0), cA, voffA); PG8_STAGE(PG8_SB(0, 1), cB + hstepB, voffB); PG8_STAGE(PG8_SA(0, 1), cA + hstepA, voffA);
    if (wr == 1) PG8_BAR;
    PG8_WAIT_V(4); PG8_BAR;
    }
    PG8_STAGE(PG8_SB(1, 0), cB + kstepB, voffB); PG8_STAGE(PG8_SA(1, 0), cA + kstep, voffA); PG8_STAGE(PG8_SB(1, 1), cB + hstepB + kstepB, voffB);
    PG8_WAIT_V(6); PG8_BAR;
    for (;;) {
        const bool has_next = S.next(ui + 1, nxt);
        const char* nA = has_next ? PG8_APTR(nxt) : cA; const char* nB = has_next ? PG8_BPTR(nxt) : cB;
        for (int t = 0; t < nt; t += 2) {
            const bool last = (t == nt - 2);
            const char* a1 = cA + (size_t)(t + 1) * kstep;
            const char* a2 = last ? nA : cA + (size_t)(t + 2) * kstep; const char* b2 = last ? nB : cB + (size_t)(t + 2) * kstepB;
            const char* a3 = a2 + kstep; const char* b3 = b2 + kstepB;
            if (last && has_next) S.a_ready(nxt);
            if constexpr (SP2) {
            PG8_LDB(B0, 0, 0); PG8_LDB(B1, 0, 1); PG8_SCHED; PG8_LDA(At, 0, 0); PG8_STAGE(PG8_SA(1, 1), a1 + hstepA, voffA);
            PG8_WAIT_V(8); PG8_WAIT_L(0); PG8_BAR; PG8_MMA(0, 0, At, B0); PG8_MMA(0, 1, At, B1); PG8_BAR; PG8_SCHED;
            PG8_LDA(At, 0, 1); PG8_STAGE(PG8_SB(0, 0), b2, voffB); PG8_STAGE(PG8_SB(0, 1), b2 + hstepB, voffB); PG8_STAGE(PG8_SA(0, 0), a2, voffA);
            PG8_WAIT_V(8); PG8_WAIT_L(0); PG8_BAR; PG8_MMA(1, 0, At, B0); PG8_MMA(1, 1, At, B1); PG8_BAR; PG8_SCHED;
            PG8_LDB(B0, 1, 0); PG8_LDB(B1, 1, 1); PG8_SCHED; PG8_LDA(At, 1, 0); PG8_STAGE(PG8_SA(0, 1), a2 + hstepA, voffA);
            PG8_WAIT_V(8); PG8_WAIT_L(0); PG8_BAR; PG8_MMA(0, 0, At, B0); PG8_MMA(0, 1, At, B1); PG8_BAR; PG8_SCHED;
            PG8_LDA(At, 1, 1); PG8_STAGE(PG8_SB(1, 0), b3, voffB); PG8_STAGE(PG8_SB(1, 1), b3 + hstepB, voffB); PG8_STAGE(PG8_SA(1, 0), a3, voffA);
            PG8_WAIT_V(8); PG8_WAIT_L(0); PG8_BAR; PG8_MMA(1, 0, At, B0); PG8_MMA(1, 1, At, B1); PG8_BAR; PG8_SCHED;
            } else {
            PG8_LDB(B0, 0, 0); PG8_SCHED; PG8_LDA(At, 0, 0); PG8_STAGE(PG8_SA(1, 1), a1 + hstepA, voffA);
            PG8_WAIT_L(8); PG8_BAR; PG8_WAIT_L(0); PG8_MMA(0, 0, At, B0); PG8_BAR; PG8_SCHED;
            PG8_LDB(B1, 0, 1); PG8_STAGE(PG8_SB(0, 0), b2, voffB);
            PG8_BAR; PG8_WAIT_L(0); PG8_MMA(0, 1, At, B1); PG8_BAR;
            PG8_LDA(At, 0, 1); PG8_STAGE(PG8_SA(0, 0), a2, voffA);
            PG8_BAR; PG8_WAIT_L(0); PG8_MMA(1, 0, At, B0); PG8_BAR; PG8_SCHED;
            PG8_STAGE(PG8_SB(0, 1), b2 + hstepB, voffB);
            PG8_WAIT_V(6); PG8_BAR; PG8_MMA(1, 1, At, B1); PG8_BAR;
            PG8_LDB(B0, 1, 0); PG8_SCHED; PG8_LDA(At, 1, 0); PG8_STAGE(PG8_SA(0, 1), a2 + hstepA, voffA);
            PG8_WAIT_L(8); PG8_BAR; PG8_WAIT_L(0); PG8_MMA(0, 0, At, B0); PG8_BAR; PG8_SCHED;
            PG8_LDB(B1, 1, 1); PG8_STAGE(PG8_SB(1, 0), b3, voffB);
            PG8_BAR; PG8_WAIT_L(0); PG8_MMA(0, 1, At, B1); PG8_BAR;
            PG8_LDA(At, 1, 1); PG8_STAGE(PG8_SA(1, 0), a3, voffA);
            PG8_BAR; PG8_WAIT_L(0); PG8_MMA(1, 0, At, B0); PG8_BAR; PG8_SCHED;
            PG8_STAGE(PG8_SB(1, 1), b3 + hstepB, voffB);
            PG8_WAIT_V(6); PG8_BAR; PG8_MMA(1, 1, At, B1); PG8_BAR;
            }
        }
        if constexpr (ALIGN_EPI) { if (wr == 0) PG8_BAR; }
        if constexpr (!Epi::AFTER_DRAIN) { E(acc, cur, wr, wc, fr, fq); S.done(cur); }
        if (!has_next) break;
#pragma unroll
        for (int a = 0; a < 2; ++a)
#pragma unroll
            for (int b = 0; b < 2; ++b)
#pragma unroll
                for (int m = 0; m < 4; ++m)
#pragma unroll
                    for (int n = 0; n < 2; ++n) acc[a][b][m][n] = (f32x4){0.f, 0.f, 0.f, 0.f};
        cur = nxt; cA = nA; cB = nB; ++ui;
        if constexpr (ALIGN_EPI) { if (wr == 1) PG8_BAR; }
    }
    PG8_WAIT_V(0);
    if constexpr (!ALIGN_EPI) { if (wr == 0) PG8_BAR; }
    PG8_BAR;
    if constexpr (Epi::AFTER_DRAIN) { E.fused(acc, cur, wr, wc, fr, fq, lds, wid, lane); S.done(cur); }
#undef PG8_SA
#undef PG8_SB
#undef PG8_STAGE
#undef PG8_LDA
#undef PG8_LDB
#undef PG8_MMA
#undef PG8_WAIT_V
#undef PG8_WAIT_L
#undef PG8_BAR
#undef PG8_SCHED
#undef PG8_APTR
#undef PG8_BPTR
}
}
namespace attn {
using bf16 = __hip_bfloat16;
typedef short bf16x8 __attribute__((ext_vector_type(8)));
typedef short s16x4 __attribute__((ext_vector_type(4)));
typedef float f32x16 __attribute__((ext_vector_type(16)));
typedef float f32x4 __attribute__((ext_vector_type(4)));
typedef unsigned u32x4 __attribute__((ext_vector_type(4)));
template <class A, class Bt> struct same_t { static constexpr bool v = false; };
template <class A> struct same_t<A, A> { static constexpr bool v = true; };
constexpr int D = 128;
constexpr int QP = 2048, KVP = 2048, OP = 4096;
constexpr int CHUNKM1 = 63;
constexpr float THR = 8.f;
constexpr bool WSKIP = false;
constexpr float SCALE = 0.08838834764831845f;
constexpr int NW = 8, QBLK = 32, KVBLK = 64, QB = NW * QBLK;
constexpr int SHM_V = KVBLK * D * 2, SHM_K = KVBLK * D * 2;
constexpr int LDS_BYTES = 2 * SHM_V + 2 * SHM_K + NW * 64 * 4;
#define KSWZ(row, colB) ((row) * 256 + ((colB) ^ (((row) & 7) << 4)))
#define SBAR() __builtin_amdgcn_sched_barrier(0)
__device__ __forceinline__ int v_st(int k, int c) { const int kk = (k & ~0xC) | ((k & 4) << 1) | ((k & 8) >> 1); return ((kk >> 3) * 4 + (c >> 5)) * 512 + ((kk & 7) * 32 + (c & 31)) * 2; }
__device__ __forceinline__ int v_rd_base(int lane) { return ((lane & 3) << 3) | (((lane >> 2) & 3) << 6) | (((lane >> 4) & 1) << 5) | (((lane >> 5) & 1) << 8); }
constexpr int v_rd_off(int d0, int ks, int half) { return d0 * 512 + ks * 4096 + half * 2048; }
__device__ __forceinline__ int crow(int r, int hi) { return (r & 3) + 8 * (r >> 2) + 4 * hi; }
__device__ __forceinline__ unsigned cvtpk(float lo, float hi) {
    unsigned r; asm volatile("v_cvt_pk_bf16_f32 %0, %1, %2" : "=v"(r) : "v"(lo), "v"(hi)); return r;
}
__device__ __forceinline__ bf16x8 pack8(f32x4 a, f32x4 b) {
    u32x4 w = {cvtpk(a[0], a[1]), cvtpk(a[2], a[3]), cvtpk(b[0], b[1]), cvtpk(b[2], b[3])};
    return *reinterpret_cast<bf16x8*>(&w);
}
template <class T> __device__ __forceinline__ bf16x8 load8(const T* p) {
    if constexpr (same_t<T, float>::v) { return pack8(*(const f32x4*)p, *(const f32x4*)(p + 4)); }
    else { return *reinterpret_cast<const bf16x8*>(p); }
}
__device__ __forceinline__ void mask_tile(f32x16& p0, f32x16& p1, int dq, unsigned W) {
    const float NEG = -__builtin_inff();
#pragma unroll
    for (int r = 0; r < 16; ++r) {
        const int c = (r & 3) + 8 * (r >> 2);
        if ((unsigned)(dq - c) >= W) p0[r] = NEG;
        if ((unsigned)(dq - c - 32) >= W) p1[r] = NEG;
    }
}
__device__ __forceinline__ void partialSM(f32x16& p0, f32x16& p1, float& m_reg, float& mn, float& alpha) {
    float pmax = p0[0]; for (int r = 1; r < 16; ++r) pmax = fmaxf(pmax, p0[r]); for (int r = 0; r < 16; ++r) pmax = fmaxf(pmax, p1[r]);
    { auto rr = __builtin_amdgcn_permlane32_swap(__float_as_uint(pmax), __float_as_uint(pmax), false, false);
      pmax = fmaxf(__uint_as_float(rr[0]), __uint_as_float(rr[1])); }
    constexpr float C2 = 1.4426950408889634f * SCALE;
    if (__builtin_expect(__all((pmax - m_reg) * SCALE <= THR), 1)) { mn = m_reg; alpha = 1.f; }
    else { mn = fmaxf(m_reg, pmax); alpha = __builtin_amdgcn_exp2f((m_reg - mn) * C2); m_reg = mn; }
    const float mnL = -mn * C2;
    for (int r = 0; r < 16; ++r) p0[r] = fmaf(p0[r], C2, mnL); for (int r = 0; r < 16; ++r) p1[r] = fmaf(p1[r], C2, mnL);
    for (int r = 0; r < 16; ++r) p0[r] = __builtin_amdgcn_exp2f(p0[r]);
}
__device__ __forceinline__ void finishSM(f32x16& p0, f32x16& p1, float alpha, float& l_reg, bf16x8& pa0, bf16x8& pa1, bf16x8& pa2, bf16x8& pa3) {
    for (int r = 0; r < 16; ++r) p1[r] = __builtin_amdgcn_exp2f(p1[r]);
    float ps = 0; for (int r = 0; r < 16; ++r) ps += p0[r]; for (int r = 0; r < 16; ++r) ps += p1[r];
    { auto rr = __builtin_amdgcn_permlane32_swap(__float_as_uint(ps), __float_as_uint(ps), false, false);
      ps = __uint_as_float(rr[0]) + __uint_as_float(rr[1]); }
    l_reg = l_reg * alpha + ps;
#define PK4(P, B_, OUT) do { unsigned a0 = cvtpk(P[B_+0], P[B_+1]), a1 = cvtpk(P[B_+2], P[B_+3]);                          \
        unsigned b0 = cvtpk(P[B_+4], P[B_+5]), b1 = cvtpk(P[B_+6], P[B_+7]);                                             \
        auto r0 = __builtin_amdgcn_permlane32_swap(a0, b0, false, false); auto r1 = __builtin_amdgcn_permlane32_swap(a1, b1, false, false); \
        u32x4 w = {r0[0], r1[0], r0[1], r1[1]}; OUT = *reinterpret_cast<bf16x8*>(&w); } while (0)
    PK4(p0, 0, pa0); PK4(p0, 8, pa1); PK4(p1, 0, pa2); PK4(p1, 8, pa3);
#undef PK4
}
template <int KB, bool SK>
__device__ __forceinline__ void qkt(f32x16& p0, f32x16& p1, const char* K_lds, int r32, int hi, const bf16x8* qr, bool act) {
    if (SK && !act) { const float NEG = -__builtin_inff();
#pragma unroll
        for (int r = 0; r < 16; ++r) { p0[r] = NEG; p1[r] = NEG; } return; }
    p0 = f32x16{}; p1 = f32x16{};
    const char* kb[4];
#pragma unroll
    for (int dd = 0; dd < 4; ++dd) kb[dd] = K_lds + KB * SHM_K + KSWZ(r32, (dd * 16 + hi * 8) * 2);
#pragma unroll
    for (int d0 = 0; d0 < 8; ++d0) { const char* a = kb[d0 & 3] + (d0 >> 2) * 128;
        bf16x8 b0 = *reinterpret_cast<const bf16x8*>(a);
        bf16x8 b1 = *reinterpret_cast<const bf16x8*>(a + 32 * 256);
        p0 = __builtin_amdgcn_mfma_f32_32x32x16_bf16(b0, qr[d0], p0, 0, 0, 0);
        p1 = __builtin_amdgcn_mfma_f32_32x32x16_bf16(b1, qr[d0], p1, 0, 0, 0); }
}
template <int VB, bool SK>
__device__ __forceinline__ void pv_tile(f32x16* o, int vb0, bf16x8 pa0, bf16x8 pa1, bf16x8 pa2, bf16x8 pa3, bool act) {
    if (SK && !act) return;
#define TRRD(dst, off) asm volatile("ds_read_b64_tr_b16 %0, %1 offset:%2" : "=&v"(dst) : "v"(vb0), "i"(off) : "memory")
#define PV_D0(d0) do { s16x4 l0, l1, l2, l3, h0, h1, h2, h3; constexpr int b_ = VB * SHM_V + v_rd_off(d0, 0, 0);     \
        TRRD(l0, b_); TRRD(h0, b_ + 2048); TRRD(l1, b_ + 4096); TRRD(h1, b_ + 6144); TRRD(l2, b_ + 8192); TRRD(h2, b_ + 10240); TRRD(l3, b_ + 12288); TRRD(h3, b_ + 14336); \
        asm volatile("s_waitcnt lgkmcnt(0)" ::: "memory"); SBAR();                 \
        o[d0] = __builtin_amdgcn_mfma_f32_32x32x16_bf16(pa0, (bf16x8){l0[0], l0[1], l0[2], l0[3], h0[0], h0[1], h0[2], h0[3]}, o[d0], 0, 0, 0);   \
        o[d0] = __builtin_amdgcn_mfma_f32_32x32x16_bf16(pa1, (bf16x8){l1[0], l1[1], l1[2], l1[3], h1[0], h1[1], h1[2], h1[3]}, o[d0], 0, 0, 0);   \
        o[d0] = __builtin_amdgcn_mfma_f32_32x32x16_bf16(pa2, (bf16x8){l2[0], l2[1], l2[2], l2[3], h2[0], h2[1], h2[2], h2[3]}, o[d0], 0, 0, 0);   \
        o[d0] = __builtin_amdgcn_mfma_f32_32x32x16_bf16(pa3, (bf16x8){l3[0], l3[1], l3[2], l3[3], h3[0], h3[1], h3[2], h3[3]}, o[d0], 0, 0, 0); } while (0)
    PV_D0(0); PV_D0(1); PV_D0(2); PV_D0(3);
#undef PV_D0
#undef TRRD
}

template <class TIn, class TOut> struct BlockRef { const TIn* Q; const TIn* K; const TIn* V; TOut* O; int P0; };
template <class TIn> struct Seam {
    bf16x8 qr[8];
    bf16x8 st_v0, st_v1, st_k0, st_k1; f32x4 sf0, sf1, sf2, sf3;
    f32x4 tq[16];
};
__device__ __forceinline__ int swa_jlo(int P0, int W) { const int lowk = P0 - W + 1; return lowk > 0 ? lowk / KVBLK : 0; }
#define ROW(p, k0, rr) ((p) + (size_t)((k0) + (rr)) * KVP + sc)
#define VMW() asm volatile("s_waitcnt vmcnt(0)" ::: "memory")
#define VMWN(n) asm volatile("s_waitcnt vmcnt(%0)" :: "i"(n) : "memory")
#define SLOAD_H(Kp, Vp, k0) do { S.st_v0 = load8<TIn>(ROW(Vp, k0, sr)); S.st_v1 = load8<TIn>(ROW(Vp, k0, 32 + sr));              \
                         S.st_k0 = load8<TIn>(ROW(Kp, k0, sr)); S.st_k1 = load8<TIn>(ROW(Kp, k0, 32 + sr)); } while (0)
#define SWRITE_HK(bf) do { *(bf16x8*)(K_lds + (bf) * SHM_K + kws) = S.st_k0; *(bf16x8*)(K_lds + (bf) * SHM_K + kws + 32 * 256) = S.st_k1; } while (0)
#define SWRITE_HV(bf) do { *(bf16x8*)(V_lds + (bf) * SHM_V + vst0) = S.st_v0; *(bf16x8*)(V_lds + (bf) * SHM_V + vst1) = S.st_v1; } while (0)
#define SWRITE_H(bf) do { SWRITE_HV(bf); SWRITE_HK(bf); } while (0)
#define SLOAD_F(p, k0) do { S.sf0 = *(const f32x4*)ROW(p, k0, sr); S.sf1 = *(const f32x4*)(ROW(p, k0, sr) + 4);                \
                            S.sf2 = *(const f32x4*)ROW(p, k0, 32 + sr); S.sf3 = *(const f32x4*)(ROW(p, k0, 32 + sr) + 4); } while (0)
#define SWRITE_KF(bf) do { *(bf16x8*)(K_lds + (bf) * SHM_K + kws) = pack8(S.sf0, S.sf1); *(bf16x8*)(K_lds + (bf) * SHM_K + kws + 32 * 256) = pack8(S.sf2, S.sf3); } while (0)
#define SWRITE_VF(bf) do { *(bf16x8*)(V_lds + (bf) * SHM_V + vst0) = pack8(S.sf0, S.sf1); *(bf16x8*)(V_lds + (bf) * SHM_V + vst1) = pack8(S.sf2, S.sf3); } while (0)
template <class TIn, class TOut>
__device__ __forceinline__ void causal_swa_prime(const BlockRef<TIn, TOut>& cur, int W, char* lds, Seam<TIn>& S) {
    constexpr bool F32 = same_t<TIn, float>::v;
    int tid = threadIdx.x; asm volatile("" : "+v"(tid)); const int wid = __builtin_amdgcn_readfirstlane(tid >> 6), lane = tid & 63, r32 = lane & 31, hi = lane >> 5;
    const int sr = tid >> 4, sc = (tid & 15) * 8, kws = KSWZ(sr, sc * 2); char* K_lds = lds + 2 * SHM_V;
    const int kb0 = swa_jlo(cur.P0, W) * KVBLK;
    for (int d0 = 0; d0 < 8; ++d0) S.qr[d0] = load8<TIn>(cur.Q + (size_t)(wid * QBLK + r32) * QP + d0 * 16 + hi * 8);
    if constexpr (F32) { SLOAD_F((const float*)cur.K, kb0); VMW(); SWRITE_KF(0); SBAR(); SLOAD_F((const float*)cur.V, kb0); }
    else { SLOAD_H(cur.K, cur.V, kb0); VMW(); SWRITE_HK(0); }
    __syncthreads();
}
template <class TIn, class TOut>
__device__ __forceinline__ void causal_swa_block(const BlockRef<TIn, TOut>& cur, const BlockRef<TIn, TOut>& nxt, int skv, int W, char* lds, Seam<TIn>& S) {
    constexpr bool F32 = same_t<TIn, float>::v;
    int tid = threadIdx.x; asm volatile("" : "+v"(tid)); const int wid = __builtin_amdgcn_readfirstlane(tid >> 6), lane = tid & 63, r32 = lane & 31, hi = lane >> 5;
    const int j_lo = swa_jlo(cur.P0, W);
    int j_hi = (cur.P0 + QB - 1) / KVBLK + 1; if (j_hi > skv / KVBLK) j_hi = skv / KVBLK;
    const int NT = j_hi - j_lo;
    const int kbn = swa_jlo(nxt.P0, W) * KVBLK;
    const int qlo = (cur.P0 + wid * QBLK) | (CHUNKM1), qm = qlo - 4 * hi;
    char* V_lds = lds; char* K_lds = lds + 2 * SHM_V;
    float* ws = (float*)(lds + 2 * SHM_V + 2 * SHM_K) + wid * 64; float* li_l = ws, * al_l = ws + 32;
    float m_reg = -1e30f, l_reg = 0; f32x16 o[4] = {};
    const int sr = tid >> 4, sc = (tid & 15) * 8, vst0 = v_st(sr, sc), vst1 = v_st(32 + sr, sc), kws = KSWZ(sr, sc * 2);
    const int vb0 = (int)(uintptr_t)V_lds + v_rd_base(lane);
    const TIn* Kh = cur.K; const TIn* Vh = cur.V;
#define RESC(a) do { if (__any((a) < 1.f)) { if (hi == 0) al_l[r32] = (a); asm volatile("s_waitcnt lgkmcnt(0)" ::: "memory");              \
                     for (int d_ = 0; d_ < 4; ++d_) for (int r = 0; r < 16; ++r) o[d_][r] *= al_l[crow(r, hi)]; } } while (0)
#define KBASE(t) ((j_lo + (t)) * KVBLK)
#define ACT(t) (KBASE(t) <= qlo + QBLK - 1 && KBASE(t) + KVBLK - 1 >= qlo - W + 1)
#define MASKT(P0_, P1_, t) do { const int kb_ = KBASE(t); if ((!SK || ACT(t)) && (kb_ + KVBLK - 1 > qlo || kb_ <= qlo + QBLK - 1 - W)) mask_tile(P0_, P1_, qm - kb_, (unsigned)W); } while (0)
    constexpr int NQL = F32 ? 16 : 8;
    constexpr bool SK = WSKIP && !F32;
#define SEAM_K0() do { VMWN(NQL); if constexpr (F32) { SWRITE_KF(0); SBAR(); SLOAD_F((const float*)nxt.V, kbn); } else { SWRITE_HK(0); } SBAR(); } while (0)
    f32x16 pA0, pA1, pB0, pB1; float mnA, mnB, alA, alB; bf16x8 pa0, pa1, pa2, pa3;
    if constexpr (F32) { VMW(); SWRITE_VF(0); SBAR(); } else { SWRITE_HV(0); SBAR(); }
    if (NT > 1) { if constexpr (F32) SLOAD_F((const float*)Kh, KBASE(1)); else SLOAD_H(Kh, Vh, KBASE(1)); }
    SBAR(); qkt<0, SK>(pA0, pA1, K_lds, r32, hi, S.qr, ACT(0));
    if constexpr (F32) { if (NT > 1) { VMW(); SWRITE_KF(1); SBAR(); SLOAD_F((const float*)Vh, KBASE(1)); } }
    MASKT(pA0, pA1, 0); partialSM(pA0, pA1, m_reg, mnA, alA);
    if (NT > 1) { VMW(); if constexpr (F32) { SWRITE_VF(1); SBAR(); if (NT > 2) SLOAD_F((const float*)Kh, KBASE(2)); } else SWRITE_H(1); }
    __syncthreads();
#define HALF_STEP(PX0, PX1, mnX, alX, PY0, PY1, alY, t, KB, VB, SB) do {                                                      \
        SBAR(); qkt<KB, SK>(PX0, PX1, K_lds, r32, hi, S.qr, ACT(t));                                             \
        finishSM(PY0, PY1, alY, l_reg, pa0, pa1, pa2, pa3); SBAR();                                                           \
        if ((t) + 1 < NT) { if constexpr (F32) { VMW(); SWRITE_KF(SB); SBAR(); SLOAD_F((const float*)Vh, KBASE((t) + 1)); }  \
                            else { SLOAD_H(Kh, Vh, KBASE((t) + 1)); } SBAR(); }                                               \
        pv_tile<VB, SK>(o, vb0, pa0, pa1, pa2, pa3, ACT((t) - 1)); MASKT(PX0, PX1, (t)); partialSM(PX0, PX1, m_reg, mnX, alX);                                        \
        __syncthreads();                                                                                                      \
        if ((t) + 1 < NT) { VMW(); if constexpr (F32) { SWRITE_VF(SB); SBAR(); if ((t) + 2 < NT) SLOAD_F((const float*)Kh, KBASE((t) + 2)); } \
                            else { SWRITE_H(SB); } }                                                                          \
        RESC(alX); __syncthreads(); } while (0)
    for (int t = 1; t + 1 < NT; t += 2) {
        HALF_STEP(pB0, pB1, mnB, alB, pA0, pA1, alA, t, 1, 0, 0);
        HALF_STEP(pA0, pA1, mnA, alA, pB0, pB1, alB, t + 1, 0, 1, 1);
    }
    const bool even = (NT & 1) == 0;
    if (even) { SBAR(); qkt<1, SK>(pB0, pB1, K_lds, r32, hi, S.qr, ACT(NT - 1)); SBAR(); }
#define QROW(e) (nxt.Q + (size_t)(wid * QBLK + r32) * QP + ((e) >> 1) * 16 + hi * 8 + ((e) & 1) * 4)
    if constexpr (F32) { SLOAD_F((const float*)nxt.K, kbn); SBAR();
#pragma unroll
        for (int e = 0; e < 8; ++e) S.tq[e] = *(const f32x4*)QROW(e); }
    else { SLOAD_H(nxt.K, nxt.V, kbn); SBAR();
#pragma unroll
        for (int d0 = 0; d0 < 8; ++d0) S.qr[d0] = load8<TIn>(nxt.Q + (size_t)(wid * QBLK + r32) * QP + d0 * 16 + hi * 8); }
    SBAR();
    finishSM(pA0, pA1, alA, l_reg, pa0, pa1, pa2, pa3); SBAR();
    if constexpr (F32) {
#pragma unroll
        for (int e = 8; e < 16; ++e) S.tq[e] = *(const f32x4*)QROW(e); SBAR(); }
#undef QROW
    pv_tile<0, SK>(o, vb0, pa0, pa1, pa2, pa3, ACT(even ? NT - 2 : NT - 1));
    if (even) { MASKT(pB0, pB1, NT - 1); partialSM(pB0, pB1, m_reg, mnB, alB); __syncthreads(); RESC(alB);
        finishSM(pB0, pB1, alB, l_reg, pa0, pa1, pa2, pa3); SBAR(); pv_tile<1, SK>(o, vb0, pa0, pa1, pa2, pa3, ACT(NT - 1)); }
    SBAR(); SEAM_K0();
    if (hi == 0) li_l[r32] = l_reg; asm volatile("s_waitcnt lgkmcnt(0)" ::: "memory");
    float rli[16];
#pragma unroll
    for (int r = 0; r < 16; ++r) rli[r] = __builtin_amdgcn_rcpf(li_l[crow(r, hi)]);
    TOut* Ow = cur.O + (size_t)(wid * QBLK) * OP;
#pragma unroll
    for (int r = 0; r < 16; ++r) { const int orow = crow(r, hi);
#pragma unroll
        for (int d0 = 0; d0 < 4; ++d0) { const float v = o[d0][r] * rli[r];
            if constexpr (same_t<TOut, float>::v) { Ow[(size_t)orow * OP + d0 * 32 + r32] = v; }
            else { const float vn = __shfl_xor(v, 1);
                   if ((r32 & 1) == 0) *(unsigned*)(Ow + (size_t)orow * OP + d0 * 32 + r32) = cvtpk(v, vn); } } }
    if constexpr (F32) {
#pragma unroll
        for (int d0 = 0; d0 < 8; ++d0) S.qr[d0] = pack8(S.tq[2 * d0], S.tq[2 * d0 + 1]); }
    __syncthreads();
#undef RESC
#undef KBASE
#undef ACT
#undef MASKT
#undef SEAM_K0
#undef HALF_STEP
}
#undef ROW
#undef VMW
#undef VMWN
#undef SLOAD_H
#undef SWRITE_HK
#undef SWRITE_HV
#undef SWRITE_H
#undef SLOAD_F
#undef SWRITE_KF
#undef SWRITE_VF
}
struct Ctx {
    LAS unsigned char* lds;
    int tid, lane, wave, G, vcu, gw, NGW;
};

__device__ __forceinline__ void transpose_item(const float* W, int ldw, int k0, int n0, bf16* WT, int Kdst, int dst_row0, LAS float* scr, int lane) {
    {
        f32x4 v[8]; const int r = lane >> 3, n4 = (lane & 7) * 4;
#pragma unroll
        for (int i = 0; i < 8; ++i) v[i] = __builtin_nontemporal_load((const GAS f32x4*)(W + (size_t)(k0 + 8 * i + r) * ldw + n0 + n4));
#pragma unroll
        for (int i = 0; i < 8; ++i) { LAS float* d = scr + (8 * i + r) * 33 + n4; d[0] = v[i].x; d[1] = v[i].y; d[2] = v[i].z; d[3] = v[i].w; }
    }
    LDS_WAIT(); asm volatile("" ::: "memory");
    const int c = lane & 7;
#pragma unroll
    for (int j = 0; j < 4; ++j) { const int n = (lane >> 3) + 8 * j; const LAS float* s = scr + (8 * c) * 33 + n;
        v4u o; o.x = pk2(s[0 * 33], s[1 * 33]); o.y = pk2(s[2 * 33], s[3 * 33]); o.z = pk2(s[4 * 33], s[5 * 33]); o.w = pk2(s[6 * 33], s[7 * 33]);
        *(GAS v4u*)(WT + (((size_t)(dst_row0 >> 8) * (Kdst >> 6) + (k0 >> 6)) * 256 + (dst_row0 & 255) + n) * 64 + 8 * c) = o; }
    LDS_WAIT(); asm volatile("" ::: "memory");
}
typedef const float* const __attribute__((address_space(4)))* InTab;
__device__ __forceinline__ void p0_prologue(const Ctx& X, InTab in, unsigned char* ws) {
    LAS float* scr = (LAS float*)(X.lds + RING_OFF + X.wave * 16384);
    constexpr int I_MOD = (NMODT / 256) * 16;
    constexpr int I_FIN = (DM / 64) * (2 * DFF / 32), I_FOUT = (DFF / 64) * (DM / 32), I_LIN = (DM / 64) * (2 * DM / 32), I_G = 16 * 32;
    constexpr int I_SQ = (DM / 64) * (DM / 32), I_KV = (DM / 64) * (2 * DM / 32);
    constexpr int NITEMS = I_MOD + 4 * I_FIN + 4 * I_FOUT + I_LIN + I_G + I_SQ + I_KV + I_SQ + I_SQ;
    for (int it = X.gw; it < NITEMS; it += X.NGW) {
        int r = it;
        if (r < I_MOD) {
            const int cg = r >> 4, kc = r & 15; const float* W; int ldw, cc;
            if (cg < 72) { W = in[2]; ldw = NMOD; cc = cg * 256; } else if (cg < 144) { W = in[2] + (size_t)DM * NMOD; ldw = NMOD; cc = (cg - 72) * 256; } else { W = in[17]; ldw = 4096; cc = (cg - 144) * 256; }
            const int kb = kc * 128;
            float ca[2][2];
#pragma unroll
            for (int b = 0; b < 2; ++b)
#pragma unroll
                for (int hh = 0; hh < 2; ++hh) ca[b][hh] = silu_f(in[1][b * DM + kb + hh * 64 + X.lane]);
            f32x4 acc0 = {0.f, 0.f, 0.f, 0.f}, acc1 = {0.f, 0.f, 0.f, 0.f};
            const float* wp = W + (size_t)kb * ldw + cc + 4 * X.lane;
#pragma unroll
            for (int hh = 0; hh < 2; ++hh) {
#pragma unroll 16
                for (int kk = 0; kk < 64; ++kk) {
                    const f32x4 w = __builtin_nontemporal_load((const GAS f32x4*)(wp + (size_t)(hh * 64 + kk) * ldw));
                    const float s0 = __uint_as_float(__builtin_amdgcn_readlane(__float_as_uint(ca[0][hh]), kk));
                    const float s1 = __uint_as_float(__builtin_amdgcn_readlane(__float_as_uint(ca[1][hh]), kk));
                    acc0 += w * s0; acc1 += w * s1; }
            }
            *(GAS f32x4*)((float*)(ws + WS_MODP) + (size_t)(kc * 2 + 0) * NMODT + cg * 256 + 4 * X.lane) = acc0;
            *(GAS f32x4*)((float*)(ws + WS_MODP) + (size_t)(kc * 2 + 1) * NMODT + cg * 256 + 4 * X.lane) = acc1;
            continue; }
        r -= I_MOD;
        if (r < 3 * I_FOUT) { const int mi = 1 + r / I_FOUT, q = r % I_FOUT; constexpr int nblk = DM / 32; const int kb = q / nblk, nb = q % nblk;
            transpose_item(in[6] + (size_t)mi * DFF * DM, DM, 64 * kb, 32 * nb, (bf16*)(ws + WS_WFOUT) + (size_t)mi * DM * DFF, DFF, 32 * nb, scr, X.lane); continue; }
        r -= 3 * I_FOUT;
        if (r < 3 * I_FIN) {
            const int mi = 1 + r / I_FIN, q = r % I_FIN; constexpr int nblk = 2 * DFF / 32; const int kb = q / nblk, nb = q % nblk, n0 = 32 * nb;
            const int nn = n0 < DFF ? n0 : n0 - DFF; const int drow = (nn >> 7) * 256 + (n0 < DFF ? 0 : 128) + (nn & 127);
            transpose_item(in[5] + (size_t)mi * DM * 2 * DFF, 2 * DFF, 64 * kb, n0, (bf16*)(ws + WS_WFIN) + (size_t)mi * 2 * DFF * DM, DM, drow, scr, X.lane); continue; }
        r -= 3 * I_FIN;
        if (r < I_SQ) { constexpr int nblk = DM / 32; const int kb = r / nblk, nb = r % nblk; transpose_item(in[23], DM, 64 * kb, 32 * nb, (bf16*)(ws + WS_WO), DM, 32 * nb, scr, X.lane); continue; }
        r -= I_SQ;
        if (r < I_SQ) { constexpr int nblk = DM / 32; const int kb = r / nblk, nb = r % nblk; transpose_item(in[20], DM, 64 * kb, 32 * nb, (bf16*)(ws + WS_WQ), DM, 32 * nb, scr, X.lane); continue; }
        r -= I_SQ;
        if (r < I_KV) { constexpr int nblk = 2 * DM / 32; const int kb = r / nblk, nb = r % nblk; transpose_item(in[19], 2 * DM, 64 * kb, 32 * nb, (bf16*)(ws + WS_WKV), DM, 32 * nb, scr, X.lane); continue; }
        r -= I_KV;
        if (r < I_SQ) { constexpr int nblk = DM / 32; const int kb = r / nblk, nb = r % nblk; transpose_item(in[15], DM, 64 * kb, 32 * nb, (bf16*)(ws + WS_WLOUT), DM, 32 * nb, scr, X.lane); continue; }
        r -= I_SQ;
        if (r < I_G) { const int g = r >> 5, q = r & 31, head = g >> 1, which = g & 1, kb = q >> 3, nb = q & 7, n0 = 32 * nb;
            const float* W = (which ? in[12] : in[10]) + (size_t)head * LRUB * LRUB;
            const int drow = (head * 2 + (n0 >> 7)) * 256 + which * 128 + (n0 & 127);
            transpose_item(W, LRUB, 64 * kb, n0, (bf16*)(ws + WS_WG), LRUB, drow, scr, X.lane); continue; }
        r -= I_G;
        if (r < I_LIN) { constexpr int nblk = 2 * DM / 32; const int kb = r / nblk, nb = r % nblk;
            transpose_item(in[7], 2 * DM, 64 * kb, 32 * nb, (bf16*)(ws + WS_WLIN), DM, 32 * nb, scr, X.lane); continue; }
        r -= I_LIN;
        if (r < I_FOUT) { const int q = r; constexpr int nblk = DM / 32; const int kb = q / nblk, nb = q % nblk;
            transpose_item(in[6], DM, 64 * kb, 32 * nb, (bf16*)(ws + WS_WFOUT), DFF, 32 * nb, scr, X.lane); continue; }
        r -= I_FOUT;
        { const int q = r; constexpr int nblk = 2 * DFF / 32; const int kb = q / nblk, nb = q % nblk, n0 = 32 * nb;
            const int nn = n0 < DFF ? n0 : n0 - DFF; const int drow = (nn >> 7) * 256 + (n0 < DFF ? 0 : 128) + (nn & 127);
            transpose_item(in[5], 2 * DFF, 64 * kb, n0, (bf16*)(ws + WS_WFIN), DM, drow, scr, X.lane); }
    }
}
__device__ __forceinline__ void p1_modreduce(const Ctx& X, const float* modp, const float* b_mod, const float* kv_b_mod, float* mod,
                                             const float* b_a, const float* b_x, const float* lam, float* gc) {
    for (int idx = blockIdx.x * (NWAVES * 64) + X.tid; idx < 2 * NMODT; idx += X.G * NWAVES * 64) {
        const int b = idx / NMODT, col = idx % NMODT;
        float s = col < 2 * NMOD ? b_mod[col] : kv_b_mod[col - 2 * NMOD];
#pragma unroll
        for (int kc = 0; kc < 16; ++kc) s += modp[(size_t)(kc * 2 + b) * NMODT + col];
        mod[idx] = s;
    }
    for (int ch = blockIdx.x * (NWAVES * 64) + X.tid; ch < DM; ch += X.G * NWAVES * 64) {
        const float z = -lam[ch];
        gc[ch] = b_a[ch]; gc[DM + ch] = b_x[ch]; gc[2 * DM + ch] = 8.0f * (fmaxf(z, 0.f) + log1pf(expf(-fabsf(z))));
    }
}

struct NormArgs { const float* xin; const float* y; float* xout; bf16* h1; bf16* h2; float wgt;
                  const float *gpost, *gate;
                  const float *gpre1, *scale1, *shift1, *gpre2, *scale2, *shift2; };
__device__ __forceinline__ void norm_phase(const Ctx& X, const NormArgs& a) {
    LAS float* V = (LAS float*)(X.lds + RING_OFF);
    for (int it = blockIdx.x; it < M / 32; it += X.G) {
        const int b = (it * 32) / SEQ;
        for (int c = X.tid; c < DM; c += NWAVES * 64) {
            if (a.y)  V[c] = a.wgt * a.gate[(size_t)b * NMODT + c] * a.gpost[c];
            if (a.h1) { V[DM + c] = a.gpre1[c] * (1.0f + a.scale1[(size_t)b * NMODT + c]); V[2 * DM + c] = a.shift1[(size_t)b * NMODT + c]; }
            if (a.h2) { V[3 * DM + c] = a.gpre2[c] * (1.0f + a.scale2[(size_t)b * NMODT + c]); V[4 * DM + c] = a.shift2[(size_t)b * NMODT + c]; }
        }
        __syncthreads();
#pragma unroll 1
        for (int rr = 0; rr < 4; ++rr) {
            const size_t row = (size_t)it * 32 + X.wave * 4 + rr;
            f32x4 xv[8];
#pragma unroll
            for (int j = 0; j < 8; ++j) xv[j] = *(const GAS f32x4*)(a.xin + row * DM + 256 * j + 4 * X.lane);
            if (a.y) {
                f32x4 yv[8]; float ss = 0.f;
#pragma unroll
                for (int j = 0; j < 8; ++j) { yv[j] = *(const GAS f32x4*)(a.y + row * DM + 256 * j + 4 * X.lane); ss += (yv[j].x * yv[j].x + yv[j].y * yv[j].y) + (yv[j].z * yv[j].z + yv[j].w * yv[j].w); }
                const float rs = 1.0f / sqrtf(wave_sum(ss) * (1.0f / DM) + NORM_EPS);
#pragma unroll
                for (int j = 0; j < 8; ++j) { const f32x4 ca = *(const LAS f32x4*)(V + 256 * j + 4 * X.lane); xv[j] += ca * (yv[j] * rs); }
            }
            asm volatile("" ::: "memory");
            if (a.xout) {
#pragma unroll
                for (int j = 0; j < 8; ++j) *(GAS f32x4*)(a.xout + row * DM + 256 * j + 4 * X.lane) = xv[j];
            }
            if (a.h1 || a.h2) {
                float ss = 0.f;
#pragma unroll
                for (int j = 0; j < 8; ++j) ss += (xv[j].x * xv[j].x + xv[j].y * xv[j].y) + (xv[j].z * xv[j].z + xv[j].w * xv[j].w);
                const float rs = 1.0f / sqrtf(wave_sum(ss) * (1.0f / DM) + NORM_EPS);
                asm volatile("" ::: "memory");
                if (a.h1) {
#pragma unroll
                    for (int j = 0; j < 8; ++j) { const f32x4 cb = *(const LAS f32x4*)(V + DM + 256 * j + 4 * X.lane), cc = *(const LAS f32x4*)(V + 2 * DM + 256 * j + 4 * X.lane);
                        const f32x4 h = xv[j] * rs * cb + cc; v2u o; o.x = pk2(h.x, h.y); o.y = pk2(h.z, h.w);
                        *(GAS v2u*)(a.h1 + row * DM + 256 * j + 4 * X.lane) = o; }
                }
                asm volatile("" ::: "memory");
                if (a.h2) {
#pragma unroll
                    for (int j = 0; j < 8; ++j) { const f32x4 cb = *(const LAS f32x4*)(V + 3 * DM + 256 * j + 4 * X.lane), cc = *(const LAS f32x4*)(V + 4 * DM + 256 * j + 4 * X.lane);
                        const f32x4 h = xv[j] * rs * cb + cc; v2u o; o.x = pk2(h.x, h.y); o.y = pk2(h.z, h.w);
                        *(GAS v2u*)(a.h2 + row * DM + 256 * j + 4 * X.lane) = o; }
                }
            }
        }
        __syncthreads();
    }
}

__device__ __forceinline__ void conv_phase(const Ctx& X, const bf16* xr, const float* cw, const float* cb, bf16* xrc) {
    for (int w4 = X.gw; w4 < M / 4; w4 += X.NGW) {
        const int row0 = 4 * w4, t0 = row0 % SEQ;
#pragma unroll 1
        for (int j = 0; j < 4; ++j) {
            const int ch0 = j * 512 + 8 * X.lane;
            float wv[4][8], bv[8];
#pragma unroll
            for (int k = 0; k < 4; ++k) { const f32x4 w0 = *(const GAS f32x4*)(cw + k * DM + ch0), w1 = *(const GAS f32x4*)(cw + k * DM + ch0 + 4);
                wv[k][0] = w0.x; wv[k][1] = w0.y; wv[k][2] = w0.z; wv[k][3] = w0.w; wv[k][4] = w1.x; wv[k][5] = w1.y; wv[k][6] = w1.z; wv[k][7] = w1.w; }
            { const f32x4 b0 = *(const GAS f32x4*)(cb + ch0), b1 = *(const GAS f32x4*)(cb + ch0 + 4); bv[0] = b0.x; bv[1] = b0.y; bv[2] = b0.z; bv[3] = b0.w; bv[4] = b1.x; bv[5] = b1.y; bv[6] = b1.z; bv[7] = b1.w; }
            float xin[7][8];
#pragma unroll
            for (int i = 0; i < 7; ++i) {
                v4u w = {0u, 0u, 0u, 0u};
                if (t0 - 3 + i >= 0) w = *(const GAS v4u*)(xr + (size_t)(row0 - 3 + i) * DM + ch0);
                xin[i][0] = bflo(w.x); xin[i][1] = bfhi(w.x); xin[i][2] = bflo(w.y); xin[i][3] = bfhi(w.y); xin[i][4] = bflo(w.z); xin[i][5] = bfhi(w.z); xin[i][6] = bflo(w.w); xin[i][7] = bfhi(w.w); }
#pragma unroll
            for (int r = 0; r < 4; ++r) { float o[8];
#pragma unroll
                for (int e = 0; e < 8; ++e) { float s = bv[e];
#pragma unroll
                    for (int k = 0; k < 4; ++k) s += wv[k][e] * xin[r + k][e];
                    o[e] = s; }
                v4u w; w.x = pk2(o[0], o[1]); w.y = pk2(o[2], o[3]); w.z = pk2(o[4], o[5]); w.w = pk2(o[6], o[7]);
                *(GAS v4u*)(xrc + (size_t)(row0 + r) * DM + ch0) = w; }
        }
    }
}

__device__ __forceinline__ void scan_a_phase(const Ctx& X, const unsigned* AU, float* agp, float* agh, float* sagp, float* sagh) {
    LAS float* Pl = (LAS float*)(X.lds + RING_OFF); LAS float* Hl = Pl + 8 * 256;
    for (int bi = blockIdx.x; bi < 256; bi += X.G) {
        const int b = bi >> 7, sc = (bi >> 3) & 15, cg = bi & 7, chunk = sc * 8 + X.wave, ch = cg * 256 + 4 * X.lane;
        const size_t row0 = (size_t)b * SEQ + chunk * 32;
        f32x4 P = {1.f, 1.f, 1.f, 1.f}, H = {0.f, 0.f, 0.f, 0.f};
#pragma unroll 1
        for (int tb = 0; tb < 2; ++tb) {
            v4u wv[16];
#pragma unroll
            for (int i = 0; i < 16; ++i) wv[i] = *(const GAS v4u*)(AU + (row0 + tb * 16 + i) * DM + ch);
#pragma unroll
            for (int i = 0; i < 16; ++i) { const f32x4 a = {__builtin_amdgcn_exp2f(bflo(wv[i].x)), __builtin_amdgcn_exp2f(bflo(wv[i].y)), __builtin_amdgcn_exp2f(bflo(wv[i].z)), __builtin_amdgcn_exp2f(bflo(wv[i].w))};
                const f32x4 u = {bfhi(wv[i].x), bfhi(wv[i].y), bfhi(wv[i].z), bfhi(wv[i].w)}; H = a * H + u; P = P * a; }
        }
        *(GAS f32x4*)(agp + ((size_t)b * 128 + chunk) * DM + ch) = P; *(GAS f32x4*)(agh + ((size_t)b * 128 + chunk) * DM + ch) = H;
        *(LAS f32x4*)(Pl + X.wave * 256 + 4 * X.lane) = P; *(LAS f32x4*)(Hl + X.wave * 256 + 4 * X.lane) = H;
        __syncthreads();
        if (X.tid < 256) { float p = 1.f, h = 0.f;
#pragma unroll
            for (int w = 0; w < 8; ++w) { const float pw = Pl[w * 256 + X.tid], hw = Hl[w * 256 + X.tid]; h = pw * h + hw; p *= pw; }
            sagp[((size_t)b * 16 + sc) * DM + cg * 256 + X.tid] = p; sagh[((size_t)b * 16 + sc) * DM + cg * 256 + X.tid] = h; }
        __syncthreads();
    }
}
__device__ __forceinline__ void scan_b_phase(const Ctx& X, const unsigned* AU, const float* agp, const float* agh, const float* sagp, const float* sagh, const bf16* yg, bf16* hg) {
    for (int bi = blockIdx.x; bi < 256; bi += X.G) {
        const int b = bi >> 7, sc = (bi >> 3) & 15, cg = bi & 7, chunk = sc * 8 + X.wave, ch = cg * 256 + 4 * X.lane;
        const int chy = cg * 256 + (X.lane >> 3) * 32 + 8 * (X.lane & 3) + 4 * ((X.lane >> 2) & 1);
        const size_t row0 = (size_t)b * SEQ + chunk * 32;
        f32x4 h = {0.f, 0.f, 0.f, 0.f};
        {
            f32x4 pv[15], hv[15];
#pragma unroll
            for (int s = 0; s < 15; ++s) { const int ss = s < sc ? s : 0; pv[s] = *(const GAS f32x4*)(sagp + ((size_t)b * 16 + ss) * DM + ch); hv[s] = *(const GAS f32x4*)(sagh + ((size_t)b * 16 + ss) * DM + ch); }
#pragma unroll
            for (int s = 0; s < 15; ++s) if (s < sc) h = pv[s] * h + hv[s];
        }
        {
            f32x4 pv[7], hv[7];
#pragma unroll
            for (int w = 0; w < 7; ++w) { const int ww = w < X.wave ? w : 0; pv[w] = *(const GAS f32x4*)(agp + ((size_t)b * 128 + sc * 8 + ww) * DM + ch); hv[w] = *(const GAS f32x4*)(agh + ((size_t)b * 128 + sc * 8 + ww) * DM + ch); }
#pragma unroll
            for (int w = 0; w < 7; ++w) if (w < X.wave) h = pv[w] * h + hv[w];
        }
#pragma unroll 1
        for (int tb = 0; tb < 2; ++tb) {
            v4u wv[16]; v2u gv[16];
#pragma unroll
            for (int i = 0; i < 16; ++i) { const size_t o = (row0 + tb * 16 + i) * DM + ch; wv[i] = *(const GAS v4u*)(AU + o); gv[i] = *(const GAS v2u*)(yg + (row0 + tb * 16 + i) * DM + chy); }
#pragma unroll
            for (int i = 0; i < 16; ++i) { const f32x4 a = {__builtin_amdgcn_exp2f(bflo(wv[i].x)), __builtin_amdgcn_exp2f(bflo(wv[i].y)), __builtin_amdgcn_exp2f(bflo(wv[i].z)), __builtin_amdgcn_exp2f(bflo(wv[i].w))};
                const f32x4 u = {bfhi(wv[i].x), bfhi(wv[i].y), bfhi(wv[i].z), bfhi(wv[i].w)}; h = a * h + u;
                v2u o; o.x = pk2(h.x * bflo(gv[i].x), h.y * bfhi(gv[i].x)); o.y = pk2(h.z * bflo(gv[i].y), h.w * bfhi(gv[i].y));
                *(GAS v2u*)(hg + (row0 + tb * 16 + i) * DM + chy) = o; }
        }
    }
}

__device__ __forceinline__ void headnorm_phase(const Ctx& X, const bf16* oc, const float* lqk, const float* gsub, bf16* on) {
    float d01 = lqk[X.lane] * lqk[128 + X.lane] + lqk[64 + X.lane] * lqk[192 + X.lane];
    float d23 = lqk[256 + X.lane] * lqk[384 + X.lane] + lqk[320 + X.lane] * lqk[448 + X.lane];
    d01 = wave_sum(d01); d23 = wave_sum(d23);
    const float lam = expf(d01) - expf(d23) + LAM_INIT;
    const int l32 = X.lane & 31, hsel = X.lane >> 5;
    const f32x4 gs0 = *(const GAS f32x4*)(gsub + 8 * l32) * (1.0f - LAM_INIT), gs1 = *(const GAS f32x4*)(gsub + 8 * l32 + 4) * (1.0f - LAM_INIT);
    for (int w4 = X.gw; w4 < M / 4; w4 += X.NGW) {
#pragma unroll 1
        for (int rr = 0; rr < 4; ++rr) { const size_t row = (size_t)w4 * 4 + rr;
            v4u a0[4], a1[4];
#pragma unroll
            for (int hp = 0; hp < 4; ++hp) { const size_t o = row * 4096 + (size_t)(2 * hp + hsel) * 512 + 8 * l32; a0[hp] = *(const GAS v4u*)(oc + o); a1[hp] = *(const GAS v4u*)(oc + o + 256); }
#pragma unroll
            for (int hp = 0; hp < 4; ++hp) {
                f32x4 o0 = {bflo(a0[hp].x) - lam * bflo(a1[hp].x), bfhi(a0[hp].x) - lam * bfhi(a1[hp].x), bflo(a0[hp].y) - lam * bflo(a1[hp].y), bfhi(a0[hp].y) - lam * bfhi(a1[hp].y)};
                f32x4 o1 = {bflo(a0[hp].z) - lam * bflo(a1[hp].z), bfhi(a0[hp].z) - lam * bfhi(a1[hp].z), bflo(a0[hp].w) - lam * bflo(a1[hp].w), bfhi(a0[hp].w) - lam * bfhi(a1[hp].w)};
                float ss = ((o0.x * o0.x + o0.y * o0.y) + (o0.z * o0.z + o0.w * o0.w)) + ((o1.x * o1.x + o1.y * o1.y) + (o1.z * o1.z + o1.w * o1.w));
#pragma unroll
                for (int s = 1; s < 32; s <<= 1) ss += __shfl_xor(ss, s);
                const float rs = 1.0f / sqrtf(ss * (1.0f / VD) + NORM_EPS);
                o0 = o0 * rs * gs0; o1 = o1 * rs * gs1;
                v4u w; w.x = pk2(o0.x, o0.y); w.y = pk2(o0.z, o0.w); w.z = pk2(o1.x, o1.y); w.w = pk2(o1.z, o1.w);
                *(GAS v4u*)(on + row * DM + (size_t)(2 * hp + hsel) * VD + 8 * l32) = w; }
        }
    }
}

struct AttnItem { int bh, qb0, qb1; };
__device__ __forceinline__ AttnItem attn_decode(int L) { AttnItem it; it.bh = L >> 3; const int x = L & 7; it.qb0 = x; it.qb1 = 15 - x; return it; }
__device__ __forceinline__ attn::BlockRef<attn::bf16, attn::bf16> attn_ref(const AttnItem& it, int pass, const bf16* Q, const bf16* K, const bf16* V, bf16* O) {
    const int qb = pass ? it.qb1 : it.qb0, b = it.bh >> 5, vh = it.bh & 31, hd = vh >> 2, c = (vh >> 1) & 1, vhalf = vh & 1;
    attn::BlockRef<attn::bf16, attn::bf16> r;
    r.Q = (const attn::bf16*)(Q + ((size_t)b * SEQ + (size_t)qb * 256) * DM + hd * 256 + c * 128);
    r.K = (const attn::bf16*)(K + (size_t)b * SEQ * DM + hd * 256 + c * 128);
    r.V = (const attn::bf16*)(V + (size_t)b * SEQ * DM + hd * 256 + vhalf * 128);
    r.O = (attn::bf16*)(O + ((size_t)b * SEQ + (size_t)qb * 256) * 4096 + hd * 512 + c * 256 + vhalf * 128);
    r.P0 = qb * 256;
    return r;
}
__device__ __forceinline__ void attn_phase(const Ctx& X, const bf16* Q, const bf16* K, const bf16* V, bf16* O, char* lds) {
    constexpr int total = 512, W = 1 << 24;
    const int stride = X.G;
    int L = X.vcu; if (L >= total) return;
    AttnItem it = attn_decode(L); int pass = 0;
    attn::BlockRef<attn::bf16, attn::bf16> cur = attn_ref(it, 0, Q, K, V, O);
    attn::Seam<attn::bf16> S;
    attn::causal_swa_prime<attn::bf16, attn::bf16>(cur, W, lds, S);
    for (;;) {
        const bool more_pass = pass == 0 && it.qb1 != it.qb0, more_item = L + stride < total, last = !more_pass && !more_item;
        AttnItem itn = it; int passn = pass + 1, Ln = L;
        if (!more_pass) { passn = 0; Ln = more_item ? L + stride : L; itn = attn_decode(Ln); }
        const attn::BlockRef<attn::bf16, attn::bf16> nxt = last ? cur : attn_ref(itn, passn, Q, K, V, O);
        attn::causal_swa_block<attn::bf16, attn::bf16>(cur, nxt, SEQ, W, lds, S);
        if (last) break;
        cur = nxt; it = itn; pass = passn; L = Ln;
    }
}
struct Args { const float* in[24]; float* out; unsigned char* ws; int ph_lo, ph_hi; };
typedef const Args __attribute__((address_space(4)))* ArgP;
__device__ __forceinline__ Ctx make_ctx(LAS unsigned char* lds) {
    Ctx X; X.lds = lds; int t = threadIdx.x; asm volatile("" : "+v"(t));
    X.tid = t; X.lane = t & 63; X.wave = __builtin_amdgcn_readfirstlane(t >> 6);
    X.G = gridDim.x; { const int bx = blockIdx.x; X.vcu = (X.G % 8 == 0) ? (bx % 8) * (X.G / 8) + bx / 8 : bx; }
    X.gw = X.vcu * NWAVES + X.wave; X.NGW = X.G * NWAVES; return X;
}
__global__ void __launch_bounds__(NWAVES * 64, 2) trunk_fwd(Args args_by_value) {
    extern __shared__ __attribute__((aligned(16))) unsigned char lds[];
    LAS unsigned char* const ldsb = (LAS unsigned char*)lds;
    volatile LAS unsigned* MISC = (volatile LAS unsigned*)(ldsb + MISC_OFF);
    ArgP ap0 = (ArgP)__builtin_amdgcn_kernarg_segment_ptr();
    for (int u = threadIdx.x; u < (LDS_BYTES - LDSCTL_OFF) / 4; u += NWAVES * 64) ((LAS unsigned*)(ldsb + LDSCTL_OFF))[u] = 0u;
    __syncthreads();
    const int lo = ap0->ph_lo; int hi = ap0->ph_hi;
    XcdBarrier bar; bar.bar = (unsigned*)(ap0->ws + WS_CTL) + CW_BAR; bar.x = 0; bar.st = nullptr;
    if (!MK_PER_PHASE) bar = xcd_barrier_post((unsigned*)(ap0->ws + WS_CTL) + CW_BAR, MISC + 8);
#define GRID_BAR() do { if (!MK_PER_PHASE) xcd_barrier(bar); } while (0)
#ifndef PH_MASK
#define PH_MASK 0xFFFFFFFFu
#endif
#define IN(k) (((PH_MASK >> (k)) & 1u) && lo <= (k) && (k) < hi)
#define SEAM(k) do { if (lo <= (k) + 1 && (k) + 1 < hi) GRID_BAR(); } while (0)
#ifndef REP_MASK
#define REP_MASK 0u
#endif
#define PHASE(k, ...) if (IN(k)) { PH_BEGIN(k); __VA_ARGS__ } if (((REP_MASK >> (k)) & 1u) && IN(k)) { GRID_BAR(); { PH_BEGIN(k); __VA_ARGS__ } } if ((k) + 1 < NPH) SEAM(k);
#define PH_BEGIN(k) asm volatile("; ===PHASE " #k); const Ctx X = make_ctx(ldsb); ArgP ap = ap0; asm volatile("" : "+s"(ap)); InTab in = (InTab)ap; unsigned char* const ws = ap->ws; (void)in; (void)ws; (void)X
#define WSF(off) ((float*)(ws + (off)))
#define WSB(off) ((bf16*)(ws + (off)))
#define MODV(l, j, k) ((const float*)WSF(WS_MOD) + (size_t)(l) * NMOD + ((j) * 3 + (k)) * DM)
#define GAIN(l, i) (in[4] + ((l) * 6 + (i)) * DM)
#ifndef SWIGLU_SP2
#define SWIGLU_SP2 true
#endif
#define GEMM_SWIGLU(mi) do { pg8::Gemm g{WSB(WS_H), WSB(WS_WFIN) + (size_t)(mi) * 2 * DFF * DM, M, 2 * DFF, DM, DM, 0}; pg8::StaticOrder S; S.init(M, 2 * DFF, X.G, (int)blockIdx.x); \
        pg8::EpiSwiglu E{WSB(WS_ACT), DFF}; pg8::gemm_phase<pg8::EpiSwiglu, pg8::StaticOrder, true, SWIGLU_SP2>(X.lds + RING_OFF, g, S, E); } while (0)
#define GEMM_F32(Aop, Wt, Kdim) do { pg8::Gemm g{Aop, Wt, M, DM, Kdim, Kdim, 0}; pg8::StaticOrder S; S.init(M, DM, X.G, (int)blockIdx.x); \
        pg8::EpiF32 E{WSF(WS_Y), DM}; pg8::gemm_phase<pg8::EpiF32, pg8::StaticOrder, false>(X.lds + RING_OFF, g, S, E); } while (0)
#define NORM(xin_, y_, xout_, h1_, h2_, wgt_, gpost_, gate_, gpre1_, scale1_, shift1_, gpre2_, scale2_, shift2_) do { \
        NormArgs a{xin_, y_, xout_, h1_, h2_, wgt_, gpost_, gate_, gpre1_, scale1_, shift1_, gpre2_, scale2_, shift2_}; norm_phase(X, a); } while (0)

#define OFFP(p_, bo_) ((p_) ? (p_) + (bo_) : nullptr)
#define GEMM_NORM(bank, Aop, Wt, Kdim, xin_, xout_, h1_, h2_, wgt_, gpost_, gate_, gpre1_, scale1_, shift1_, gpre2_, scale2_, shift2_) do { \
        if (X.G == 256) { pg8::Gemm g{Aop, Wt, M, DM, Kdim, Kdim, 0}; pg8::StaticOrder S; S.init(M, DM, X.G, (int)blockIdx.x); \
            pg8::Unit u0; (void)S.next(0, u0); const size_t bo = (size_t)(u0.pm >> 4) * NMODT; \
            pg8::RowStats s1{WSF(WS_XSLOT) + (size_t)(2 * (bank)) * 65536, bar}; \
            pg8::RowStats s2{WSF(WS_XSLOT) + (size_t)(2 * (bank) + 1) * 65536, bar}; \
            pg8::EpiNorm E{xin_, xout_, h1_, h2_, wgt_, gpost_, (gate_) + bo, gpre1_, OFFP(scale1_, bo), OFFP(shift1_, bo), gpre2_, OFFP(scale2_, bo), OFFP(shift2_, bo), s1, s2}; \
            pg8::gemm_phase<pg8::EpiNorm, pg8::StaticOrder, false>(X.lds + RING_OFF, g, S, E); } \
        else { GEMM_F32(Aop, Wt, Kdim); GRID_BAR(); NORM(xin_, WSF(WS_Y), xout_, h1_, h2_, wgt_, gpost_, gate_, gpre1_, scale1_, shift1_, gpre2_, scale2_, shift2_); } } while (0)
#define NOF ((const float*)nullptr)
#define NOB ((bf16*)nullptr)

#ifdef PROBE_HI2
    for (int pass = 0; pass < 2; ++pass) { if (pass == 1) { GRID_BAR(); hi = PROBE_HI2; }
#endif
    PHASE(0, p0_prologue(X, in, ws);)
    PHASE(1, p1_modreduce(X, WSF(WS_MODP), in[3], in[18], WSF(WS_MOD), in[11], in[13], in[14], WSF(WS_GC));)
    PHASE(2, NORM(in[0], NOF, (float*)nullptr, WSB(WS_H), NOB, 0.f, NOF, NOF, GAIN(0, 0), MODV(0, 0, 1), MODV(0, 0, 0), NOF, NOF, NOF);)
    PHASE(3, GEMM_SWIGLU(0);)
    PHASE(4, GEMM_NORM(0, WSB(WS_ACT), WSB(WS_WFOUT) + (size_t)0 * DM * DFF, DFF, in[0], WSF(WS_XS), WSB(WS_H), NOB, 0.5f, GAIN(0, 1), MODV(0, 0, 2), GAIN(0, 2), MODV(0, 1, 1), MODV(0, 1, 0), NOF, NOF, NOF);)
    PHASE(5, pg8::Gemm g{WSB(WS_H), WSB(WS_WLIN), M, 2 * DM, DM, DM, 0}; pg8::StaticOrder S; S.init(M, 2 * DM, X.G, (int)blockIdx.x);
        pg8::EpiLruIn E{WSB(WS_YG), WSB(WS_XR), DM, DM / 256}; pg8::gemm_phase<pg8::EpiLruIn, pg8::StaticOrder, true>(X.lds + RING_OFF, g, S, E);)
    PHASE(6, conv_phase(X, WSB(WS_XR), in[8], in[9], WSB(WS_XRC));)
    PHASE(7, int kdim = LRUB; asm volatile("" : "+s"(kdim));
        pg8::Gemm g{WSB(WS_XRC), WSB(WS_WG), M, 2 * DM, kdim, DM, LRUB}; pg8::StaticOrder S; S.init(M, 2 * DM, X.G, (int)blockIdx.x);
        pg8::EpiGates E{WSB(WS_XRC), (unsigned*)(ws + WS_A), DM, WSF(WS_GC)}; pg8::gemm_phase<pg8::EpiGates, pg8::StaticOrder, true>(X.lds + RING_OFF, g, S, E);)
    PHASE(8, scan_a_phase(X, (const unsigned*)(ws + WS_A), WSF(WS_AGP), WSF(WS_AGH), WSF(WS_SAGP), WSF(WS_SAGH));)
    PHASE(9, scan_b_phase(X, (const unsigned*)(ws + WS_A), WSF(WS_AGP), WSF(WS_AGH), WSF(WS_SAGP), WSF(WS_SAGH), WSB(WS_YG), WSB(WS_HG));)
    PHASE(10, GEMM_NORM(1, WSB(WS_HG), WSB(WS_WLOUT), DM, WSF(WS_XS), WSF(WS_XS), WSB(WS_H), NOB, 1.0f, GAIN(0, 3), MODV(0, 1, 2), GAIN(0, 4), MODV(0, 2, 1), MODV(0, 2, 0), NOF, NOF, NOF);)
    PHASE(11, GEMM_SWIGLU(1);)
    PHASE(12, GEMM_NORM(2, WSB(WS_ACT), WSB(WS_WFOUT) + (size_t)1 * DM * DFF, DFF, WSF(WS_XS), WSF(WS_XS), WSB(WS_H), WSB(WS_HKV), 0.5f, GAIN(0, 5), MODV(0, 2, 2), GAIN(1, 0), MODV(1, 0, 1), MODV(1, 0, 0),
                        in[16], WSF(WS_MOD) + 2 * NMOD + DM, WSF(WS_MOD) + 2 * NMOD);)
    PHASE(13, { pg8::Gemm g{WSB(WS_HKV), WSB(WS_WKV), M, 2 * DM, DM, DM, 0}; pg8::StaticOrder S; S.init(M, 2 * DM, X.G, (int)blockIdx.x);
          pg8::EpiBf16 E{WSB(WS_K), DM, DM, (size_t)(WS_V - WS_K) / 2}; pg8::gemm_phase<pg8::EpiBf16, pg8::StaticOrder, true>(X.lds + RING_OFF, g, S, E); }
        GEMM_SWIGLU(2);)
    PHASE(14, GEMM_NORM(3, WSB(WS_ACT), WSB(WS_WFOUT) + (size_t)2 * DM * DFF, DFF, WSF(WS_XS), WSF(WS_XS), WSB(WS_H), NOB, 0.5f, GAIN(1, 1), MODV(1, 0, 2), GAIN(1, 2), MODV(1, 1, 1), MODV(1, 1, 0), NOF, NOF, NOF);)
    PHASE(15, pg8::Gemm g{WSB(WS_H), WSB(WS_WQ), M, DM, DM, DM, 0}; pg8::StaticOrder S; S.init(M, DM, X.G, (int)blockIdx.x);
        pg8::EpiBf16 E{WSB(WS_Q), DM, 0, 0}; pg8::gemm_phase<pg8::EpiBf16, pg8::StaticOrder, false>(X.lds + RING_OFF, g, S, E);)
    PHASE(16, attn_phase(X, WSB(WS_Q), WSB(WS_K), WSB(WS_V), WSB(WS_OC), (char*)lds + RING_OFF);)
    PHASE(17, headnorm_phase(X, WSB(WS_OC), in[21], in[22], WSB(WS_ON));)
    PHASE(18, GEMM_NORM(4, WSB(WS_ON), WSB(WS_WO), DM, WSF(WS_XS), WSF(WS_XS), WSB(WS_H), NOB, 1.0f, GAIN(1, 3), MODV(1, 1, 2), GAIN(1, 4), MODV(1, 2, 1), MODV(1, 2, 0), NOF, NOF, NOF);)
    PHASE(19, GEMM_SWIGLU(3);)
    PHASE(20, GEMM_NORM(5, WSB(WS_ACT), WSB(WS_WFOUT) + (size_t)3 * DM * DFF, DFF, WSF(WS_XS), ap->out, NOB, NOB, 0.5f, GAIN(1, 5), MODV(1, 2, 2), NOF, NOF, NOF, NOF, NOF, NOF);)
#ifdef PROBE_HI2
    }
#endif
#ifdef PROBE_EXTRA_BARRIERS
    for (int eb = 0; eb < PROBE_EXTRA_BARRIERS; ++eb) GRID_BAR();
#endif
#undef IN
#undef SEAM
#undef GRID_BAR
}

extern "C" void kernel_launch(void* const* d_in, const int* in_sizes, int n_in, void* d_out, int out_size, void* d_ws, size_t ws_size, hipStream_t stream) {
    static int grid = 0;
    if (grid == 0) {
        if (n_in != 24 || in_sizes[0] != M * DM || out_size != M * DM || ws_size < WS_END) { fprintf(stderr, "kernel_launch: unexpected shapes (n_in %d, in0 %d, out %d, ws %zu)\n", n_in, n_in > 0 ? in_sizes[0] : -1, out_size, ws_size); grid = -1; return; }
        int dev = 0, cus = 0, per_cu = 0;
        if (hipGetDevice(&dev) != hipSuccess || hipDeviceGetAttribute(&cus, hipDeviceAttributeMultiprocessorCount, dev) != hipSuccess) { fprintf(stderr, "kernel_launch: device query failed\n"); grid = -1; return; }
        if (hipFuncSetAttribute((const void*)trunk_fwd, hipFuncAttributeMaxDynamicSharedMemorySize, LDS_BYTES) != hipSuccess) { fprintf(stderr, "kernel_launch: hipFuncSetAttribute failed\n"); grid = -1; return; }
        if (hipOccupancyMaxActiveBlocksPerMultiprocessor(&per_cu, (const void*)trunk_fwd, NWAVES * 64, LDS_BYTES) != hipSuccess || per_cu < 1) { fprintf(stderr, "kernel_launch: occupancy query reports %d workgroups per CU\n", per_cu); }
        (void)hipGetLastError();
        grid = cus;
    }
    if (grid < 0) return;
    if (hipMemsetAsync((char*)d_ws + WS_CTL, 0, CTL_ZERO_BYTES, stream) != hipSuccess) { fprintf(stderr, "kernel_launch: hipMemsetAsync failed\n"); return; }
    Args a{};
    for (int i = 0; i < 24; ++i) a.in[i] = (const float*)d_in[i];
    a.out = (float*)d_out; a.ws = (unsigned char*)d_ws;
#if MK_PER_PHASE
    for (int p = 0; p <= MK_STOP_AFTER; ++p) { a.ph_lo = p; a.ph_hi = p + 1; hipLaunchKernelGGL(trunk_fwd, dim3(grid), dim3(NWAVES * 64), LDS_BYTES, stream, a); }
#else
    a.ph_lo = 0; a.ph_hi = MK_STOP_AFTER + 1;
    hipLaunchKernelGGL(trunk_fwd, dim3(grid), dim3(NWAVES * 64), LDS_BYTES, stream, a);
#endif
    const hipError_t le = hipPeekAtLastError();
    if (le != hipSuccess) fprintf(stderr, "kernel_launch: launch failed: %s\n", hipGetErrorName(le));
}
```

```cpp
#include <hip/hip_runtime.h>
#include <hip/hip_bf16.h>
#include <cstdio>
#include <cstdint>
#define MK_PER_PHASE 0
constexpr int NWAVES = 8;
constexpr int NPH = 21;
#ifndef MK_PER_PHASE
#define MK_PER_PHASE 0
#endif
#ifndef MK_STOP_AFTER
#define MK_STOP_AFTER (NPH - 1)
#endif

constexpr int BATCH = 2, SEQ = 4096, DM = 2048, M = BATCH * SEQ, DFF = 6144, NMOD = 18432, NMODT = 2 * NMOD + 4096;
constexpr int NH = 8, VD = 256, LRUB = 256;
constexpr float NORM_EPS = 1e-6f;
constexpr float LAM_INIT = 0.35550906759096315f;

constexpr size_t MiB = 1u << 20;
constexpr size_t WS_CTL = 0, CTL_ZERO_BYTES = 1 * MiB;
constexpr size_t WS_MODP = 2 * MiB, WS_MOD = 8 * MiB, WS_AGP = 9 * MiB, WS_AGH = 11 * MiB, WS_SAGP = 13 * MiB, WS_SAGH = 14 * MiB, WS_GC = 15 * MiB;
constexpr size_t WS_WG = 16 * MiB, WS_WLIN = 18 * MiB, WS_WLOUT = 34 * MiB, WS_WKV = 42 * MiB, WS_WQ = 58 * MiB, WS_WO = 66 * MiB;
constexpr size_t WS_WFIN = 74 * MiB, WS_WFOUT = 266 * MiB;
constexpr size_t WS_XS = 362 * MiB, WS_Y = 426 * MiB, WS_H = 490 * MiB, WS_HKV = 522 * MiB, WS_ACT = 554 * MiB;
constexpr size_t WS_YG = 650 * MiB, WS_XR = 682 * MiB, WS_XRC = 714 * MiB, WS_A = 746 * MiB, WS_U = 810 * MiB, WS_HG = 874 * MiB;
constexpr size_t WS_Q = 906 * MiB, WS_K = 938 * MiB, WS_V = 970 * MiB, WS_OC = 1002 * MiB, WS_ON = 1066 * MiB, WS_XSLOT = 1098 * MiB, WS_END = 1102 * MiB;
constexpr int CW_BAR = 4096, CW_XCNT = 16384;

constexpr int RING_OFF = 0, RING_BYTES = 151552;
constexpr int LDSCTL_OFF = RING_BYTES, MISC_OFF = LDSCTL_OFF + 320;
constexpr int LDS_BYTES = 155648;

#define GAS __attribute__((address_space(1)))
#define LAS __attribute__((address_space(3)))
typedef unsigned short bf16;
typedef unsigned v4u __attribute__((ext_vector_type(4)));
typedef unsigned v2u __attribute__((ext_vector_type(2)));
typedef float f32x4 __attribute__((ext_vector_type(4)));
#define LDS_WAIT() asm volatile("s_waitcnt lgkmcnt(0)" ::: "memory")
#define VM_WAIT() asm volatile("s_waitcnt vmcnt(0)" ::: "memory")
__device__ __forceinline__ unsigned f2bf(float f) { unsigned u = __builtin_bit_cast(unsigned, f); return (u + 0x7fffu + ((u >> 16) & 1u)) >> 16; }
__device__ __forceinline__ unsigned pk2(float lo, float hi) { return f2bf(lo) | (f2bf(hi) << 16); }
__device__ __forceinline__ float bflo(unsigned w) { return __uint_as_float(w << 16); }
__device__ __forceinline__ float bfhi(unsigned w) { return __uint_as_float(w & 0xffff0000u); }
__device__ __forceinline__ float wave_sum(float v) {
#pragma unroll
    for (int o = 1; o < 64; o <<= 1) v += __shfl_xor(v, o);
    return v;
}
__device__ __forceinline__ float silu_f(float v) { return v / (1.0f + __expf(-v)); }
#define XB_TMO      128
#define XB_XCNT(j)  (256  + 64 * (j))
#define XB_XSUB(j)  (1280 + 64 * (j))
#define XB_XGEN(j)  (2304 + 64 * (j))
#define XB_TOP      3328
#define XB_TOPGEN   3392
#define XCD_BAR_WORDS 3456
#define XB_SPIN_CAP (1u << 18)

__device__ __forceinline__ unsigned xb_ld(unsigned* p)              { return __hip_atomic_load(p, __ATOMIC_RELAXED, __HIP_MEMORY_SCOPE_AGENT); }
__device__ __forceinline__ unsigned xb_add(unsigned* p, unsigned v) { return __hip_atomic_fetch_add(p, v, __ATOMIC_RELAXED, __HIP_MEMORY_SCOPE_AGENT); }
__device__ __forceinline__ unsigned xb_xcc_id() { return (unsigned)__builtin_amdgcn_s_getreg((3 << 11) | 20) & 0xFu; }
#define XB_SPIN(cond, bar) do { unsigned _sp = 0; while (cond) { __builtin_amdgcn_s_sleep(1); \
    if ((++_sp & 255u) == 0u) { if (xb_ld(&(bar)[XB_TMO])) break; if (_sp > XB_SPIN_CAP) { atomicAdd(&(bar)[XB_TMO], 1u); break; } } } } while (0)

struct XcdBarrier {
    unsigned* bar; unsigned x;
    volatile LAS unsigned* st;
};

__device__ __forceinline__ XcdBarrier xcd_barrier_post(unsigned* bar, volatile LAS unsigned* st) {
    XcdBarrier b; b.bar = bar; b.x = xb_xcc_id(); b.st = st;
    if (threadIdx.x == 0) (void)xb_add(&bar[XB_XCNT(b.x)], 1u);
    return b;
}
__device__ __forceinline__ void xcd_barrier_complete(unsigned* bar, unsigned x, unsigned& nloc, unsigned& nx) {
    const unsigned G = gridDim.x * gridDim.y * gridDim.z;
    unsigned sum, cnt, mine, sp = 0u;
    for (;;) {
        sum = 0u; cnt = 0u; mine = 0u;
#pragma unroll
        for (unsigned j = 0; j < 16; ++j) { const unsigned c = xb_ld(&bar[XB_XCNT(j)]); sum += c; cnt += (c > 0u) ? 1u : 0u; mine = (j == x) ? c : mine; }
        if (sum == G) break;
        __builtin_amdgcn_s_sleep(1);
        if ((++sp & 255u) == 0u) { if (xb_ld(&bar[XB_TMO])) break; if (sp > XB_SPIN_CAP) { atomicAdd(&bar[XB_TMO], 1u); break; } }
    }
    nloc = mine > 0u ? mine : 1u; nx = cnt > 0u ? cnt : 1u;
}

__device__ __forceinline__ void xcd_barrier(const XcdBarrier& b) {
    asm volatile("s_waitcnt vmcnt(0)" ::: "memory");
    __syncthreads();
    if (threadIdx.x == 0) {
        unsigned* bar = b.bar;
        __builtin_amdgcn_s_waitcnt(0);
        unsigned nloc = b.st[0], nx = b.st[1];
        if (nloc == 0u) { xcd_barrier_complete(bar, b.x, nloc, nx); b.st[0] = nloc; b.st[1] = nx; }
        const unsigned old = xb_add(&bar[XB_XSUB(b.x)], 1u);
        const unsigned gen = old / nloc;
        if (old + 1u == (gen + 1u) * nloc) {
            __builtin_amdgcn_fence(__ATOMIC_RELEASE, "agent");
            asm volatile("s_waitcnt vmcnt(0)" ::: "memory");
            const unsigned og = xb_add(&bar[XB_TOP], 1u);
            const unsigned tg = og / nx;
            if (og + 1u == (tg + 1u) * nx) xb_add(&bar[XB_TOPGEN], 1u);
            else XB_SPIN(xb_ld(&bar[XB_TOPGEN]) == tg, bar);
            __builtin_amdgcn_fence(__ATOMIC_ACQUIRE, "agent");
            xb_add(&bar[XB_XGEN(b.x)], 1u);
            asm volatile("s_waitcnt vmcnt(0)" ::: "memory");
        } else {
            XB_SPIN(xb_ld(&bar[XB_XGEN(b.x)]) == gen, bar);
            __builtin_amdgcn_fence(__ATOMIC_ACQUIRE, "agent");
            asm volatile("s_waitcnt vmcnt(0)" ::: "memory");
        }
    }
    __syncthreads();
}
namespace pg8 {
#define PG8_LAS __attribute__((address_space(3)))
typedef unsigned short bf16_t;
typedef short bf16x8 __attribute__((ext_vector_type(8)));
typedef float f32x4 __attribute__((ext_vector_type(4)));
typedef float f32x2 __attribute__((ext_vector_type(2)));
typedef unsigned u32x4 __attribute__((ext_vector_type(4)));
constexpr int BM = 256, BK = 64, HALF = 128, HTB = HALF * BK * 2  , STAGE_BYTES = 8 * HTB, NXCD = 8, WGM = 8;

__host__ __device__ __forceinline__ int lds_byte(int r, int c) { const int st = (r >> 4) * 2 + (c >> 5), rr = r & 15, cc = c & 31, ob = rr * 64 + cc * 2; return st * 1024 + (ob ^ (((ob >> 9) & 1) << 5)); }
__host__ __device__ __forceinline__ void stage_rc(int b, int& R, int& C) { const int st = b / 1024, sb = b % 1024, swz = sb ^ (((sb >> 9) & 1) << 5); R = (st >> 1) * 16 + swz / 64; C = (st & 1) * 32 + (swz % 64) / 2; }
__host__ __device__ __forceinline__ int perm32(int rho) { const int n = rho >> 4, i = rho & 15; return 8 * (i >> 2) + 4 * n + (i & 3); }

struct Unit { int pm, pn; };
struct Gemm { const bf16_t* A; const bf16_t* Bt; int M, N, K, lda, agrp; };

struct StaticOrder {
    int nM, nN, nwg, G, c;
    __host__ __device__ __forceinline__ void init(int M, int N, int G_, int c_) { nM = M / BM; nN = N / BM; nwg = nM * nN; G = G_; c = c_; }
    __host__ __device__ __forceinline__ bool next(int i, Unit& u) const {
        const long L = (long)i * G + c; if (L >= nwg) return false;
        int wgid = (int)L; { const int q = nwg / NXCD, r = nwg % NXCD, xcd = wgid % NXCD, off = wgid / NXCD; wgid = (xcd < r ? xcd * (q + 1) : r * (q + 1) + (xcd - r) * q) + off; }
        const int nig = WGM * nN, gid = wgid / nig, fm = gid * WGM, gsz = (nM - fm) < WGM ? (nM - fm) : WGM;
        u.pm = fm + ((wgid % nig) % gsz); u.pn = (wgid % nig) / gsz; return true;
    }
    __device__ __forceinline__ void a_ready(const Unit&) const {}
    __device__ __forceinline__ void done(const Unit&) const {}
};

__device__ __forceinline__ unsigned cvt_pk_bf16(float lo, float hi) { unsigned r; asm volatile("v_cvt_pk_bf16_f32 %0, %1, %2" : "=v"(r) : "v"(lo), "v"(hi)); return r; }
__device__ __forceinline__ float bf_lo(unsigned w) { return __uint_as_float(w << 16); }
__device__ __forceinline__ float bf_hi(unsigned w) { return __uint_as_float(w & 0xffff0000u); }
__device__ __forceinline__ float sigmoidf_(float v) { return __builtin_amdgcn_rcpf(1.0f + __builtin_amdgcn_exp2f(-1.4426950408889634f * v)); }
__device__ __forceinline__ float siluf_(float v) { return v * sigmoidf_(v); }
__device__ __forceinline__ float gelu_tanh_(float v) { const float t = 1.5957691216057308f * (v + 0.044715f * v * v * v); return v * sigmoidf_(t); }

struct EpiF32 {
    static constexpr bool PERM = false, AFTER_DRAIN = false;
    float* C; int ldc;
    __device__ __forceinline__ void operator()(const f32x4 (&acc)[2][2][4][2], const Unit& u, int wr, int wc, int fr, int fq) const {
        const int row0 = u.pm * BM + wr * 64 + fr, col0 = u.pn * BM + wc * 32 + 4 * fq;
#pragma unroll
        for (int ai = 0; ai < 2; ++ai)
#pragma unroll
            for (int m = 0; m < 4; ++m) { float* rowp = C + (size_t)(row0 + ai * HALF + m * 16) * ldc + col0;
#pragma unroll
                for (int bj = 0; bj < 2; ++bj)
#pragma unroll
                    for (int n = 0; n < 2; ++n) *(f32x4*)(rowp + bj * HALF + n * 16) = acc[ai][bj][m][n]; }
    }
};
struct EpiBf16 {
    static constexpr bool PERM = true, AFTER_DRAIN = false;
    bf16_t* O; int ldc; int split_cols; size_t split_stride;
    __device__ __forceinline__ void operator()(const f32x4 (&acc)[2][2][4][2], const Unit& u, int wr, int wc, int fr, int fq) const {
        const int row0 = u.pm * BM + wr * 64 + fr; int colt = u.pn * BM; bf16_t* base = O;
        if (split_cols) { const int t = colt / split_cols; base += (size_t)t * split_stride; colt -= t * split_cols; }
        const int col0 = colt + wc * 32 + 8 * fq;
#pragma unroll
        for (int ai = 0; ai < 2; ++ai)
#pragma unroll
            for (int m = 0; m < 4; ++m) { bf16_t* rowp = base + (size_t)(row0 + ai * HALF + m * 16) * ldc + col0;
#pragma unroll
                for (int bj = 0; bj < 2; ++bj) { const f32x4 v0 = acc[ai][bj][m][0], v1 = acc[ai][bj][m][1];
                    u32x4 w; w.x = cvt_pk_bf16(v0[0], v0[1]); w.y = cvt_pk_bf16(v0[2], v0[3]); w.z = cvt_pk_bf16(v1[0], v1[1]); w.w = cvt_pk_bf16(v1[2], v1[3]);
                    *(u32x4*)(rowp + bj * HALF) = w; } }
    }
};
struct EpiHead {
    static constexpr bool PERM = true, AFTER_DRAIN = false;
    bf16_t* O0; bf16_t* O1; int hsplit; int seq;
    __device__ __forceinline__ void operator()(const f32x4 (&acc)[2][2][4][2], const Unit& u, int wr, int wc, int fr, int fq) const {
        const bool second = u.pn >= hsplit; bf16_t* base = second ? O1 : O0; const int head = second ? u.pn - hsplit : u.pn;
        const int row0 = u.pm * BM + wr * 64 + fr, d0 = wc * 32 + 8 * fq;
#pragma unroll
        for (int ai = 0; ai < 2; ++ai)
#pragma unroll
            for (int m = 0; m < 4; ++m) { const int r = row0 + ai * HALF + m * 16, b = r / seq, sidx = r - b * seq;
#pragma unroll
                for (int bj = 0; bj < 2; ++bj) { const f32x4 v0 = acc[ai][bj][m][0], v1 = acc[ai][bj][m][1];
                    u32x4 w; w.x = cvt_pk_bf16(v0[0], v0[1]); w.y = cvt_pk_bf16(v0[2], v0[3]); w.z = cvt_pk_bf16(v1[0], v1[1]); w.w = cvt_pk_bf16(v1[2], v1[3]);
                    *(u32x4*)(base + ((size_t)((b * 8 + head) * 2 + bj) * seq + sidx) * 128 + d0) = w; } }
    }
};
struct EpiSwiglu {
    static constexpr bool PERM = true, AFTER_DRAIN = false;
    bf16_t* O; int ldc;
    __device__ __forceinline__ void operator()(const f32x4 (&acc)[2][2][4][2], const Unit& u, int wr, int wc, int fr, int fq) const {
        const int row0 = u.pm * BM + wr * 64 + fr, col0 = u.pn * HALF + wc * 32 + 8 * fq;
#pragma unroll
        for (int ai = 0; ai < 2; ++ai)
#pragma unroll
            for (int m = 0; m < 4; ++m) { bf16_t* rowp = O + (size_t)(row0 + ai * HALF + m * 16) * ldc + col0;
                float o[8];
#pragma unroll
                for (int n = 0; n < 2; ++n)
#pragma unroll
                    for (int i = 0; i < 4; ++i) o[4 * n + i] = siluf_(acc[ai][0][m][n][i]) * acc[ai][1][m][n][i];
                u32x4 w; w.x = cvt_pk_bf16(o[0], o[1]); w.y = cvt_pk_bf16(o[2], o[3]); w.z = cvt_pk_bf16(o[4], o[5]); w.w = cvt_pk_bf16(o[6], o[7]);
                *(u32x4*)rowp = w; }
    }
};
struct EpiLruIn {
    static constexpr bool PERM = true, AFTER_DRAIN = false;
    bf16_t* O0; bf16_t* O1; int ldc; int nsplit;
    __device__ __forceinline__ void operator()(const f32x4 (&acc)[2][2][4][2], const Unit& u, int wr, int wc, int fr, int fq) const {
        const bool act = u.pn < nsplit; bf16_t* base = act ? O0 : O1;
        const int row0 = u.pm * BM + wr * 64 + fr, col0 = (act ? u.pn : u.pn - nsplit) * BM + wc * 32 + 8 * fq;
#pragma unroll
        for (int ai = 0; ai < 2; ++ai)
#pragma unroll
            for (int m = 0; m < 4; ++m) { bf16_t* rowp = base + (size_t)(row0 + ai * HALF + m * 16) * ldc + col0;
#pragma unroll
                for (int bj = 0; bj < 2; ++bj) { f32x4 v0 = acc[ai][bj][m][0], v1 = acc[ai][bj][m][1];
                    if (act) {
#pragma unroll
                        for (int i = 0; i < 4; ++i) { v0[i] = gelu_tanh_(v0[i]); v1[i] = gelu_tanh_(v1[i]); } }
                    u32x4 w; w.x = cvt_pk_bf16(v0[0], v0[1]); w.y = cvt_pk_bf16(v0[2], v0[3]); w.z = cvt_pk_bf16(v1[0], v1[1]); w.w = cvt_pk_bf16(v1[2], v1[3]);
                    *(u32x4*)(rowp + bj * HALF) = w; } }
    }
};
__device__ __forceinline__ float neg_expm1_(float z) {
    const float s = -z * (1.0f + z * (0.5f + z * (0.16666667f + z * (0.041666668f + z * (0.008333334f + z * 0.0013888889f)))));
    const float d = 1.0f - __builtin_amdgcn_exp2f(1.4426950408889634f * z);
    return z > -0.5f ? s : d;
}
struct EpiGates {
    static constexpr bool PERM = true, AFTER_DRAIN = false;
    const bf16_t* X; unsigned* AU; int ldc; const float* gc;
    __device__ __forceinline__ void operator()(const f32x4 (&acc)[2][2][4][2], const Unit& u, int wr, int wc, int fr, int fq) const {
        const int row0 = u.pm * BM + wr * 64 + fr, grp0 = (u.pn >> 1) * BM + (u.pn & 1) * HALF + wc * 32, ch0 = grp0 + 8 * fq;
        f32x4 ba[2], bx[2], sp8[2];
#pragma unroll
        for (int n = 0; n < 2; ++n) { ba[n] = *(const f32x4*)(gc + ch0 + 4 * n); bx[n] = *(const f32x4*)(gc + ldc + ch0 + 4 * n); sp8[n] = *(const f32x4*)(gc + 2 * ldc + ch0 + 4 * n); }
#pragma unroll
        for (int ai = 0; ai < 2; ++ai)
#pragma unroll
            for (int m = 0; m < 4; ++m) { const size_t rowoff = (size_t)(row0 + ai * HALF + m * 16) * ldc;
                const u32x4 xw = *(const u32x4*)(X + rowoff + ch0);
#pragma unroll
                for (int n = 0; n < 2; ++n) {
                    const unsigned w0 = n ? xw.z : xw.x, w1 = n ? xw.w : xw.y;
                    const f32x4 xv = {bf_lo(w0), bf_hi(w0), bf_lo(w1), bf_hi(w1)};
                    u32x4 pw;
#pragma unroll
                    for (int e = 0; e < 4; ++e) { const float r = sigmoidf_(acc[ai][0][m][n][e] + ba[n][e]), ig = sigmoidf_(acc[ai][1][m][n][e] + bx[n][e]), la = -sp8[n][e] * r;
                        pw[e] = cvt_pk_bf16(1.4426950408889634f * la, __builtin_sqrtf(neg_expm1_(2.0f * la)) * (ig * xv[e])); }
                    *(u32x4*)(AU + rowoff + grp0 + 16 * n + 4 * fq) = pw; }
                asm volatile("" ::: "memory"); }
    }
};
struct RowStats {
    float* slots; XcdBarrier bar;
    __device__ __forceinline__ void run(const f32x4 (&v)[2][2][4][2], const Unit& u, int wr, int wc, int fr, int fq, PG8_LAS unsigned char* lds, int wid, int lane) const {
        PG8_LAS float* P = (PG8_LAS float*)lds;
        PG8_LAS float* S = (PG8_LAS float*)(lds + 4096);
#pragma unroll
        for (int ai = 0; ai < 2; ++ai)
#pragma unroll
            for (int m = 0; m < 4; ++m) {
                float s = 0.f;
#pragma unroll
                for (int bj = 0; bj < 2; ++bj)
#pragma unroll
                    for (int n = 0; n < 2; ++n) { const f32x4 x = v[ai][bj][m][n]; s += (x[0] * x[0] + x[1] * x[1]) + (x[2] * x[2] + x[3] * x[3]); }
                s += __shfl_xor(s, 16); s += __shfl_xor(s, 32);
                if (fq == 0) P[(ai * HALF + wr * 64 + m * 16 + fr) * 4 + wc] = s;
            }
        asm volatile("s_waitcnt lgkmcnt(0)" ::: "memory"); __builtin_amdgcn_s_barrier(); asm volatile("" ::: "memory");
        const int row = wid * 32 + (lane & 31);
        if (lane < 32) slots[(size_t)(u.pm * BM + row) * 8 + u.pn] = (P[row * 4 + 0] + P[row * 4 + 1]) + (P[row * 4 + 2] + P[row * 4 + 3]);
        xcd_barrier(bar);
        if (lane < 32) {
            const f32x4 s0 = *(const f32x4*)(slots + (size_t)(u.pm * BM + row) * 8), s1 = *(const f32x4*)(slots + (size_t)(u.pm * BM + row) * 8 + 4);
            const float tot = ((s0[0] + s0[1]) + (s0[2] + s0[3])) + ((s1[0] + s1[1]) + (s1[2] + s1[3]));
            S[row] = 1.0f / __builtin_sqrtf(tot * (1.0f / 2048.0f) + 1e-6f);
        }
        asm volatile("s_waitcnt vmcnt(0) lgkmcnt(0)" ::: "memory"); __builtin_amdgcn_s_barrier(); asm volatile("" ::: "memory");
    }
};
typedef unsigned u32x2v __attribute__((ext_vector_type(2)));
__device__ __forceinline__ void store_h8(bf16_t* p  , const u32x2v (&w)[2], int fq) {
    const bool odd = (fq & 1) != 0;
    const u32x2v snd = odd ? w[0] : w[1]; u32x2v rcv; rcv.x = (unsigned)__shfl_xor((int)snd.x, 16); rcv.y = (unsigned)__shfl_xor((int)snd.y, 16);
    u32x4 o; if (odd) { o.x = rcv.x; o.y = rcv.y; o.z = w[1].x; o.w = w[1].y; } else { o.x = w[0].x; o.y = w[0].y; o.z = rcv.x; o.w = rcv.y; }
    *(u32x4*)(p + (odd ? 12 : 0)) = o;
}
struct EpiNorm {
    static constexpr bool PERM = false, AFTER_DRAIN = true;
    const float* xin; float* xout; bf16_t* h1; bf16_t* h2; float wgt;
    const float *gpost, *gate, *gpre1, *scale1, *shift1, *gpre2, *scale2, *shift2;
    RowStats st1, st2;
    __device__ __forceinline__ void fused(f32x4 (&acc)[2][2][4][2], const Unit& u, int wr, int wc, int fr, int fq, PG8_LAS unsigned char* lds, int wid, int lane) const {
        const PG8_LAS float* S = (const PG8_LAS float*)(lds + 4096);
        const int col0 = u.pn * BM + wc * 32 + 4 * fq;
        f32x4 pre[4][2][2];
#pragma unroll
        for (int m = 0; m < 4; ++m) { const size_t off = (size_t)(u.pm * BM + wr * 64 + m * 16 + fr) * 2048 + col0;
#pragma unroll
            for (int bj = 0; bj < 2; ++bj)
#pragma unroll
                for (int n = 0; n < 2; ++n) pre[m][bj][n] = *(const f32x4*)(xin + off + bj * HALF + n * 16); }
        st1.run(acc, u, wr, wc, fr, fq, lds, wid, lane);
        {
            f32x4 ca[2][2];
#pragma unroll
            for (int bj = 0; bj < 2; ++bj)
#pragma unroll
                for (int n = 0; n < 2; ++n) ca[bj][n] = *(const f32x4*)(gate + col0 + bj * HALF + n * 16) * *(const f32x4*)(gpost + col0 + bj * HALF + n * 16) * wgt;
#pragma unroll
            for (int ai = 0; ai < 2; ++ai)
#pragma unroll
                for (int m = 0; m < 4; ++m) { const int r = ai * HALF + wr * 64 + m * 16 + fr; const float rs = S[r]; const size_t off = (size_t)(u.pm * BM + r) * 2048 + col0;
#pragma unroll
                    for (int bj = 0; bj < 2; ++bj)
#pragma unroll
                        for (int n = 0; n < 2; ++n) { const f32x4 bs = ai == 0 ? pre[m][bj][n] : *(const f32x4*)(xin + off + bj * HALF + n * 16); acc[ai][bj][m][n] = bs + ca[bj][n] * (acc[ai][bj][m][n] * rs); }
                    asm volatile("" : "+v"(acc[ai][0][m][0]), "+v"(acc[ai][0][m][1]), "+v"(acc[ai][1][m][0]), "+v"(acc[ai][1][m][1]));
                    if (m & 1) asm volatile("" ::: "memory"); }
        }
        if (h1 == nullptr && h2 == nullptr) {
#pragma unroll
            for (int ai = 0; ai < 2; ++ai)
#pragma unroll
                for (int m = 0; m < 4; ++m) { const int r = ai * HALF + wr * 64 + m * 16 + fr; const size_t off = (size_t)(u.pm * BM + r) * 2048 + col0;
#pragma unroll
                    for (int bj = 0; bj < 2; ++bj)
#pragma unroll
                        for (int n = 0; n < 2; ++n) *(f32x4*)(xout + off + bj * HALF + n * 16) = acc[ai][bj][m][n]; }
            return;
        }
        st2.run(acc, u, wr, wc, fr, fq, lds, wid, lane);
        {
            f32x4 cb[2][2], cc[2][2];
#pragma unroll
            for (int bj = 0; bj < 2; ++bj)
#pragma unroll
                for (int n = 0; n < 2; ++n) { cb[bj][n] = *(const f32x4*)(gpre1 + col0 + bj * HALF + n * 16) * (*(const f32x4*)(scale1 + col0 + bj * HALF + n * 16) + 1.0f); cc[bj][n] = *(const f32x4*)(shift1 + col0 + bj * HALF + n * 16); }
#pragma unroll
            for (int ai = 0; ai < 2; ++ai)
#pragma unroll
                for (int m = 0; m < 4; ++m) { const int r = ai * HALF + wr * 64 + m * 16 + fr; const float rs = S[r]; const size_t off = (size_t)(u.pm * BM + r) * 2048 + col0;
#pragma unroll
                    for (int bj = 0; bj < 2; ++bj) { u32x2v w[2];
#pragma unroll
                        for (int n = 0; n < 2; ++n) { const f32x4 x1 = acc[ai][bj][m][n]; *(f32x4*)(xout + off + bj * HALF + n * 16) = x1;
                            const f32x4 o = (x1 * rs) * cb[bj][n] + cc[bj][n]; w[n].x = cvt_pk_bf16(o[0], o[1]); w[n].y = cvt_pk_bf16(o[2], o[3]); }
                        store_h8(h1 + off + bj * HALF, w, fq); }
                    asm volatile("" ::: "memory"); }
        }
        if (h2 != nullptr) {
            f32x4 cb[2][2], cc[2][2];
#pragma unroll
            for (int bj = 0; bj < 2; ++bj)
#pragma unroll
                for (int n = 0; n < 2; ++n) { cb[bj][n] = *(const f32x4*)(gpre2 + col0 + bj * HALF + n * 16) * (*(const f32x4*)(scale2 + col0 + bj * HALF + n * 16) + 1.0f); cc[bj][n] = *(const f32x4*)(shift2 + col0 + bj * HALF + n * 16); }
#pragma unroll
            for (int ai = 0; ai < 2; ++ai)
#pragma unroll
                for (int m = 0; m < 4; ++m) { const int r = ai * HALF + wr * 64 + m * 16 + fr; const float rs = S[r]; const size_t off = (size_t)(u.pm * BM + r) * 2048 + col0;
#pragma unroll
                    for (int bj = 0; bj < 2; ++bj) { u32x2v w[2];
#pragma unroll
                        for (int n = 0; n < 2; ++n) { const f32x4 o = (acc[ai][bj][m][n] * rs) * cb[bj][n] + cc[bj][n]; w[n].x = cvt_pk_bf16(o[0], o[1]); w[n].y = cvt_pk_bf16(o[2], o[3]); }
                        store_h8(h2 + off + bj * HALF, w, fq); }
                    asm volatile("" ::: "memory"); }
        }
    }
};
template <class Epi, class Sched, bool ALIGN_EPI, bool SP2 = true>
__device__ __forceinline__ void gemm_phase(PG8_LAS unsigned char* lds, const Gemm g, const Sched& S, const Epi& E) {
    int tid = threadIdx.x; asm volatile("" : "+v"(tid)); const int wid = __builtin_amdgcn_readfirstlane(tid >> 6), lane = tid & 63, wr = wid >> 2, wc = wid & 3, fr = lane & 15, fq = lane >> 4;
    const int K = g.K, nt = K / BK, lda = g.lda;
    unsigned voffA[2], voffB[2];
#pragma unroll
    for (int i = 0; i < 2; ++i) { int R, C; stage_rc(tid * 16 + i * 8192, R, C); const int Rb = Epi::PERM ? ((R & ~31) + perm32(R & 31)) : R;
        voffA[i] = (unsigned)(R * lda + C) * 2u; voffB[i] = (unsigned)(Rb * BK + C) * 2u; }
    const size_t kstep = (size_t)(BK * 2), kstepB = (size_t)BM * BK * 2;
    const size_t hstepA = (size_t)HALF * lda * 2, hstepB = (size_t)HALF * BK * 2;
    const size_t tstepA = 2 * hstepA, tstepB = (size_t)BM * K * 2;
    const unsigned ldsw = (unsigned)wid * 1024u;
    const int aoff = lds_byte(wr * 64 + fr, fq * 8), boff = lds_byte(wc * 32 + fr, fq * 8);
#define PG8_SA(b, h) (((b) * 2 + (h)) * HTB)
#define PG8_SB(b, h) ((4 + (b) * 2 + (h)) * HTB)
#define PG8_STAGE(bufoff, gbase, voff) do { _Pragma("unroll") for (int _i = 0; _i < 2; ++_i) \
        __builtin_amdgcn_global_load_lds((const unsigned*)((const char*)(gbase) + (voff)[_i]), (PG8_LAS unsigned*)(lds + (bufoff) + ldsw + _i * 8192), 16, 0, 0); } while (0)
#define PG8_LDA(dst, b, h) do { _Pragma("unroll") for (int m = 0; m < 4; ++m) _Pragma("unroll") for (int k = 0; k < 2; ++k) dst[m][k] = *(const PG8_LAS bf16x8*)(lds + PG8_SA(b, h) + aoff + m * 2048 + k * 1024); } while (0)
#define PG8_LDB(dst, b, h) do { _Pragma("unroll") for (int n = 0; n < 2; ++n) _Pragma("unroll") for (int k = 0; k < 2; ++k) dst[n][k] = *(const PG8_LAS bf16x8*)(lds + PG8_SB(b, h) + boff + n * 2048 + k * 1024); } while (0)
#define PG8_MMA(ai, bj, At, Bt) do { __builtin_amdgcn_s_setprio(1); _Pragma("unroll") for (int m = 0; m < 4; ++m) _Pragma("unroll") for (int n = 0; n < 2; ++n) _Pragma("unroll") for (int k = 0; k < 2; ++k) \
        acc[ai][bj][m][n] = __builtin_amdgcn_mfma_f32_16x16x32_bf16(Bt[n][k], At[m][k], acc[ai][bj][m][n], 0, 0, 0); __builtin_amdgcn_s_setprio(0); } while (0)
#define PG8_WAIT_V(n) asm volatile("s_waitcnt vmcnt(" #n ")" ::: "memory")
#define PG8_WAIT_L(n) asm volatile("s_waitcnt lgkmcnt(" #n ")" ::: "memory")
#define PG8_BAR __builtin_amdgcn_s_barrier()
#define PG8_SCHED __builtin_amdgcn_sched_barrier(0)
#define PG8_APTR(u_) ((const char*)g.A + (size_t)(u_).pm * tstepA + (size_t)(((u_).pn >> 1) * g.agrp) * 2)
#define PG8_BPTR(u_) ((const char*)g.Bt + (size_t)(u_).pn * tstepB)
    Unit cur, nxt; int ui = 0;
    if (!S.next(0, cur)) return;
    f32x4 acc[2][2][4][2];
#pragma unroll
    for (int a = 0; a < 2; ++a)
#pragma unroll
        for (int b = 0; b < 2; ++b)
#pragma unroll
            for (int m = 0; m < 4; ++m)
#pragma unroll
                for (int n = 0; n < 2; ++n) acc[a][b][m][n] = (f32x4){0.f, 0.f, 0.f, 0.f};
    bf16x8 At[4][2], B0[2][2], B1[2][2];
    const char* cA = PG8_APTR(cur); const char* cB = PG8_BPTR(cur);
    S.a_ready(cur);
    if constexpr (SP2) {
    PG8_STAGE(PG8_SB(0, 0), cB, voffB); PG8_STAGE(PG8_SB(0, 1), cB + hstepB, voffB); PG8_STAGE(PG8_SA(0, 0), cA, voffA); PG8_STAGE(PG8_SA(0, 1), cA + hstepA, voffA);
    if (wr == 1) PG8_BAR;
    PG8_WAIT_V(2); PG8_BAR;
    } else {
    PG8_STAGE(PG8_SB(0, 0), cB, voffB); PG8_STAGE(PG8_SA(0, 0), cA, voffA); PG8_STAGE(PG8_SB(0, 1), cB + hstepB, voffB); PG8_STAGE(PG8_SA(0, 1), cA + hstepA, voffA);
    if (wr == 1) PG8_BAR;
    PG8_WAIT_V(4); PG8_BAR;
    }
    PG8_STAGE(PG8_SB(1, 0), cB + kstepB, voffB); PG8_STAGE(PG8_SA(1, 0), cA + kstep, voffA); PG8_STAGE(PG8_SB(1, 1), cB + hstepB + kstepB, voffB);
    PG8_WAIT_V(6); PG8_BAR;
    for (;;) {
        const bool has_next = S.next(ui + 1, nxt);
        const char* nA = has_next ? PG8_APTR(nxt) : cA; const char* nB = has_next ? PG8_BPTR(nxt) : cB;
        for (int t = 0; t < nt; t += 2) {
            const bool last = (t == nt - 2);
            const char* a1 = cA + (size_t)(t + 1) * kstep;
            const char* a2 = last ? nA : cA + (size_t)(t + 2) * kstep; const char* b2 = last ? nB : cB + (size_t)(t + 2) * kstepB;
            const char* a3 = a2 + kstep; const char* b3 = b2 + kstepB;
            if (last && has_next) S.a_ready(nxt);
            if constexpr (SP2) {
            PG8_LDB(B0, 0, 0); PG8_LDB(B1, 0, 1); PG8_SCHED; PG8_LDA(At, 0, 0); PG8_STAGE(PG8_SA(1, 1), a1 + hstepA, voffA);
            PG8_WAIT_V(8); PG8_WAIT_L(0); PG8_BAR; PG8_MMA(0, 0, At, B0); PG8_MMA(0, 1, At, B1); PG8_BAR; PG8_SCHED;
            PG8_LDA(At, 0, 1); PG8_STAGE(PG8_SB(0, 0), b2, voffB); PG8_STAGE(PG8_SB(0, 1), b2 + hstepB, voffB); PG8_STAGE(PG8_SA(0, 0), a2, voffA);
            PG8_WAIT_V(8); PG8_WAIT_L(0); PG8_BAR; PG8_MMA(1, 0, At, B0); PG8_MMA(1, 1, At, B1); PG8_BAR; PG8_SCHED;
            PG8_LDB(B0, 1, 0); PG8_LDB(B1, 1, 1); PG8_SCHED; PG8_LDA(At, 1, 0); PG8_STAGE(PG8_SA(0, 1), a2 + hstepA, voffA);
            PG8_WAIT_V(8); PG8_WAIT_L(0); PG8_BAR; PG8_MMA(0, 0, At, B0); PG8_MMA(0, 1, At, B1); PG8_BAR; PG8_SCHED;
            PG8_LDA(At, 1, 1); PG8_STAGE(PG8_SB(1, 0), b3, voffB); PG8_STAGE(PG8_SB(1, 1), b3 + hstepB, voffB); PG8_STAGE(PG8_SA(1, 0), a3, voffA);
            PG8_WAIT_V(8); PG8_WAIT_L(0); PG8_BAR; PG8_MMA(1, 0, At, B0); PG8_MMA(1, 1, At, B1); PG8_BAR; PG8_SCHED;
            } else {
            PG8_LDB(B0, 0, 0); PG8_SCHED; PG8_LDA(At, 0, 0); PG8_STAGE(PG8_SA(1, 1), a1 + hstepA, voffA);
            PG8_WAIT_L(8); PG8_BAR; PG8_WAIT_L(0); PG8_MMA(0, 0, At, B0); PG8_BAR; PG8_SCHED;
            PG8_LDB(B1, 0, 1); PG8_STAGE(PG8_SB(0, 0), b2, voffB);
            PG8_BAR; PG8_WAIT_L(0); PG8_MMA(0, 1, At, B1); PG8_BAR;
            PG8_LDA(At, 0, 1); PG8_STAGE(PG8_SA(0, 0), a2, voffA);
            PG8_BAR; PG8_WAIT_L(0); PG8_MMA(1, 0, At, B0); PG8_BAR; PG8_SCHED;
            PG8_STAGE(PG8_SB(0, 1), b2 + hstepB, voffB);
            PG8_WAIT_V(6); PG8_BAR; PG8_MMA(1, 1, At, B1); PG8_BAR;
            PG8_LDB(B0, 1, 0); PG8_SCHED; PG8_LDA(At, 1, 0); PG8_STAGE(PG8_SA(0, 1), a2 + hstepA, voffA);
            PG8_WAIT_L(8); PG8_BAR; PG8_WAIT_L(0); PG8_MMA(0, 0, At, B0); PG8_BAR; PG8_SCHED;
            PG8_LDB(B1, 1, 1); PG8_STAGE(PG8_SB(1, 0), b3, voffB);
            PG8_BAR; PG8_WAIT_L(0); PG8_MMA(0, 1, At, B1); PG8_BAR;
            PG8_LDA(At, 1, 1); PG8_STAGE(PG8_SA(1, 0), a3, voffA);
            PG8_BAR; PG8_WAIT_L(0); PG8_MMA(1, 0, At, B0); PG8_BAR; PG8_SCHED;
            PG8_STAGE(PG8_SB(1, 1), b3 + hstepB, voffB);
            PG8_WAIT_V(6); PG8_BAR; PG8_MMA(1, 1, At, B1); PG8_BAR;
            }
        }
        if constexpr (ALIGN_EPI) { if (wr == 0) PG8_BAR; }
        if constexpr (!Epi::AFTER_DRAIN) { E(acc, cur, wr, wc, fr, fq); S.done(cur); }
        if (!has_next) break;
#pragma unroll
        for (int a = 0; a < 2; ++a)
#pragma unroll
            for (int b = 0; b < 2; ++b)
#pragma unroll
                for (int m = 0; m < 4; ++m)
#pragma unroll
                    for (int n = 0; n < 2; ++n) acc[a][b][m][n] = (f32x4){0.f, 0.f, 0.f, 0.f};
        cur = nxt; cA = nA; cB = nB; ++ui;
        if constexpr (ALIGN_EPI) { if (wr == 1) PG8_BAR; }
    }
    PG8_WAIT_V(0);
    if constexpr (!ALIGN_EPI) { if (wr == 0) PG8_BAR; }
    PG8_BAR;
    if constexpr (Epi::AFTER_DRAIN) { E.fused(acc, cur, wr, wc, fr, fq, lds, wid, lane); S.done(cur); }
#undef PG8_SA
#undef PG8_SB
#undef PG8_STAGE
#undef PG8_LDA
#undef PG8_LDB
#undef PG8_MMA
#undef PG8_WAIT_V
#undef PG8_WAIT_L
#undef PG8_BAR
#undef PG8_SCHED
#undef PG8_APTR
#undef PG8_BPTR
}
}
namespace attn {
using bf16 = __hip_bfloat16;
typedef short bf16x8 __attribute__((ext_vector_type(8)));
typedef short s16x4 __attribute__((ext_vector_type(4)));
typedef float f32x16 __attribute__((ext_vector_type(16)));
typedef float f32x4 __attribute__((ext_vector_type(4)));
typedef unsigned u32x4 __attribute__((ext_vector_type(4)));
template <class A, class Bt> struct same_t { static constexpr bool v = false; };
template <class A> struct same_t<A, A> { static constexpr bool v = true; };
constexpr int D = 128;
constexpr int QP = 128, KVP = 128, OP = 4096;
constexpr int CHUNKM1 = 63;
constexpr float THR = 8.f;
constexpr bool WSKIP = true;
constexpr float SCALE = 0.08838834764831845f;
constexpr int NW = 8, QBLK = 32, KVBLK = 64, QB = NW * QBLK;
constexpr int SHM_V = KVBLK * D * 2, SHM_K = KVBLK * D * 2;
constexpr int NVS = 3;
constexpr int LDS_BYTES = NVS * SHM_V + 2 * SHM_K + NW * 64 * 4;
#define KSWZ(row, colB) ((row) * 256 + ((colB) ^ (((row) & 7) << 4)))
#define SBAR() __builtin_amdgcn_sched_barrier(0)
__device__ __forceinline__ int v_st(int k, int c) { const int kk = (k & ~0xC) | ((k & 4) << 1) | ((k & 8) >> 1); return ((kk >> 3) * 4 + (c >> 5)) * 512 + ((kk & 7) * 32 + (c & 31)) * 2; }
__device__ __forceinline__ int v_rd_base(int lane) { return ((lane & 3) << 3) | (((lane >> 2) & 3) << 6) | (((lane >> 4) & 1) << 5) | (((lane >> 5) & 1) << 8); }
constexpr int v_rd_off(int d0, int ks, int half) { return d0 * 512 + ks * 4096 + half * 2048; }
__device__ __forceinline__ int crow(int r, int hi) { return (r & 3) + 8 * (r >> 2) + 4 * hi; }
__device__ __forceinline__ unsigned cvtpk(float lo, float hi) {
    unsigned r; asm volatile("v_cvt_pk_bf16_f32 %0, %1, %2" : "=v"(r) : "v"(lo), "v"(hi)); return r;
}
__device__ __forceinline__ bf16x8 pack8(f32x4 a, f32x4 b) {
    u32x4 w = {cvtpk(a[0], a[1]), cvtpk(a[2], a[3]), cvtpk(b[0], b[1]), cvtpk(b[2], b[3])};
    return *reinterpret_cast<bf16x8*>(&w);
}
template <class T> __device__ __forceinline__ bf16x8 load8(const T* p) {
    if constexpr (same_t<T, float>::v) { return pack8(*(const f32x4*)p, *(const f32x4*)(p + 4)); }
    else { return *reinterpret_cast<const bf16x8*>(p); }
}
__device__ __forceinline__ void mask_tile(f32x16& p0, f32x16& p1, int dq, unsigned W) {
    const float NEG = -__builtin_inff();
#pragma unroll
    for (int r = 0; r < 16; ++r) {
        const int c = (r & 3) + 8 * (r >> 2);
        if ((unsigned)(dq - c) >= W) p0[r] = NEG;
        if ((unsigned)(dq - c - 32) >= W) p1[r] = NEG;
    }
}
__device__ __forceinline__ void partialSM(f32x16& p0, f32x16& p1, float& m_reg, float& mn, float& alpha) {
    float pmax = p0[0]; for (int r = 1; r < 16; ++r) pmax = fmaxf(pmax, p0[r]); for (int r = 0; r < 16; ++r) pmax = fmaxf(pmax, p1[r]);
    { auto rr = __builtin_amdgcn_permlane32_swap(__float_as_uint(pmax), __float_as_uint(pmax), false, false);
      pmax = fmaxf(__uint_as_float(rr[0]), __uint_as_float(rr[1])); }
    constexpr float C2 = 1.4426950408889634f * SCALE;
    if (__builtin_expect(__all((pmax - m_reg) * SCALE <= THR), 1)) { mn = m_reg; alpha = 1.f; }
    else { mn = fmaxf(m_reg, pmax); alpha = __builtin_amdgcn_exp2f((m_reg - mn) * C2); m_reg = mn; }
    const float mnL = -mn * C2;
    for (int r = 0; r < 16; ++r) p0[r] = fmaf(p0[r], C2, mnL); for (int r = 0; r < 16; ++r) p1[r] = fmaf(p1[r], C2, mnL);
    for (int r = 0; r < 16; ++r) p0[r] = __builtin_amdgcn_exp2f(p0[r]);
}
__device__ __forceinline__ void finishSM(f32x16& p0, f32x16& p1, float alpha, float& l_reg, bf16x8& pa0, bf16x8& pa1, bf16x8& pa2, bf16x8& pa3) {
    for (int r = 0; r < 16; ++r) p1[r] = __builtin_amdgcn_exp2f(p1[r]);
    float ps = 0; for (int r = 0; r < 16; ++r) ps += p0[r]; for (int r = 0; r < 16; ++r) ps += p1[r];
    { auto rr = __builtin_amdgcn_permlane32_swap(__float_as_uint(ps), __float_as_uint(ps), false, false);
      ps = __uint_as_float(rr[0]) + __uint_as_float(rr[1]); }
    l_reg = l_reg * alpha + ps;
#define PK4(P, B_, OUT) do { unsigned a0 = cvtpk(P[B_+0], P[B_+1]), a1 = cvtpk(P[B_+2], P[B_+3]);                          \
        unsigned b0 = cvtpk(P[B_+4], P[B_+5]), b1 = cvtpk(P[B_+6], P[B_+7]);                                             \
        auto r0 = __builtin_amdgcn_permlane32_swap(a0, b0, false, false); auto r1 = __builtin_amdgcn_permlane32_swap(a1, b1, false, false); \
        u32x4 w = {r0[0], r1[0], r0[1], r1[1]}; OUT = *reinterpret_cast<bf16x8*>(&w); } while (0)
    PK4(p0, 0, pa0); PK4(p0, 8, pa1); PK4(p1, 0, pa2); PK4(p1, 8, pa3);
#undef PK4
}
template <int KB, bool SK>
__device__ __forceinline__ void qkt(f32x16& p0, f32x16& p1, const char* K_lds, int r32, int hi, const bf16x8* qr, bool act) {
    if (SK && !act) { const float NEG = -__builtin_inff();
#pragma unroll
        for (int r = 0; r < 16; ++r) { p0[r] = NEG; p1[r] = NEG; } return; }
    p0 = f32x16{}; p1 = f32x16{};
    const char* kb[4];
#pragma unroll
    for (int dd = 0; dd < 4; ++dd) kb[dd] = K_lds + KB * SHM_K + KSWZ(r32, (dd * 16 + hi * 8) * 2);
#pragma unroll
    for (int d0 = 0; d0 < 8; ++d0) { const char* a = kb[d0 & 3] + (d0 >> 2) * 128;
        bf16x8 b0 = *reinterpret_cast<const bf16x8*>(a);
        bf16x8 b1 = *reinterpret_cast<const bf16x8*>(a + 32 * 256);
        p0 = __builtin_amdgcn_mfma_f32_32x32x16_bf16(b0, qr[d0], p0, 0, 0, 0);
        p1 = __builtin_amdgcn_mfma_f32_32x32x16_bf16(b1, qr[d0], p1, 0, 0, 0); }
}
template <int VB, bool SK>
__device__ __forceinline__ void pv_tile(f32x16* o, int vb0, bf16x8 pa0, bf16x8 pa1, bf16x8 pa2, bf16x8 pa3, bool act) {
    if (SK && !act) return;
#define TRRD(dst, off) asm volatile("ds_read_b64_tr_b16 %0, %1 offset:%2" : "=&v"(dst) : "v"(vb0), "i"(off) : "memory")
#define PV_D0(d0) do { s16x4 l0, l1, l2, l3, h0, h1, h2, h3; constexpr int b_ = VB * SHM_V + v_rd_off(d0, 0, 0);     \
        TRRD(l0, b_); TRRD(h0, b_ + 2048); TRRD(l1, b_ + 4096); TRRD(h1, b_ + 6144); TRRD(l2, b_ + 8192); TRRD(h2, b_ + 10240); TRRD(l3, b_ + 12288); TRRD(h3, b_ + 14336); \
        asm volatile("s_waitcnt lgkmcnt(0)" ::: "memory"); SBAR();                 \
        o[d0] = __builtin_amdgcn_mfma_f32_32x32x16_bf16(pa0, (bf16x8){l0[0], l0[1], l0[2], l0[3], h0[0], h0[1], h0[2], h0[3]}, o[d0], 0, 0, 0);   \
        o[d0] = __builtin_amdgcn_mfma_f32_32x32x16_bf16(pa1, (bf16x8){l1[0], l1[1], l1[2], l1[3], h1[0], h1[1], h1[2], h1[3]}, o[d0], 0, 0, 0);   \
        o[d0] = __builtin_amdgcn_mfma_f32_32x32x16_bf16(pa2, (bf16x8){l2[0], l2[1], l2[2], l2[3], h2[0], h2[1], h2[2], h2[3]}, o[d0], 0, 0, 0);   \
        o[d0] = __builtin_amdgcn_mfma_f32_32x32x16_bf16(pa3, (bf16x8){l3[0], l3[1], l3[2], l3[3], h3[0], h3[1], h3[2], h3[3]}, o[d0], 0, 0, 0); } while (0)
    PV_D0(0); PV_D0(1); PV_D0(2); PV_D0(3);
#undef PV_D0
#undef TRRD
}

template <class TIn, class TOut> struct BlockRef { const TIn* Q; const TIn* K; const TIn* V; TOut* O; int P0; };
template <class TIn> struct Seam {
    bf16x8 qr[8];
    bf16x8 st_v0, st_v1, st_k0, st_k1; f32x4 sf0, sf1, sf2, sf3;
    f32x4 tq[16];
};
__device__ __forceinline__ int swa_jlo(int P0, int W) { const int lowk = P0 - W + 1; return lowk > 0 ? lowk / KVBLK : 0; }
#define ROW(p, k0, rr) ((p) + (size_t)((k0) + (rr)) * KVP + sc)
#define VMW() asm volatile("s_waitcnt vmcnt(0)" ::: "memory")
#define VMWN(n) asm volatile("s_waitcnt vmcnt(%0)" :: "i"(n) : "memory")
#define SLOAD_H(Kp, Vp, k0) do { S.st_v0 = load8<TIn>(ROW(Vp, k0, sr)); S.st_v1 = load8<TIn>(ROW(Vp, k0, 32 + sr));              \
                         S.st_k0 = load8<TIn>(ROW(Kp, k0, sr)); S.st_k1 = load8<TIn>(ROW(Kp, k0, 32 + sr)); } while (0)
#define SWRITE_HK(bf) do { *(bf16x8*)(K_lds + (bf) * SHM_K + kws) = S.st_k0; *(bf16x8*)(K_lds + (bf) * SHM_K + kws + 32 * 256) = S.st_k1; } while (0)
#define SWRITE_HV(bf) do { *(bf16x8*)(V_lds + (bf) * SHM_V + vst0) = S.st_v0; *(bf16x8*)(V_lds + (bf) * SHM_V + vst1) = S.st_v1; } while (0)
#define SWRITE_H(bf) do { SWRITE_HV(bf); SWRITE_HK(bf); } while (0)
#define SLOAD_F(p, k0) do { S.sf0 = *(const f32x4*)ROW(p, k0, sr); S.sf1 = *(const f32x4*)(ROW(p, k0, sr) + 4);                \
                            S.sf2 = *(const f32x4*)ROW(p, k0, 32 + sr); S.sf3 = *(const f32x4*)(ROW(p, k0, 32 + sr) + 4); } while (0)
#define SWRITE_KF(bf) do { *(bf16x8*)(K_lds + (bf) * SHM_K + kws) = pack8(S.sf0, S.sf1); *(bf16x8*)(K_lds + (bf) * SHM_K + kws + 32 * 256) = pack8(S.sf2, S.sf3); } while (0)
#define SWRITE_VF(bf) do { *(bf16x8*)(V_lds + (bf) * SHM_V + vst0) = pack8(S.sf0, S.sf1); *(bf16x8*)(V_lds + (bf) * SHM_V + vst1) = pack8(S.sf2, S.sf3); } while (0)
template <class TIn, class TOut>
__device__ __forceinline__ void causal_swa_prime(const BlockRef<TIn, TOut>& cur, int W, char* lds, Seam<TIn>& S) {
    constexpr bool F32 = same_t<TIn, float>::v;
    int tid = threadIdx.x; asm volatile("" : "+v"(tid)); const int wid = __builtin_amdgcn_readfirstlane(tid >> 6), lane = tid & 63, r32 = lane & 31, hi = lane >> 5;
    const int sr = tid >> 4, sc = (tid & 15) * 8, kws = KSWZ(sr, sc * 2); char* K_lds = lds + NVS * SHM_V;
    const int kb0 = swa_jlo(cur.P0, W) * KVBLK;
    for (int d0 = 0; d0 < 8; ++d0) S.qr[d0] = load8<TIn>(cur.Q + (size_t)(wid * QBLK + r32) * QP + d0 * 16 + hi * 8);
    if constexpr (F32) { SLOAD_F((const float*)cur.K, kb0); VMW(); SWRITE_KF(0); SBAR(); SLOAD_F((const float*)cur.V, kb0); }
    else { SLOAD_H(cur.K, cur.V, kb0); VMW(); SWRITE_HK(0); }
    __syncthreads();
}
template <class TIn, class TOut>
__device__ __forceinline__ void causal_swa_block(const BlockRef<TIn, TOut>& cur, const BlockRef<TIn, TOut>& nxt, int skv, int W, char* lds, Seam<TIn>& S) {
    constexpr bool F32 = same_t<TIn, float>::v;
    int tid = threadIdx.x; asm volatile("" : "+v"(tid)); const int wid = __builtin_amdgcn_readfirstlane(tid >> 6), lane = tid & 63, r32 = lane & 31, hi = lane >> 5;
    const int j_lo = swa_jlo(cur.P0, W);
    int j_hi = (cur.P0 + QB - 1) / KVBLK + 1; if (j_hi > skv / KVBLK) j_hi = skv / KVBLK;
    const int NT = j_hi - j_lo;
    const int kbn = swa_jlo(nxt.P0, W) * KVBLK;
    const int qlo = (cur.P0 + wid * QBLK) | (CHUNKM1), qm = qlo - 4 * hi;
    char* V_lds = lds; char* K_lds = lds + NVS * SHM_V;
    float* ws = (float*)(lds + NVS * SHM_V + 2 * SHM_K) + wid * 64; float* li_l = ws, * al_l = ws + 32;
    float m_reg = -1e30f, l_reg = 0; f32x16 o[4] = {};
    const int sr = tid >> 4, sc = (tid & 15) * 8, vst0 = v_st(sr, sc), vst1 = v_st(32 + sr, sc), kws = KSWZ(sr, sc * 2);
    const int vb0 = (int)(uintptr_t)V_lds + v_rd_base(lane);
    const TIn* Kh = cur.K; const TIn* Vh = cur.V;
#define RESC(a) do { if (__any((a) < 1.f)) { if (hi == 0) al_l[r32] = (a); asm volatile("s_waitcnt lgkmcnt(0)" ::: "memory");              \
                     for (int d_ = 0; d_ < 4; ++d_) for (int r = 0; r < 16; ++r) o[d_][r] *= al_l[crow(r, hi)]; } } while (0)
#define KBASE(t) ((j_lo + (t)) * KVBLK)
#define ACT(t) (KBASE(t) <= qlo)
#define MASKT(P0_, P1_, t) do { const int kb_ = KBASE(t); if ((!SK || ACT(t)) && (kb_ + KVBLK - 1 > qlo || kb_ <= qlo + QBLK - 1 - W)) mask_tile(P0_, P1_, qm - kb_, (unsigned)W); } while (0)
    constexpr int NQL = F32 ? 16 : 8;
    constexpr bool SK = WSKIP && !F32;
#define SEAM_K0() do { VMWN(NQL); if constexpr (F32) { SWRITE_KF(0); SBAR(); SLOAD_F((const float*)nxt.V, kbn); } else { SWRITE_HK(0); } SBAR(); } while (0)
    f32x16 pA0, pA1, pB0, pB1; float mnA, mnB, alA, alB; bf16x8 pa0, pa1, pa2, pa3;
    if constexpr (F32) { VMW(); SWRITE_VF(0); SBAR(); } else { SWRITE_HV(0); SBAR(); }
    if (NT > 1) { if constexpr (F32) SLOAD_F((const float*)Kh, KBASE(1)); else SLOAD_H(Kh, Vh, KBASE(1)); }
    SBAR(); qkt<0, SK>(pA0, pA1, K_lds, r32, hi, S.qr, ACT(0));
    if constexpr (F32) { if (NT > 1) { VMW(); SWRITE_KF(1); SBAR(); SLOAD_F((const float*)Vh, KBASE(1)); } }
    MASKT(pA0, pA1, 0); partialSM(pA0, pA1, m_reg, mnA, alA);
    if (NT > 1) { VMW(); if constexpr (F32) { SWRITE_VF(1); SBAR(); if (NT > 2) SLOAD_F((const float*)Kh, KBASE(2)); } else SWRITE_H(1); }
    __syncthreads();
    static_assert(!F32, "the one-barrier V-ring loop is the bf16 path");
    int vs_rd = 0, vs_wr = 2 * SHM_V;
#define VS_NEXT(x) ((x) == (NVS - 1) * SHM_V ? 0 : (x) + SHM_V)
#define HALF_STEP(PX0, PX1, mnX, alX, PY0, PY1, alY, t, KB, SB) do {                                                          \
        SBAR(); qkt<KB, SK>(PX0, PX1, K_lds, r32, hi, S.qr, ACT(t));                                             \
        finishSM(PY0, PY1, alY, l_reg, pa0, pa1, pa2, pa3); SBAR();                                                           \
        if ((t) + 1 < NT) { SLOAD_H(Kh, Vh, KBASE((t) + 1)); SBAR(); }                                                        \
        pv_tile<0, SK>(o, vb0 + vs_rd, pa0, pa1, pa2, pa3, ACT((t) - 1)); MASKT(PX0, PX1, (t)); partialSM(PX0, PX1, m_reg, mnX, alX);              \
        if ((t) + 1 < NT) { VMW(); SWRITE_HK(SB); *(bf16x8*)(V_lds + vs_wr + vst0) = S.st_v0; *(bf16x8*)(V_lds + vs_wr + vst1) = S.st_v1; }      \
        RESC(alX); __syncthreads(); vs_rd = VS_NEXT(vs_rd); vs_wr = VS_NEXT(vs_wr); } while (0)
    for (int t = 1; t + 1 < NT; t += 2) {
        HALF_STEP(pB0, pB1, mnB, alB, pA0, pA1, alA, t, 1, 0);
        HALF_STEP(pA0, pA1, mnA, alA, pB0, pB1, alB, t + 1, 0, 1);
    }
    const bool even = (NT & 1) == 0;
    if (even) { SBAR(); qkt<1, SK>(pB0, pB1, K_lds, r32, hi, S.qr, ACT(NT - 1)); SBAR(); }
#define QROW(e) (nxt.Q + (size_t)(wid * QBLK + r32) * QP + ((e) >> 1) * 16 + hi * 8 + ((e) & 1) * 4)
    if constexpr (F32) { SLOAD_F((const float*)nxt.K, kbn); SBAR();
#pragma unroll
        for (int e = 0; e < 8; ++e) S.tq[e] = *(const f32x4*)QROW(e); }
    else { SLOAD_H(nxt.K, nxt.V, kbn); SBAR();
#pragma unroll
        for (int d0 = 0; d0 < 8; ++d0) S.qr[d0] = load8<TIn>(nxt.Q + (size_t)(wid * QBLK + r32) * QP + d0 * 16 + hi * 8); }
    SBAR();
    finishSM(pA0, pA1, alA, l_reg, pa0, pa1, pa2, pa3); SBAR();
    if constexpr (F32) {
#pragma unroll
        for (int e = 8; e < 16; ++e) S.tq[e] = *(const f32x4*)QROW(e); SBAR(); }
#undef QROW
    pv_tile<0, SK>(o, vb0 + ((even ? NT - 2 : NT - 1) % NVS) * SHM_V, pa0, pa1, pa2, pa3, ACT(even ? NT - 2 : NT - 1));
    if (even) { MASKT(pB0, pB1, NT - 1); partialSM(pB0, pB1, m_reg, mnB, alB); __syncthreads(); RESC(alB);
        finishSM(pB0, pB1, alB, l_reg, pa0, pa1, pa2, pa3); SBAR(); pv_tile<0, SK>(o, vb0 + ((NT - 1) % NVS) * SHM_V, pa0, pa1, pa2, pa3, ACT(NT - 1)); }
    SBAR(); SEAM_K0();
    if (hi == 0) li_l[r32] = l_reg; asm volatile("s_waitcnt lgkmcnt(0)" ::: "memory");
    float rli[16];
#pragma unroll
    for (int r = 0; r < 16; ++r) rli[r] = __builtin_amdgcn_rcpf(li_l[crow(r, hi)]);
    TOut* Ow = cur.O + (size_t)(wid * QBLK) * OP;
#pragma unroll
    for (int r = 0; r < 16; ++r) { const int orow = crow(r, hi);
#pragma unroll
        for (int d0 = 0; d0 < 4; ++d0) { const float v = o[d0][r] * rli[r];
            if constexpr (same_t<TOut, float>::v) { Ow[(size_t)orow * OP + d0 * 32 + r32] = v; }
            else { const float vn = __shfl_xor(v, 1);
                   if ((r32 & 1) == 0) *(unsigned*)(Ow + (size_t)orow * OP + d0 * 32 + r32) = cvtpk(v, vn); } } }
    if constexpr (F32) {
#pragma unroll
        for (int d0 = 0; d0 < 8; ++d0) S.qr[d0] = pack8(S.tq[2 * d0], S.tq[2 * d0 + 1]); }
    __syncthreads();
#undef RESC
#undef KBASE
#undef ACT
#undef MASKT
#undef SEAM_K0
#undef HALF_STEP
}
#undef ROW
#undef VMW
#undef VMWN
#undef SLOAD_H
#undef SWRITE_HK
#undef SWRITE_HV
#undef SWRITE_H
#undef SLOAD_F
#undef SWRITE_KF
#undef SWRITE_VF
}
namespace attn_pc {
using namespace attn;
typedef unsigned short bh16;
struct Block { const bh16* Q; const bh16* K; const bh16* V0; const bh16* V1; bh16* O; int P0; };
constexpr int NVSL = 3, LDS_V = 0, LDS_K = NVSL * 32768, LDS_P = LDS_K + 2 * SHM_K, LDS_S = LDS_P + 4 * 4096, PC_LDS_BYTES = LDS_S + 4 * 96 * 4;
#define PCV_RD(dst, off) asm volatile("ds_read_b64_tr_b16 %0, %1 offset:%2" : "=&v"(dst) : "v"(vb), "i"(off) : "memory")
#define PCV_RD8(F, base) do { PCV_RD(F[0], (base)); PCV_RD(F[1], (base) + 2048); PCV_RD(F[2], (base) + 4096); PCV_RD(F[3], (base) + 6144); \
                              PCV_RD(F[4], (base) + 8192); PCV_RD(F[5], (base) + 10240); PCV_RD(F[6], (base) + 12288); PCV_RD(F[7], (base) + 14336); } while (0)
#define PCV_FR(F, k) (bf16x8){F[2 * (k)][0], F[2 * (k)][1], F[2 * (k)][2], F[2 * (k)][3], F[2 * (k) + 1][0], F[2 * (k) + 1][1], F[2 * (k) + 1][2], F[2 * (k) + 1][3]}
#define PCV_MM(X, Y, FX, FY) do { \
        o[X] = __builtin_amdgcn_mfma_f32_32x32x16_bf16(pa0, PCV_FR(FX, 0), o[X], 0, 0, 0); o[Y] = __builtin_amdgcn_mfma_f32_32x32x16_bf16(pa0, PCV_FR(FY, 0), o[Y], 0, 0, 0); \
        o[X] = __builtin_amdgcn_mfma_f32_32x32x16_bf16(pa1, PCV_FR(FX, 1), o[X], 0, 0, 0); o[Y] = __builtin_amdgcn_mfma_f32_32x32x16_bf16(pa1, PCV_FR(FY, 1), o[Y], 0, 0, 0); \
        o[X] = __builtin_amdgcn_mfma_f32_32x32x16_bf16(pa2, PCV_FR(FX, 2), o[X], 0, 0, 0); o[Y] = __builtin_amdgcn_mfma_f32_32x32x16_bf16(pa2, PCV_FR(FY, 2), o[Y], 0, 0, 0); \
        o[X] = __builtin_amdgcn_mfma_f32_32x32x16_bf16(pa3, PCV_FR(FX, 3), o[X], 0, 0, 0); o[Y] = __builtin_amdgcn_mfma_f32_32x32x16_bf16(pa3, PCV_FR(FY, 3), o[Y], 0, 0, 0); } while (0)
#define PCV_WAIT() do { asm volatile("s_waitcnt lgkmcnt(0)" ::: "memory"); SBAR(); } while (0)
__device__ __forceinline__ void pv_both(f32x16 (&o)[8], int vb, bf16x8 pa0, bf16x8 pa1, bf16x8 pa2, bf16x8 pa3) {
    s16x4 A0[8], A1[8], B0[8], B1[8];
    PCV_RD8(A0, 0 * 512); PCV_RD8(A1, 16384 + 0 * 512); PCV_WAIT();
    PCV_RD8(B0, 1 * 512); PCV_RD8(B1, 16384 + 1 * 512); SBAR(); PCV_MM(0, 4, A0, A1); PCV_WAIT();
    PCV_RD8(A0, 2 * 512); PCV_RD8(A1, 16384 + 2 * 512); SBAR(); PCV_MM(1, 5, B0, B1); PCV_WAIT();
    PCV_RD8(B0, 3 * 512); PCV_RD8(B1, 16384 + 3 * 512); SBAR(); PCV_MM(2, 6, A0, A1); PCV_WAIT();
    PCV_MM(3, 7, B0, B1);
}
#undef PCV_RD
#undef PCV_RD8
#undef PCV_FR
#undef PCV_MM
#undef PCV_WAIT
__device__ __forceinline__ void block(const Block& it, char* lds) {
    int tid = threadIdx.x; asm volatile("" : "+v"(tid));
    const int wid = __builtin_amdgcn_readfirstlane(tid >> 6), lane = tid & 63, r32 = lane & 31, hi = lane >> 5;
    const bool swave = wid < 4; const int g = wid & 3;
    char* V_lds = lds + LDS_V; char* K_lds = lds + LDS_K; char* P_lds = lds + LDS_P + g * 4096;
    typedef __attribute__((address_space(3))) float lfloat; typedef __attribute__((address_space(3))) unsigned lunsigned;
    lfloat* al_l = (lfloat*)(__attribute__((address_space(3))) char*)lds + (LDS_S / 4) + g * 96; lfloat* li_l = al_l + 32; lunsigned* flag = (lunsigned*)(al_l + 64);
    const int NT = it.P0 / KVBLK + 2;
    const int nvis = it.P0 / KVBLK + (g >> 1) + 1;
#define PC_VMW() asm volatile("s_waitcnt vmcnt(0)" ::: "memory")
#define PC_BAR() asm volatile("s_waitcnt lgkmcnt(0)\n\ts_barrier" ::: "memory")
#define PC_DMA(gsrc, ldst) __builtin_amdgcn_global_load_lds((const unsigned*)(gsrc), (__attribute__((address_space(3))) unsigned*)(__attribute__((address_space(3))) char*)(ldst), 16, 0, 0)
    const int krow = lane >> 4, kpos = lane & 15;
    const int vsub = lane >> 5, vkk = (lane & 31) >> 2, vcc = (lane & 3) * 8;
#define PC_DMA_K(tt, buf, p) do { const int row_ = 4 * (p) + krow; \
        PC_DMA(it.K + (size_t)((tt) * KVBLK + row_) * D + ((kpos ^ (row_ & 7)) << 3), K_lds + (buf) * SHM_K + (p) * 1024); } while (0)
#define PC_DMA_V(tt, off, hq) do { const int st_ = 2 * ((hq) & 15) + vsub, kk_ = (st_ >> 2) * 8 + vkk, k_ = (kk_ & ~0xC) | ((kk_ & 4) << 1) | ((kk_ & 8) >> 1); \
        PC_DMA((((hq) >> 4) ? it.V1 : it.V0) + (size_t)((tt) * KVBLK + k_) * D + (st_ & 3) * 32 + vcc, V_lds + (off) + ((hq) >> 4) * 16384 + ((hq) & 15) * 1024); } while (0)
#define PC_ISSUE_S(tt, kbuf, voff) do { _Pragma("unroll") for (int j = 0; j < 4; ++j) { PC_DMA_K(tt, kbuf, 4 * g + j); PC_DMA_V(tt, voff, 4 * wid + j); } } while (0)
#define PC_ISSUE_PV(tt, voff) do { _Pragma("unroll") for (int j = 0; j < 4; ++j) PC_DMA_V(tt, voff, 4 * wid + j); } while (0)
    if (swave) {
        bf16x8 qr[8]; float l_reg = 0.f, m_reg = -1e30f; int vs_nx = 65536;
#pragma unroll
        for (int d0 = 0; d0 < 8; ++d0) qr[d0] = *reinterpret_cast<const bf16x8*>(it.Q + (size_t)(g * QBLK + r32) * D + d0 * 16 + hi * 8);
        PC_ISSUE_S(0, 0, 0); PC_VMW(); if (NT > 1) PC_ISSUE_S(1, 1, 32768);
        if (lane == 0) *flag = 0u;
        PC_BAR();
#pragma unroll 1
        for (int t = 0; t <= NT; ++t) {
            const int par = t & 1; const bool act = t < nvis;
            bf16x8 pa0 = {}, pa1 = {}, pa2 = {}, pa3 = {}; float alpha = 1.f; bool resc = false;
            if (act) {
                f32x16 p0, p1; float mn;
                qkt<0, false>(p0, p1, K_lds + par * SHM_K, r32, hi, qr, true);
                partialSM(p0, p1, m_reg, mn, alpha);
                finishSM(p0, p1, alpha, l_reg, pa0, pa1, pa2, pa3);
                resc = __any(alpha < 1.f);
            }
            PC_BAR();
            if (act) {
                bf16x8* pp = (bf16x8*)(P_lds + lane * 16); pp[0] = pa0; pp[64] = pa1; pp[128] = pa2; pp[192] = pa3;
                if (resc && hi == 0) al_l[r32] = alpha;
                if (lane == 0) *flag = resc ? 3u : 1u;
            } else { if (lane == 0) *flag = 0u; }
            PC_VMW();
            if (t + 2 < NT) PC_ISSUE_S(t + 2, par, vs_nx);
            vs_nx = (vs_nx == (NVSL - 1) * 32768) ? 0 : vs_nx + 32768;
            asm volatile("" ::: "memory");
            PC_BAR();
        }
        if (hi == 0) li_l[r32] = l_reg;
        PC_BAR();
        PC_BAR();
    } else {
        f32x16 o[8] = {};
        const int vbl = (int)(uintptr_t)V_lds + v_rd_base(lane);
        PC_ISSUE_PV(0, 0); PC_VMW(); if (NT > 1) PC_ISSUE_PV(1, 32768);
        PC_BAR();
        int vs_rd = 0, vs_wr = 65536;
#pragma unroll 1
        for (int t = 0; t <= NT; ++t) {
            asm volatile("" ::: "memory"); const unsigned f = (unsigned)__builtin_amdgcn_readfirstlane((int)*flag);
            if (f & 1u) {
                const bf16x8* pp = (const bf16x8*)(P_lds + lane * 16); const bf16x8 pa0 = pp[0], pa1 = pp[64], pa2 = pp[128], pa3 = pp[192];
                if (f & 2u) { float al[16];
#pragma unroll
                    for (int r = 0; r < 16; ++r) al[r] = al_l[crow(r, hi)];
#pragma unroll
                    for (int d_ = 0; d_ < 8; ++d_)
#pragma unroll
                        for (int r = 0; r < 16; ++r) o[d_][r] *= al[r]; }
                pv_both(o, vbl + vs_rd, pa0, pa1, pa2, pa3);
            }
            PC_BAR();
            PC_VMW(); if (t + 2 < NT) PC_ISSUE_PV(t + 2, vs_wr);
            if (t >= 1) vs_rd = (vs_rd == (NVSL - 1) * 32768) ? 0 : vs_rd + 32768;
            vs_wr = (vs_wr == (NVSL - 1) * 32768) ? 0 : vs_wr + 32768;
            PC_BAR();
        }
        PC_BAR();
        float rli[16];
#pragma unroll
        for (int r = 0; r < 16; ++r) rli[r] = __builtin_amdgcn_rcpf(li_l[crow(r, hi)]);
        unsigned short* Ow = (unsigned short*)it.O + (size_t)(g * QBLK) * OP;
        unsigned short* stg = (unsigned short*)(V_lds + g * 16384);
#pragma unroll
        for (int r = 0; r < 16; ++r) { const int orow = crow(r, hi);
#pragma unroll
            for (int d0 = 0; d0 < 8; ++d0) { const float v = o[d0][r] * rli[r]; stg[orow * 256 + d0 * 32 + r32] = (unsigned short)(cvtpk(v, v) & 0xffffu); } }
        asm volatile("s_waitcnt lgkmcnt(0)" ::: "memory");
#pragma unroll
        for (int i = 0; i < 16; ++i) { const int chunk = i * 64 + lane, row = chunk >> 5, cc = chunk & 31;
            const u32x4 val = *(const u32x4*)(stg + row * 256 + cc * 8);
            *(u32x4*)(Ow + (size_t)row * OP + cc * 8) = val; }
        PC_BAR();
    }
#undef PC_VMW
#undef PC_DMA
#undef PC_DMA_K
#undef PC_DMA_V
#undef PC_ISSUE_S
#undef PC_ISSUE_PV
#undef PC_BAR
}
}
struct Ctx {
    LAS unsigned char* lds;
    int tid, lane, wave, G, vcu, gw, NGW;
};

__device__ __forceinline__ void transpose_item(const float* W, int ldw, int k0, int n0, bf16* WT, int Kdst, int dst_row0, LAS float* scr, int lane) {
    {
        f32x4 v[8]; const int r = lane >> 3, n4 = (lane & 7) * 4;
#pragma unroll
        for (int i = 0; i < 8; ++i) v[i] = __builtin_nontemporal_load((const GAS f32x4*)(W + (size_t)(k0 + 8 * i + r) * ldw + n0 + n4));
#pragma unroll
        for (int i = 0; i < 8; ++i) { LAS float* d = scr + (8 * i + r) * 33 + n4; d[0] = v[i].x; d[1] = v[i].y; d[2] = v[i].z; d[3] = v[i].w; }
    }
    LDS_WAIT(); asm volatile("" ::: "memory");
    const int c = lane & 7;
#pragma unroll
    for (int j = 0; j < 4; ++j) { const int n = (lane >> 3) + 8 * j; const LAS float* s = scr + (8 * c) * 33 + n;
        v4u o; o.x = pk2(s[0 * 33], s[1 * 33]); o.y = pk2(s[2 * 33], s[3 * 33]); o.z = pk2(s[4 * 33], s[5 * 33]); o.w = pk2(s[6 * 33], s[7 * 33]);
        *(GAS v4u*)(WT + (((size_t)(dst_row0 >> 8) * (Kdst >> 6) + (k0 >> 6)) * 256 + (dst_row0 & 255) + n) * 64 + 8 * c) = o; }
    LDS_WAIT(); asm volatile("" ::: "memory");
}
typedef const float* const __attribute__((address_space(4)))* InTab;
__device__ __forceinline__ void p0_prologue(const Ctx& X, InTab in, unsigned char* ws) {
    LAS float* scr = (LAS float*)(X.lds + RING_OFF + X.wave * 16384);
    constexpr int I_MOD = (NMODT / 256) * 16;
    constexpr int I_FIN = (DM / 64) * (2 * DFF / 32), I_FOUT = (DFF / 64) * (DM / 32), I_LIN = (DM / 64) * (2 * DM / 32), I_G = 16 * 32;
    constexpr int I_SQ = (DM / 64) * (DM / 32), I_KV = (DM / 64) * (2 * DM / 32);
    constexpr int NITEMS = I_MOD + 4 * I_FIN + 4 * I_FOUT + I_LIN + I_G + I_SQ + I_KV + I_SQ + I_SQ;
    for (int it = X.gw; it < NITEMS; it += X.NGW) {
        int r = it;
        if (r < I_MOD) {
            const int cg = r >> 4, kc = r & 15; const float* W; int ldw, cc;
            if (cg < 72) { W = in[2]; ldw = NMOD; cc = cg * 256; } else if (cg < 144) { W = in[2] + (size_t)DM * NMOD; ldw = NMOD; cc = (cg - 72) * 256; } else { W = in[17]; ldw = 4096; cc = (cg - 144) * 256; }
            const int kb = kc * 128;
            float ca[2][2];
#pragma unroll
            for (int b = 0; b < 2; ++b)
#pragma unroll
                for (int hh = 0; hh < 2; ++hh) ca[b][hh] = silu_f(in[1][b * DM + kb + hh * 64 + X.lane]);
            f32x4 acc0 = {0.f, 0.f, 0.f, 0.f}, acc1 = {0.f, 0.f, 0.f, 0.f};
            const float* wp = W + (size_t)kb * ldw + cc + 4 * X.lane;
#pragma unroll
            for (int hh = 0; hh < 2; ++hh) {
#pragma unroll 16
                for (int kk = 0; kk < 64; ++kk) {
                    const f32x4 w = __builtin_nontemporal_load((const GAS f32x4*)(wp + (size_t)(hh * 64 + kk) * ldw));
                    const float s0 = __uint_as_float(__builtin_amdgcn_readlane(__float_as_uint(ca[0][hh]), kk));
                    const float s1 = __uint_as_float(__builtin_amdgcn_readlane(__float_as_uint(ca[1][hh]), kk));
                    acc0 += w * s0; acc1 += w * s1; }
            }
            *(GAS f32x4*)((float*)(ws + WS_MODP) + (size_t)(kc * 2 + 0) * NMODT + cg * 256 + 4 * X.lane) = acc0;
            *(GAS f32x4*)((float*)(ws + WS_MODP) + (size_t)(kc * 2 + 1) * NMODT + cg * 256 + 4 * X.lane) = acc1;
            continue; }
        r -= I_MOD;
        if (r < 3 * I_FOUT) { const int mi = 1 + r / I_FOUT, q = r % I_FOUT; constexpr int nblk = DM / 32; const int kb = q / nblk, nb = q % nblk;
            transpose_item(in[6] + (size_t)mi * DFF * DM, DM, 64 * kb, 32 * nb, (bf16*)(ws + WS_WFOUT) + (size_t)mi * DM * DFF, DFF, 32 * nb, scr, X.lane); continue; }
        r -= 3 * I_FOUT;
        if (r < 3 * I_FIN) {
            const int mi = 1 + r / I_FIN, q = r % I_FIN; constexpr int nblk = 2 * DFF / 32; const int kb = q / nblk, nb = q % nblk, n0 = 32 * nb;
            const int nn = n0 < DFF ? n0 : n0 - DFF; const int drow = (nn >> 7) * 256 + (n0 < DFF ? 0 : 128) + (nn & 127);
            transpose_item(in[5] + (size_t)mi * DM * 2 * DFF, 2 * DFF, 64 * kb, n0, (bf16*)(ws + WS_WFIN) + (size_t)mi * 2 * DFF * DM, DM, drow, scr, X.lane); continue; }
        r -= 3 * I_FIN;
        if (r < I_SQ) { constexpr int nblk = DM / 32; const int kb = r / nblk, nb = r % nblk; transpose_item(in[23], DM, 64 * kb, 32 * nb, (bf16*)(ws + WS_WO), DM, 32 * nb, scr, X.lane); continue; }
        r -= I_SQ;
        if (r < I_SQ) { constexpr int nblk = DM / 32; const int kb = r / nblk, nb = r % nblk; transpose_item(in[20], DM, 64 * kb, 32 * nb, (bf16*)(ws + WS_WQ), DM, 32 * nb, scr, X.lane); continue; }
        r -= I_SQ;
        if (r < I_KV) { constexpr int nblk = 2 * DM / 32; const int kb = r / nblk, nb = r % nblk; transpose_item(in[19], 2 * DM, 64 * kb, 32 * nb, (bf16*)(ws + WS_WKV), DM, 32 * nb, scr, X.lane); continue; }
        r -= I_KV;
        if (r < I_SQ) { constexpr int nblk = DM / 32; const int kb = r / nblk, nb = r % nblk; transpose_item(in[15], DM, 64 * kb, 32 * nb, (bf16*)(ws + WS_WLOUT), DM, 32 * nb, scr, X.lane); continue; }
        r -= I_SQ;
        if (r < I_G) { const int g = r >> 5, q = r & 31, head = g >> 1, which = g & 1, kb = q >> 3, nb = q & 7, n0 = 32 * nb;
            const float* W = (which ? in[12] : in[10]) + (size_t)head * LRUB * LRUB;
            const int drow = (head * 2 + (n0 >> 7)) * 256 + which * 128 + (n0 & 127);
            transpose_item(W, LRUB, 64 * kb, n0, (bf16*)(ws + WS_WG), LRUB, drow, scr, X.lane); continue; }
        r -= I_G;
        if (r < I_LIN) { constexpr int nblk = 2 * DM / 32; const int kb = r / nblk, nb = r % nblk;
            transpose_item(in[7], 2 * DM, 64 * kb, 32 * nb, (bf16*)(ws + WS_WLIN), DM, 32 * nb, scr, X.lane); continue; }
        r -= I_LIN;
        if (r < I_FOUT) { const int q = r; constexpr int nblk = DM / 32; const int kb = q / nblk, nb = q % nblk;
            transpose_item(in[6], DM, 64 * kb, 32 * nb, (bf16*)(ws + WS_WFOUT), DFF, 32 * nb, scr, X.lane); continue; }
        r -= I_FOUT;
        { const int q = r; constexpr int nblk = 2 * DFF / 32; const int kb = q / nblk, nb = q % nblk, n0 = 32 * nb;
            const int nn = n0 < DFF ? n0 : n0 - DFF; const int drow = (nn >> 7) * 256 + (n0 < DFF ? 0 : 128) + (nn & 127);
            transpose_item(in[5], 2 * DFF, 64 * kb, n0, (bf16*)(ws + WS_WFIN), DM, drow, scr, X.lane); }
    }
}
__device__ __forceinline__ void p1_modreduce(const Ctx& X, const float* modp, const float* b_mod, const float* kv_b_mod, float* mod,
                                             const float* b_a, const float* b_x, const float* lam, float* gc) {
    for (int idx = blockIdx.x * (NWAVES * 64) + X.tid; idx < 2 * NMODT; idx += X.G * NWAVES * 64) {
        const int b = idx / NMODT, col = idx % NMODT;
        float s = col < 2 * NMOD ? b_mod[col] : kv_b_mod[col - 2 * NMOD];
#pragma unroll
        for (int kc = 0; kc < 16; ++kc) s += modp[(size_t)(kc * 2 + b) * NMODT + col];
        mod[idx] = s;
    }
    for (int ch = blockIdx.x * (NWAVES * 64) + X.tid; ch < DM; ch += X.G * NWAVES * 64) {
        const float z = -lam[ch];
        gc[ch] = b_a[ch]; gc[DM + ch] = b_x[ch]; gc[2 * DM + ch] = 8.0f * (fmaxf(z, 0.f) + log1pf(expf(-fabsf(z))));
    }
}

struct NormArgs { const float* xin; const float* y; float* xout; bf16* h1; bf16* h2; float wgt;
                  const float *gpost, *gate;
                  const float *gpre1, *scale1, *shift1, *gpre2, *scale2, *shift2; };
__device__ __forceinline__ void norm_phase(const Ctx& X, const NormArgs& a) {
    LAS float* V = (LAS float*)(X.lds + RING_OFF);
    for (int it = blockIdx.x; it < M / 32; it += X.G) {
        const int b = (it * 32) / SEQ;
        for (int c = X.tid; c < DM; c += NWAVES * 64) {
            if (a.y)  V[c] = a.wgt * a.gate[(size_t)b * NMODT + c] * a.gpost[c];
            if (a.h1) { V[DM + c] = a.gpre1[c] * (1.0f + a.scale1[(size_t)b * NMODT + c]); V[2 * DM + c] = a.shift1[(size_t)b * NMODT + c]; }
            if (a.h2) { V[3 * DM + c] = a.gpre2[c] * (1.0f + a.scale2[(size_t)b * NMODT + c]); V[4 * DM + c] = a.shift2[(size_t)b * NMODT + c]; }
        }
        __syncthreads();
#pragma unroll 1
        for (int rr = 0; rr < 4; ++rr) {
            const size_t row = (size_t)it * 32 + X.wave * 4 + rr;
            f32x4 xv[8];
#pragma unroll
            for (int j = 0; j < 8; ++j) xv[j] = *(const GAS f32x4*)(a.xin + row * DM + 256 * j + 4 * X.lane);
            if (a.y) {
                f32x4 yv[8]; float ss = 0.f;
#pragma unroll
                for (int j = 0; j < 8; ++j) { yv[j] = *(const GAS f32x4*)(a.y + row * DM + 256 * j + 4 * X.lane); ss += (yv[j].x * yv[j].x + yv[j].y * yv[j].y) + (yv[j].z * yv[j].z + yv[j].w * yv[j].w); }
                const float rs = 1.0f / sqrtf(wave_sum(ss) * (1.0f / DM) + NORM_EPS);
#pragma unroll
                for (int j = 0; j < 8; ++j) { const f32x4 ca = *(const LAS f32x4*)(V + 256 * j + 4 * X.lane); xv[j] += ca * (yv[j] * rs); }
            }
            asm volatile("" ::: "memory");
            if (a.xout) {
#pragma unroll
                for (int j = 0; j < 8; ++j) *(GAS f32x4*)(a.xout + row * DM + 256 * j + 4 * X.lane) = xv[j];
            }
            if (a.h1 || a.h2) {
                float ss = 0.f;
#pragma unroll
                for (int j = 0; j < 8; ++j) ss += (xv[j].x * xv[j].x + xv[j].y * xv[j].y) + (xv[j].z * xv[j].z + xv[j].w * xv[j].w);
                const float rs = 1.0f / sqrtf(wave_sum(ss) * (1.0f / DM) + NORM_EPS);
                asm volatile("" ::: "memory");
                if (a.h1) {
#pragma unroll
                    for (int j = 0; j < 8; ++j) { const f32x4 cb = *(const LAS f32x4*)(V + DM + 256 * j + 4 * X.lane), cc = *(const LAS f32x4*)(V + 2 * DM + 256 * j + 4 * X.lane);
                        const f32x4 h = xv[j] * rs * cb + cc; v2u o; o.x = pk2(h.x, h.y); o.y = pk2(h.z, h.w);
                        *(GAS v2u*)(a.h1 + row * DM + 256 * j + 4 * X.lane) = o; }
                }
                asm volatile("" ::: "memory");
                if (a.h2) {
#pragma unroll
                    for (int j = 0; j < 8; ++j) { const f32x4 cb = *(const LAS f32x4*)(V + 3 * DM + 256 * j + 4 * X.lane), cc = *(const LAS f32x4*)(V + 4 * DM + 256 * j + 4 * X.lane);
                        const f32x4 h = xv[j] * rs * cb + cc; v2u o; o.x = pk2(h.x, h.y); o.y = pk2(h.z, h.w);
                        *(GAS v2u*)(a.h2 + row * DM + 256 * j + 4 * X.lane) = o; }
                }
            }
        }
        __syncthreads();
    }
}

__device__ __forceinline__ void norm0_phase(const Ctx& X, const float* xin, bf16* h1, const float* gpre1, const float* scale1, const float* shift1) {
    LAS float* V = (LAS float*)(X.lds + RING_OFF);
    for (int it = blockIdx.x; it < M / 32; it += X.G) {
        const int b = (it * 32) / SEQ;
        f32x4 xv[4][4][2];
#pragma unroll
        for (int rr = 0; rr < 4; ++rr) { const size_t row = (size_t)it * 32 + X.wave * 4 + rr;
#pragma unroll
            for (int j = 0; j < 4; ++j) { xv[rr][j][0] = *(const GAS f32x4*)(xin + row * DM + 512 * j + 8 * X.lane); xv[rr][j][1] = *(const GAS f32x4*)(xin + row * DM + 512 * j + 8 * X.lane + 4); } }
        for (int c = X.tid; c < DM; c += NWAVES * 64) { V[c] = gpre1[c] * (1.0f + scale1[(size_t)b * NMODT + c]); V[DM + c] = shift1[(size_t)b * NMODT + c]; }
        __syncthreads();
#pragma unroll
        for (int rr = 0; rr < 4; ++rr) { const size_t row = (size_t)it * 32 + X.wave * 4 + rr;
            float ss = 0.f;
#pragma unroll
            for (int j = 0; j < 4; ++j)
#pragma unroll
                for (int e = 0; e < 2; ++e) { const f32x4 v = xv[rr][j][e]; ss += (v.x * v.x + v.y * v.y) + (v.z * v.z + v.w * v.w); }
            const float rs = 1.0f / sqrtf(wave_sum(ss) * (1.0f / DM) + NORM_EPS);
#pragma unroll
            for (int j = 0; j < 4; ++j) { v4u o;
#pragma unroll
                for (int e = 0; e < 2; ++e) { const f32x4 cb = *(const LAS f32x4*)(V + 512 * j + 8 * X.lane + 4 * e), cc = *(const LAS f32x4*)(V + DM + 512 * j + 8 * X.lane + 4 * e);
                    const f32x4 h = xv[rr][j][e] * rs * cb + cc; if (e == 0) { o.x = pk2(h.x, h.y); o.y = pk2(h.z, h.w); } else { o.z = pk2(h.x, h.y); o.w = pk2(h.z, h.w); } }
                *(GAS v4u*)(h1 + row * DM + 512 * j + 8 * X.lane) = o; }
            asm volatile("" ::: "memory");
        }
        __syncthreads();
    }
}

__device__ __forceinline__ void conv_phase(const Ctx& X, const bf16* xr, const float* cw, const float* cb, bf16* xrc) {
    for (int w4 = X.gw; w4 < M / 4; w4 += X.NGW) {
        const int row0 = 4 * w4, t0 = row0 % SEQ;
#pragma unroll 1
        for (int j = 0; j < 4; ++j) {
            const int ch0 = j * 512 + 8 * X.lane;
            float wv[4][8], bv[8];
#pragma unroll
            for (int k = 0; k < 4; ++k) { const f32x4 w0 = *(const GAS f32x4*)(cw + k * DM + ch0), w1 = *(const GAS f32x4*)(cw + k * DM + ch0 + 4);
                wv[k][0] = w0.x; wv[k][1] = w0.y; wv[k][2] = w0.z; wv[k][3] = w0.w; wv[k][4] = w1.x; wv[k][5] = w1.y; wv[k][6] = w1.z; wv[k][7] = w1.w; }
            { const f32x4 b0 = *(const GAS f32x4*)(cb + ch0), b1 = *(const GAS f32x4*)(cb + ch0 + 4); bv[0] = b0.x; bv[1] = b0.y; bv[2] = b0.z; bv[3] = b0.w; bv[4] = b1.x; bv[5] = b1.y; bv[6] = b1.z; bv[7] = b1.w; }
            float xin[7][8];
#pragma unroll
            for (int i = 0; i < 7; ++i) {
                v4u w = {0u, 0u, 0u, 0u};
                if (t0 - 3 + i >= 0) w = *(const GAS v4u*)(xr + (size_t)(row0 - 3 + i) * DM + ch0);
                xin[i][0] = bflo(w.x); xin[i][1] = bfhi(w.x); xin[i][2] = bflo(w.y); xin[i][3] = bfhi(w.y); xin[i][4] = bflo(w.z); xin[i][5] = bfhi(w.z); xin[i][6] = bflo(w.w); xin[i][7] = bfhi(w.w); }
#pragma unroll
            for (int r = 0; r < 4; ++r) { float o[8];
#pragma unroll
                for (int e = 0; e < 8; ++e) { float s = bv[e];
#pragma unroll
                    for (int k = 0; k < 4; ++k) s += wv[k][e] * xin[r + k][e];
                    o[e] = s; }
                v4u w; w.x = pk2(o[0], o[1]); w.y = pk2(o[2], o[3]); w.z = pk2(o[4], o[5]); w.w = pk2(o[6], o[7]);
                *(GAS v4u*)(xrc + (size_t)(row0 + r) * DM + ch0) = w; }
        }
    }
}

__device__ __forceinline__ void scan_a_phase(const Ctx& X, const unsigned* AU, float* agp, float* agh, float* sagp, float* sagh) {
    LAS float* Pl = (LAS float*)(X.lds + RING_OFF); LAS float* Hl = Pl + 8 * 256;
    for (int bi = blockIdx.x; bi < 256; bi += X.G) {
        const int b = bi >> 7, sc = (bi >> 3) & 15, cg = bi & 7, chunk = sc * 8 + X.wave, ch = cg * 256 + 4 * X.lane;
        const size_t row0 = (size_t)b * SEQ + chunk * 32;
        f32x4 P = {1.f, 1.f, 1.f, 1.f}, H = {0.f, 0.f, 0.f, 0.f};
#pragma unroll 1
        for (int tb = 0; tb < 4; ++tb) {
            v4u wv[8];
#pragma unroll
            for (int i = 0; i < 8; ++i) wv[i] = *(const GAS v4u*)(AU + (row0 + tb * 8 + i) * DM + ch);
#pragma unroll
            for (int i = 0; i < 8; ++i) { const f32x4 a = {__builtin_amdgcn_exp2f(bflo(wv[i].x)), __builtin_amdgcn_exp2f(bflo(wv[i].y)), __builtin_amdgcn_exp2f(bflo(wv[i].z)), __builtin_amdgcn_exp2f(bflo(wv[i].w))};
                const f32x4 u = {bfhi(wv[i].x), bfhi(wv[i].y), bfhi(wv[i].z), bfhi(wv[i].w)}; H = a * H + u; P = P * a; }
        }
        *(GAS f32x4*)(agp + ((size_t)b * 128 + chunk) * DM + ch) = P; *(GAS f32x4*)(agh + ((size_t)b * 128 + chunk) * DM + ch) = H;
        *(LAS f32x4*)(Pl + X.wave * 256 + 4 * X.lane) = P; *(LAS f32x4*)(Hl + X.wave * 256 + 4 * X.lane) = H;
        __syncthreads();
        if (X.tid < 256) { float p = 1.f, h = 0.f;
#pragma unroll
            for (int w = 0; w < 8; ++w) { const float pw = Pl[w * 256 + X.tid], hw = Hl[w * 256 + X.tid]; h = pw * h + hw; p *= pw; }
            sagp[((size_t)b * 16 + sc) * DM + cg * 256 + X.tid] = p; sagh[((size_t)b * 16 + sc) * DM + cg * 256 + X.tid] = h; }
        __syncthreads();
    }
}
__device__ __forceinline__ void scan_b_phase(const Ctx& X, const unsigned* AU, const float* agp, const float* agh, const float* sagp, const float* sagh, const bf16* yg, bf16* hg) {
    for (int bi = blockIdx.x; bi < 256; bi += X.G) {
        const int b = bi >> 7, sc = (bi >> 3) & 15, cg = bi & 7, chunk = sc * 8 + X.wave, ch = cg * 256 + 4 * X.lane;
        const int chy = cg * 256 + (X.lane >> 3) * 32 + 8 * (X.lane & 3) + 4 * ((X.lane >> 2) & 1);
        const size_t row0 = (size_t)b * SEQ + chunk * 32;
        f32x4 h = {0.f, 0.f, 0.f, 0.f};
        {
            f32x4 pv[15], hv[15];
#pragma unroll
            for (int s = 0; s < 15; ++s) { const int ss = s < sc ? s : 0; pv[s] = *(const GAS f32x4*)(sagp + ((size_t)b * 16 + ss) * DM + ch); hv[s] = *(const GAS f32x4*)(sagh + ((size_t)b * 16 + ss) * DM + ch); }
#pragma unroll
            for (int s = 0; s < 15; ++s) if (s < sc) h = pv[s] * h + hv[s];
        }
        {
            f32x4 pv[7], hv[7];
#pragma unroll
            for (int w = 0; w < 7; ++w) { const int ww = w < X.wave ? w : 0; pv[w] = *(const GAS f32x4*)(agp + ((size_t)b * 128 + sc * 8 + ww) * DM + ch); hv[w] = *(const GAS f32x4*)(agh + ((size_t)b * 128 + sc * 8 + ww) * DM + ch); }
#pragma unroll
            for (int w = 0; w < 7; ++w) if (w < X.wave) h = pv[w] * h + hv[w];
        }
#pragma unroll 1
        for (int tb = 0; tb < 4; ++tb) {
            v4u wv[8]; v2u gv[8];
#pragma unroll
            for (int i = 0; i < 8; ++i) { const size_t o = (row0 + tb * 8 + i) * DM + ch; wv[i] = *(const GAS v4u*)(AU + o); gv[i] = *(const GAS v2u*)(yg + (row0 + tb * 8 + i) * DM + chy); }
#pragma unroll
            for (int i = 0; i < 8; ++i) { const f32x4 a = {__builtin_amdgcn_exp2f(bflo(wv[i].x)), __builtin_amdgcn_exp2f(bflo(wv[i].y)), __builtin_amdgcn_exp2f(bflo(wv[i].z)), __builtin_amdgcn_exp2f(bflo(wv[i].w))};
                const f32x4 u = {bfhi(wv[i].x), bfhi(wv[i].y), bfhi(wv[i].z), bfhi(wv[i].w)}; h = a * h + u;
                v2u o; o.x = pk2(h.x * bflo(gv[i].x), h.y * bfhi(gv[i].x)); o.y = pk2(h.z * bflo(gv[i].y), h.w * bfhi(gv[i].y));
                *(GAS v2u*)(hg + (row0 + tb * 8 + i) * DM + chy) = o; }
        }
    }
}

__device__ __forceinline__ void headnorm_phase(const Ctx& X, const bf16* oc, const float* lqk, const float* gsub, bf16* on) {
    float d01 = lqk[X.lane] * lqk[128 + X.lane] + lqk[64 + X.lane] * lqk[192 + X.lane];
    float d23 = lqk[256 + X.lane] * lqk[384 + X.lane] + lqk[320 + X.lane] * lqk[448 + X.lane];
    d01 = wave_sum(d01); d23 = wave_sum(d23);
    const float lam = expf(d01) - expf(d23) + LAM_INIT;
    const int l32 = X.lane & 31, hsel = X.lane >> 5;
    const f32x4 gs0 = *(const GAS f32x4*)(gsub + 8 * l32) * (1.0f - LAM_INIT), gs1 = *(const GAS f32x4*)(gsub + 8 * l32 + 4) * (1.0f - LAM_INIT);
    for (int w4 = X.gw; w4 < M / 4; w4 += X.NGW) {
#pragma unroll 1
        for (int rr = 0; rr < 4; ++rr) { const size_t row = (size_t)w4 * 4 + rr;
            v4u a0[4], a1[4];
#pragma unroll
            for (int hp = 0; hp < 4; ++hp) { const size_t o = row * 4096 + (size_t)(2 * hp + hsel) * 512 + 8 * l32; a0[hp] = *(const GAS v4u*)(oc + o); a1[hp] = *(const GAS v4u*)(oc + o + 256); }
#pragma unroll
            for (int hp = 0; hp < 4; ++hp) {
                f32x4 o0 = {bflo(a0[hp].x) - lam * bflo(a1[hp].x), bfhi(a0[hp].x) - lam * bfhi(a1[hp].x), bflo(a0[hp].y) - lam * bflo(a1[hp].y), bfhi(a0[hp].y) - lam * bfhi(a1[hp].y)};
                f32x4 o1 = {bflo(a0[hp].z) - lam * bflo(a1[hp].z), bfhi(a0[hp].z) - lam * bfhi(a1[hp].z), bflo(a0[hp].w) - lam * bflo(a1[hp].w), bfhi(a0[hp].w) - lam * bfhi(a1[hp].w)};
                float ss = ((o0.x * o0.x + o0.y * o0.y) + (o0.z * o0.z + o0.w * o0.w)) + ((o1.x * o1.x + o1.y * o1.y) + (o1.z * o1.z + o1.w * o1.w));
#pragma unroll
                for (int s = 1; s < 32; s <<= 1) ss += __shfl_xor(ss, s);
                const float rs = 1.0f / sqrtf(ss * (1.0f / VD) + NORM_EPS);
                o0 = o0 * rs * gs0; o1 = o1 * rs * gs1;
                v4u w; w.x = pk2(o0.x, o0.y); w.y = pk2(o0.z, o0.w); w.z = pk2(o1.x, o1.y); w.w = pk2(o1.z, o1.w);
                *(GAS v4u*)(on + row * DM + (size_t)(2 * hp + hsel) * VD + 8 * l32) = w; }
        }
    }
}

__device__ __forceinline__ void attn_phase(const Ctx& X, const bf16* Q, const bf16* K, const bf16* V, bf16* O, char* lds) {
    for (int L = X.vcu; L < 512; L += X.G) {
        const int idx = L >> 4, x = L & 15, b = idx >> 4, hd = (idx >> 1) & 7, c = idx & 1;
#pragma unroll 1
        for (int pass = 0; pass < 2; ++pass) { const int qb = pass ? 31 - x : x;
            attn_pc::Block it;
            it.Q = (Q + ((size_t)((b * 8 + hd) * 2 + c) * SEQ + (size_t)qb * 128) * 128);
            it.K = (K + (size_t)((b * 8 + hd) * 2 + c) * SEQ * 128);
            it.V0 = (V + (size_t)((b * 8 + hd) * 2 + 0) * SEQ * 128);
            it.V1 = (V + (size_t)((b * 8 + hd) * 2 + 1) * SEQ * 128);
            it.O = (O + ((size_t)b * SEQ + (size_t)qb * 128) * 4096 + hd * 512 + c * 256);
            it.P0 = qb * 128;
            attn_pc::block(it, lds); }
    }
}
struct Args { const float* in[24]; float* out; unsigned char* ws; int ph_lo, ph_hi; };
typedef const Args __attribute__((address_space(4)))* ArgP;
__device__ __forceinline__ Ctx make_ctx(LAS unsigned char* lds) {
    Ctx X; X.lds = lds; int t = threadIdx.x; asm volatile("" : "+v"(t));
    X.tid = t; X.lane = t & 63; X.wave = __builtin_amdgcn_readfirstlane(t >> 6);
    X.G = gridDim.x; { const int bx = blockIdx.x; X.vcu = (X.G % 8 == 0) ? (bx % 8) * (X.G / 8) + bx / 8 : bx; }
    X.gw = X.vcu * NWAVES + X.wave; X.NGW = X.G * NWAVES; return X;
}
__global__ void __launch_bounds__(NWAVES * 64, 2) trunk_fwd(Args args_by_value) {
    extern __shared__ __attribute__((aligned(16))) unsigned char lds[];
    LAS unsigned char* const ldsb = (LAS unsigned char*)lds;
    volatile LAS unsigned* MISC = (volatile LAS unsigned*)(ldsb + MISC_OFF);
    ArgP ap0 = (ArgP)__builtin_amdgcn_kernarg_segment_ptr();
    for (int u = threadIdx.x; u < (LDS_BYTES - LDSCTL_OFF) / 4; u += NWAVES * 64) ((LAS unsigned*)(ldsb + LDSCTL_OFF))[u] = 0u;
    __syncthreads();
    const int lo = ap0->ph_lo; int hi = ap0->ph_hi;
    XcdBarrier bar; bar.bar = (unsigned*)(ap0->ws + WS_CTL) + CW_BAR; bar.x = 0; bar.st = nullptr;
    if (!MK_PER_PHASE) bar = xcd_barrier_post((unsigned*)(ap0->ws + WS_CTL) + CW_BAR, MISC + 8);
#define GRID_BAR() do { if (!MK_PER_PHASE) xcd_barrier(bar); } while (0)
#ifndef PH_MASK
#define PH_MASK 0xFFFFFFFFu
#endif
#define IN(k) (((PH_MASK >> (k)) & 1u) && lo <= (k) && (k) < hi)
#define SEAM(k) do { if (lo <= (k) + 1 && (k) + 1 < hi) GRID_BAR(); } while (0)
#ifndef REP_MASK
#define REP_MASK 0u
#endif
#ifdef PROBE_STAMP_LO
    unsigned long long pt0 = 0ull, pt1 = 0ull, pc0 = 0ull, pc1 = 0ull;
#define STAMP_BEGIN(k) do { if ((k) == PROBE_STAMP_LO && blockIdx.x == 0) { pt0 = __builtin_amdgcn_s_memrealtime(); pc0 = __builtin_amdgcn_s_memtime(); } } while (0)
#define STAMP_END(k) do { if ((k) == PROBE_STAMP_HI && blockIdx.x == 0) { pt1 = __builtin_amdgcn_s_memrealtime(); pc1 = __builtin_amdgcn_s_memtime(); } } while (0)
#else
#define STAMP_BEGIN(k) do { } while (0)
#define STAMP_END(k) do { } while (0)
#endif
#define PHASE(k, ...) STAMP_BEGIN(k); if (IN(k)) { PH_BEGIN(k); __VA_ARGS__ } if (((REP_MASK >> (k)) & 1u) && IN(k)) { GRID_BAR(); { PH_BEGIN(k); __VA_ARGS__ } } if ((k) + 1 < NPH) SEAM(k); STAMP_END(k);
#define PH_BEGIN(k) asm volatile("; ===PHASE " #k); const Ctx X = make_ctx(ldsb); ArgP ap = ap0; asm volatile("" : "+s"(ap)); InTab in = (InTab)ap; unsigned char* const ws = ap->ws; (void)in; (void)ws; (void)X
#define WSF(off) ((float*)(ws + (off)))
#define WSB(off) ((bf16*)(ws + (off)))
#define MODV(l, j, k) ((const float*)WSF(WS_MOD) + (size_t)(l) * NMOD + ((j) * 3 + (k)) * DM)
#define GAIN(l, i) (in[4] + ((l) * 6 + (i)) * DM)
#ifndef SWIGLU_SP2
#define SWIGLU_SP2 true
#endif
#define GEMM_SWIGLU(mi) do { pg8::Gemm g{WSB(WS_H), WSB(WS_WFIN) + (size_t)(mi) * 2 * DFF * DM, M, 2 * DFF, DM, DM, 0}; pg8::StaticOrder S; S.init(M, 2 * DFF, X.G, (int)blockIdx.x); \
        pg8::EpiSwiglu E{WSB(WS_ACT), DFF}; pg8::gemm_phase<pg8::EpiSwiglu, pg8::StaticOrder, true, SWIGLU_SP2>(X.lds + RING_OFF, g, S, E); } while (0)
#define GEMM_F32(Aop, Wt, Kdim) do { pg8::Gemm g{Aop, Wt, M, DM, Kdim, Kdim, 0}; pg8::StaticOrder S; S.init(M, DM, X.G, (int)blockIdx.x); \
        pg8::EpiF32 E{WSF(WS_Y), DM}; pg8::gemm_phase<pg8::EpiF32, pg8::StaticOrder, false>(X.lds + RING_OFF, g, S, E); } while (0)
#define NORM(xin_, y_, xout_, h1_, h2_, wgt_, gpost_, gate_, gpre1_, scale1_, shift1_, gpre2_, scale2_, shift2_) do { \
        NormArgs a{xin_, y_, xout_, h1_, h2_, wgt_, gpost_, gate_, gpre1_, scale1_, shift1_, gpre2_, scale2_, shift2_}; norm_phase(X, a); } while (0)

#define OFFP(p_, bo_) ((p_) ? (p_) + (bo_) : nullptr)
#define GEMM_NORM(bank, Aop, Wt, Kdim, xin_, xout_, h1_, h2_, wgt_, gpost_, gate_, gpre1_, scale1_, shift1_, gpre2_, scale2_, shift2_) do { \
        if (X.G == 256) { pg8::Gemm g{Aop, Wt, M, DM, Kdim, Kdim, 0}; pg8::StaticOrder S; S.init(M, DM, X.G, (int)blockIdx.x); \
            pg8::Unit u0; (void)S.next(0, u0); const size_t bo = (size_t)(u0.pm >> 4) * NMODT; \
            pg8::RowStats s1{WSF(WS_XSLOT) + (size_t)(2 * (bank)) * 65536, bar}; \
            pg8::RowStats s2{WSF(WS_XSLOT) + (size_t)(2 * (bank) + 1) * 65536, bar}; \
            pg8::EpiNorm E{xin_, xout_, h1_, h2_, wgt_, gpost_, (gate_) + bo, gpre1_, OFFP(scale1_, bo), OFFP(shift1_, bo), gpre2_, OFFP(scale2_, bo), OFFP(shift2_, bo), s1, s2}; \
            pg8::gemm_phase<pg8::EpiNorm, pg8::StaticOrder, false>(X.lds + RING_OFF, g, S, E); } \
        else { GEMM_F32(Aop, Wt, Kdim); GRID_BAR(); NORM(xin_, WSF(WS_Y), xout_, h1_, h2_, wgt_, gpost_, gate_, gpre1_, scale1_, shift1_, gpre2_, scale2_, shift2_); } } while (0)
#define NOF ((const float*)nullptr)
#define NOB ((bf16*)nullptr)

#ifdef PROBE_HI2
    for (int pass = 0; pass < 2; ++pass) { if (pass == 1) { GRID_BAR(); hi = PROBE_HI2; }
#endif
    PHASE(0, p0_prologue(X, in, ws);)
    PHASE(1, p1_modreduce(X, WSF(WS_MODP), in[3], in[18], WSF(WS_MOD), in[11], in[13], in[14], WSF(WS_GC));)
    PHASE(2, norm0_phase(X, in[0], WSB(WS_H), GAIN(0, 0), MODV(0, 0, 1), MODV(0, 0, 0));)
    PHASE(3, GEMM_SWIGLU(0);)
    PHASE(4, GEMM_NORM(0, WSB(WS_ACT), WSB(WS_WFOUT) + (size_t)0 * DM * DFF, DFF, in[0], WSF(WS_XS), WSB(WS_H), NOB, 0.5f, GAIN(0, 1), MODV(0, 0, 2), GAIN(0, 2), MODV(0, 1, 1), MODV(0, 1, 0), NOF, NOF, NOF);)
    PHASE(5, pg8::Gemm g{WSB(WS_H), WSB(WS_WLIN), M, 2 * DM, DM, DM, 0}; pg8::StaticOrder S; S.init(M, 2 * DM, X.G, (int)blockIdx.x);
        pg8::EpiLruIn E{WSB(WS_YG), WSB(WS_XR), DM, DM / 256}; pg8::gemm_phase<pg8::EpiLruIn, pg8::StaticOrder, true>(X.lds + RING_OFF, g, S, E);)
    PHASE(6, conv_phase(X, WSB(WS_XR), in[8], in[9], WSB(WS_XRC));)
    PHASE(7, int kdim = LRUB; asm volatile("" : "+s"(kdim));
        pg8::Gemm g{WSB(WS_XRC), WSB(WS_WG), M, 2 * DM, kdim, DM, LRUB}; pg8::StaticOrder S; S.init(M, 2 * DM, X.G, (int)blockIdx.x);
        pg8::EpiGates E{WSB(WS_XRC), (unsigned*)(ws + WS_A), DM, WSF(WS_GC)}; pg8::gemm_phase<pg8::EpiGates, pg8::StaticOrder, true>(X.lds + RING_OFF, g, S, E);)
    PHASE(8, scan_a_phase(X, (const unsigned*)(ws + WS_A), WSF(WS_AGP), WSF(WS_AGH), WSF(WS_SAGP), WSF(WS_SAGH));)
    PHASE(9, scan_b_phase(X, (const unsigned*)(ws + WS_A), WSF(WS_AGP), WSF(WS_AGH), WSF(WS_SAGP), WSF(WS_SAGH), WSB(WS_YG), WSB(WS_HG));)
    PHASE(10, GEMM_NORM(1, WSB(WS_HG), WSB(WS_WLOUT), DM, WSF(WS_XS), WSF(WS_XS), WSB(WS_H), NOB, 1.0f, GAIN(0, 3), MODV(0, 1, 2), GAIN(0, 4), MODV(0, 2, 1), MODV(0, 2, 0), NOF, NOF, NOF);)
    PHASE(11, GEMM_SWIGLU(1);)
    PHASE(12, GEMM_NORM(2, WSB(WS_ACT), WSB(WS_WFOUT) + (size_t)1 * DM * DFF, DFF, WSF(WS_XS), WSF(WS_XS), WSB(WS_H), WSB(WS_HKV), 0.5f, GAIN(0, 5), MODV(0, 2, 2), GAIN(1, 0), MODV(1, 0, 1), MODV(1, 0, 0),
                        in[16], WSF(WS_MOD) + 2 * NMOD + DM, WSF(WS_MOD) + 2 * NMOD);)
    PHASE(13, { pg8::Gemm g{WSB(WS_HKV), WSB(WS_WKV), M, 2 * DM, DM, DM, 0}; pg8::StaticOrder S; S.init(M, 2 * DM, X.G, (int)blockIdx.x);
          pg8::EpiHead E{WSB(WS_K), WSB(WS_V), 8, SEQ}; pg8::gemm_phase<pg8::EpiHead, pg8::StaticOrder, true>(X.lds + RING_OFF, g, S, E); }
        GEMM_SWIGLU(2);)
    PHASE(14, GEMM_NORM(3, WSB(WS_ACT), WSB(WS_WFOUT) + (size_t)2 * DM * DFF, DFF, WSF(WS_XS), WSF(WS_XS), WSB(WS_H), NOB, 0.5f, GAIN(1, 1), MODV(1, 0, 2), GAIN(1, 2), MODV(1, 1, 1), MODV(1, 1, 0), NOF, NOF, NOF);)
    PHASE(15, pg8::Gemm g{WSB(WS_H), WSB(WS_WQ), M, DM, DM, DM, 0}; pg8::StaticOrder S; S.init(M, DM, X.G, (int)blockIdx.x);
        pg8::EpiHead E{WSB(WS_Q), WSB(WS_Q), 8, SEQ}; pg8::gemm_phase<pg8::EpiHead, pg8::StaticOrder, false>(X.lds + RING_OFF, g, S, E);)
    PHASE(16, attn_phase(X, WSB(WS_Q), WSB(WS_K), WSB(WS_V), WSB(WS_OC), (char*)lds + RING_OFF);)
    PHASE(17, headnorm_phase(X, WSB(WS_OC), in[21], in[22], WSB(WS_ON));)
    PHASE(18, GEMM_NORM(4, WSB(WS_ON), WSB(WS_WO), DM, WSF(WS_XS), WSF(WS_XS), WSB(WS_H), NOB, 1.0f, GAIN(1, 3), MODV(1, 1, 2), GAIN(1, 4), MODV(1, 2, 1), MODV(1, 2, 0), NOF, NOF, NOF);)
    PHASE(19, GEMM_SWIGLU(3);)
    PHASE(20, GEMM_NORM(5, WSB(WS_ACT), WSB(WS_WFOUT) + (size_t)3 * DM * DFF, DFF, WSF(WS_XS), ap->out, NOB, NOB, 0.5f, GAIN(1, 5), MODV(1, 2, 2), NOF, NOF, NOF, NOF, NOF, NOF);)
#ifdef PROBE_HI2
    }
#endif
#ifdef PROBE_STAMP_LO
#ifdef PROBE_ATTN_SEG
    if (blockIdx.x == 0 && threadIdx.x == 0) { const unsigned long long w = (unsigned long long)(*(LAS unsigned*)(ldsb + 151552 + 512)) / 8ull, te = __builtin_amdgcn_s_memrealtime();
#elif defined(PROBE_CLOCK)
    if (blockIdx.x == 0 && threadIdx.x == 0) { const unsigned long long w = ((pc1 - pc0) * 100ull / (pt1 - pt0)) * 50ull, te = __builtin_amdgcn_s_memrealtime();
#else
    if (blockIdx.x == 0 && threadIdx.x == 0) { const unsigned long long w = (pt1 - pt0) * (unsigned long long)PROBE_MULT, te = __builtin_amdgcn_s_memrealtime();
#endif
        while (__builtin_amdgcn_s_memrealtime() - te < w) __builtin_amdgcn_s_sleep(16); }
#endif
#ifdef PROBE_EXTRA_BARRIERS
    for (int eb = 0; eb < PROBE_EXTRA_BARRIERS; ++eb) GRID_BAR();
#endif
#undef IN
#undef SEAM
#undef GRID_BAR
}

extern "C" void kernel_launch(void* const* d_in, const int* in_sizes, int n_in, void* d_out, int out_size, void* d_ws, size_t ws_size, hipStream_t stream) {
    static int grid = 0;
    if (grid == 0) {
        if (n_in != 24 || in_sizes[0] != M * DM || out_size != M * DM || ws_size < WS_END) { fprintf(stderr, "kernel_launch: unexpected shapes (n_in %d, in0 %d, out %d, ws %zu)\n", n_in, n_in > 0 ? in_sizes[0] : -1, out_size, ws_size); grid = -1; return; }
        int dev = 0, cus = 0, per_cu = 0;
        if (hipGetDevice(&dev) != hipSuccess || hipDeviceGetAttribute(&cus, hipDeviceAttributeMultiprocessorCount, dev) != hipSuccess) { fprintf(stderr, "kernel_launch: device query failed\n"); grid = -1; return; }
        if (hipFuncSetAttribute((const void*)trunk_fwd, hipFuncAttributeMaxDynamicSharedMemorySize, LDS_BYTES) != hipSuccess) { fprintf(stderr, "kernel_launch: hipFuncSetAttribute failed\n"); grid = -1; return; }
        if (hipOccupancyMaxActiveBlocksPerMultiprocessor(&per_cu, (const void*)trunk_fwd, NWAVES * 64, LDS_BYTES) != hipSuccess || per_cu < 1) { fprintf(stderr, "kernel_launch: occupancy query reports %d workgroups per CU\n", per_cu); }
        (void)hipGetLastError();
        grid = cus;
    }
    if (grid < 0) return;
    if (hipMemsetAsync((char*)d_ws + WS_CTL, 0, CTL_ZERO_BYTES, stream) != hipSuccess) { fprintf(stderr, "kernel_launch: hipMemsetAsync failed\n"); return; }
    Args a{};
    for (int i = 0; i < 24; ++i) a.in[i] = (const float*)d_in[i];
    a.out = (float*)d_out; a.ws = (unsigned char*)d_ws;
#if MK_PER_PHASE
    for (int p = 0; p <= MK_STOP_AFTER; ++p) { a.ph_lo = p; a.ph_hi = p + 1; hipLaunchKernelGGL(trunk_fwd, dim3(grid), dim3(NWAVES * 64), LDS_BYTES, stream, a); }
#else
    a.ph_lo = 0; a.ph_hi = MK_STOP_AFTER + 1;
    hipLaunchKernelGGL(trunk_fwd, dim3(grid), dim3(NWAVES * 64), LDS_BYTES, stream, a);
#endif
    const hipError_t le = hipPeekAtLastError();
    if (le != hipSuccess) fprintf(stderr, "kernel_launch: launch failed: %s\n", hipGetErrorName(le));
}
```

```cpp
#include <hip/hip_runtime.h>
#include <hip/hip_bf16.h>
#include <cstdio>
#include <cstdint>
#define MK_PER_PHASE 0
constexpr int NWAVES = 8;
constexpr int NPH = 21;
#ifndef MK_PER_PHASE
#define MK_PER_PHASE 0
#endif
#ifndef MK_STOP_AFTER
#define MK_STOP_AFTER (NPH - 1)
#endif

constexpr int BATCH = 2, SEQ = 4096, DM = 2048, M = BATCH * SEQ, DFF = 6144, NMOD = 18432, NMODT = 2 * NMOD + 4096;
constexpr int NH = 8, VD = 256, LRUB = 256;
constexpr float NORM_EPS = 1e-6f;
constexpr float LAM_INIT = 0.35550906759096315f;

constexpr size_t MiB = 1u << 20;
constexpr size_t WS_CTL = 0, CTL_ZERO_BYTES = 1 * MiB;
constexpr size_t WS_MODP = 2 * MiB, WS_MOD = 8 * MiB, WS_AGP = 9 * MiB, WS_AGH = 11 * MiB, WS_SAGP = 13 * MiB, WS_SAGH = 14 * MiB, WS_GC = 15 * MiB;
constexpr size_t WS_WG = 16 * MiB, WS_WLIN = 18 * MiB, WS_WLOUT = 34 * MiB, WS_WKV = 42 * MiB, WS_WQ = 58 * MiB, WS_WO = 66 * MiB;
constexpr size_t WS_WFIN = 74 * MiB, WS_WFOUT = 266 * MiB;
constexpr size_t WS_XS = 362 * MiB, WS_Y = 426 * MiB, WS_H = 490 * MiB, WS_HKV = 522 * MiB, WS_ACT = 554 * MiB;
constexpr size_t WS_YG = 650 * MiB, WS_XR = 682 * MiB, WS_XRC = 714 * MiB, WS_A = 746 * MiB, WS_U = 810 * MiB, WS_HG = 874 * MiB;
constexpr size_t WS_Q = 906 * MiB, WS_K = 938 * MiB, WS_V = 970 * MiB, WS_OC = 1002 * MiB, WS_ON = 1066 * MiB, WS_XSLOT = 1098 * MiB, WS_END = 1102 * MiB;
constexpr int CW_BAR = 4096, CW_XCNT = 16384;

constexpr int RING_OFF = 0, RING_BYTES = 151552;
constexpr int LDSCTL_OFF = RING_BYTES, MISC_OFF = LDSCTL_OFF + 320;
constexpr int LDS_BYTES = 155648;

#define GAS __attribute__((address_space(1)))
#define LAS __attribute__((address_space(3)))
typedef unsigned short bf16;
typedef unsigned v4u __attribute__((ext_vector_type(4)));
typedef unsigned v2u __attribute__((ext_vector_type(2)));
typedef float f32x4 __attribute__((ext_vector_type(4)));
#define LDS_WAIT() asm volatile("s_waitcnt lgkmcnt(0)" ::: "memory")
#define VM_WAIT() asm volatile("s_waitcnt vmcnt(0)" ::: "memory")
__device__ __forceinline__ unsigned f2bf(float f) { unsigned u = __builtin_bit_cast(unsigned, f); return (u + 0x7fffu + ((u >> 16) & 1u)) >> 16; }
__device__ __forceinline__ unsigned pk2(float lo, float hi) { return f2bf(lo) | (f2bf(hi) << 16); }
__device__ __forceinline__ float bflo(unsigned w) { return __uint_as_float(w << 16); }
__device__ __forceinline__ float bfhi(unsigned w) { return __uint_as_float(w & 0xffff0000u); }
__device__ __forceinline__ float wave_sum(float v) {
#pragma unroll
    for (int o = 1; o < 64; o <<= 1) v += __shfl_xor(v, o);
    return v;
}
__device__ __forceinline__ float silu_f(float v) { return v / (1.0f + __expf(-v)); }
#define XB_TMO      128
#define XB_XCNT(j)  (256  + 64 * (j))
#define XB_XSUB(j)  (1280 + 64 * (j))
#define XB_XGEN(j)  (2304 + 64 * (j))
#define XB_TOP      3328
#define XB_TOPGEN   3392
#define XCD_BAR_WORDS 3456
#define XB_SPIN_CAP (1u << 18)

__device__ __forceinline__ unsigned xb_ld(unsigned* p)              { return __hip_atomic_load(p, __ATOMIC_RELAXED, __HIP_MEMORY_SCOPE_AGENT); }
__device__ __forceinline__ unsigned xb_add(unsigned* p, unsigned v) { return __hip_atomic_fetch_add(p, v, __ATOMIC_RELAXED, __HIP_MEMORY_SCOPE_AGENT); }
__device__ __forceinline__ unsigned xb_xcc_id() { return (unsigned)__builtin_amdgcn_s_getreg((3 << 11) | 20) & 0xFu; }
#define XB_SPIN(cond, bar) do { unsigned _sp = 0; while (cond) { __builtin_amdgcn_s_sleep(1); \
    if ((++_sp & 255u) == 0u) { if (xb_ld(&(bar)[XB_TMO])) break; if (_sp > XB_SPIN_CAP) { atomicAdd(&(bar)[XB_TMO], 1u); break; } } } } while (0)

struct XcdBarrier {
    unsigned* bar; unsigned x;
    volatile LAS unsigned* st;
};

__device__ __forceinline__ XcdBarrier xcd_barrier_post(unsigned* bar, volatile LAS unsigned* st) {
    XcdBarrier b; b.bar = bar; b.x = xb_xcc_id(); b.st = st;
    if (threadIdx.x == 0) (void)xb_add(&bar[XB_XCNT(b.x)], 1u);
    return b;
}
__device__ __forceinline__ void xcd_barrier_complete(unsigned* bar, unsigned x, unsigned& nloc, unsigned& nx) {
    const unsigned G = gridDim.x * gridDim.y * gridDim.z;
    unsigned sum, cnt, mine, sp = 0u;
    for (;;) {
        sum = 0u; cnt = 0u; mine = 0u;
#pragma unroll
        for (unsigned j = 0; j < 16; ++j) { const unsigned c = xb_ld(&bar[XB_XCNT(j)]); sum += c; cnt += (c > 0u) ? 1u : 0u; mine = (j == x) ? c : mine; }
        if (sum == G) break;
        __builtin_amdgcn_s_sleep(1);
        if ((++sp & 255u) == 0u) { if (xb_ld(&bar[XB_TMO])) break; if (sp > XB_SPIN_CAP) { atomicAdd(&bar[XB_TMO], 1u); break; } }
    }
    nloc = mine > 0u ? mine : 1u; nx = cnt > 0u ? cnt : 1u;
}

__device__ __forceinline__ void xcd_barrier(const XcdBarrier& b) {
    asm volatile("s_waitcnt vmcnt(0)" ::: "memory");
    __syncthreads();
    if (threadIdx.x == 0) {
        unsigned* bar = b.bar;
        __builtin_amdgcn_s_waitcnt(0);
        unsigned nloc = b.st[0], nx = b.st[1];
        if (nloc == 0u) { xcd_barrier_complete(bar, b.x, nloc, nx); b.st[0] = nloc; b.st[1] = nx; }
        const unsigned old = xb_add(&bar[XB_XSUB(b.x)], 1u);
        const unsigned gen = old / nloc;
        if (old + 1u == (gen + 1u) * nloc) {
            __builtin_amdgcn_fence(__ATOMIC_RELEASE, "agent");
            asm volatile("s_waitcnt vmcnt(0)" ::: "memory");
            const unsigned og = xb_add(&bar[XB_TOP], 1u);
            const unsigned tg = og / nx;
            if (og + 1u == (tg + 1u) * nx) xb_add(&bar[XB_TOPGEN], 1u);
            else XB_SPIN(xb_ld(&bar[XB_TOPGEN]) == tg, bar);
            __builtin_amdgcn_fence(__ATOMIC_ACQUIRE, "agent");
            xb_add(&bar[XB_XGEN(b.x)], 1u);
            asm volatile("s_waitcnt vmcnt(0)" ::: "memory");
        } else {
            XB_SPIN(xb_ld(&bar[XB_XGEN(b.x)]) == gen, bar);
            __builtin_amdgcn_fence(__ATOMIC_ACQUIRE, "agent");
            asm volatile("s_waitcnt vmcnt(0)" ::: "memory");
        }
    }
    __syncthreads();
}
namespace pg8 {
#define PG8_LAS __attribute__((address_space(3)))
typedef unsigned short bf16_t;
typedef short bf16x8 __attribute__((ext_vector_type(8)));
typedef float f32x4 __attribute__((ext_vector_type(4)));
typedef float f32x2 __attribute__((ext_vector_type(2)));
typedef unsigned u32x4 __attribute__((ext_vector_type(4)));
constexpr int BM = 256, BK = 64, HALF = 128, HTB = HALF * BK * 2  , STAGE_BYTES = 8 * HTB, NXCD = 8, WGM = 8;

__host__ __device__ __forceinline__ int lds_byte(int r, int c) { const int st = (r >> 4) * 2 + (c >> 5), rr = r & 15, cc = c & 31, ob = rr * 64 + cc * 2; return st * 1024 + (ob ^ (((ob >> 9) & 1) << 5)); }
__host__ __device__ __forceinline__ void stage_rc(int b, int& R, int& C) { const int st = b / 1024, sb = b % 1024, swz = sb ^ (((sb >> 9) & 1) << 5); R = (st >> 1) * 16 + swz / 64; C = (st & 1) * 32 + (swz % 64) / 2; }
__host__ __device__ __forceinline__ int perm32(int rho) { const int n = rho >> 4, i = rho & 15; return 8 * (i >> 2) + 4 * n + (i & 3); }

struct Unit { int pm, pn; };
struct Gemm { const bf16_t* A; const bf16_t* Bt; int M, N, K, lda, agrp; };

struct StaticOrder {
    int nM, nN, nwg, G, c;
    __host__ __device__ __forceinline__ void init(int M, int N, int G_, int c_) { nM = M / BM; nN = N / BM; nwg = nM * nN; G = G_; c = c_; }
    __host__ __device__ __forceinline__ bool next(int i, Unit& u) const {
        const long L = (long)i * G + c; if (L >= nwg) return false;
        int wgid = (int)L; { const int q = nwg / NXCD, r = nwg % NXCD, xcd = wgid % NXCD, off = wgid / NXCD; wgid = (xcd < r ? xcd * (q + 1) : r * (q + 1) + (xcd - r) * q) + off; }
        const int nig = WGM * nN, gid = wgid / nig, fm = gid * WGM, gsz = (nM - fm) < WGM ? (nM - fm) : WGM;
        u.pm = fm + ((wgid % nig) % gsz); u.pn = (wgid % nig) / gsz; return true;
    }
    __device__ __forceinline__ void a_ready(const Unit&) const {}
    __device__ __forceinline__ void done(const Unit&) const {}
};

__device__ __forceinline__ unsigned cvt_pk_bf16(float lo, float hi) { unsigned r; asm volatile("v_cvt_pk_bf16_f32 %0, %1, %2" : "=v"(r) : "v"(lo), "v"(hi)); return r; }
__device__ __forceinline__ float bf_lo(unsigned w) { return __uint_as_float(w << 16); }
__device__ __forceinline__ float bf_hi(unsigned w) { return __uint_as_float(w & 0xffff0000u); }
__device__ __forceinline__ float sigmoidf_(float v) { return __builtin_amdgcn_rcpf(1.0f + __builtin_amdgcn_exp2f(-1.4426950408889634f * v)); }
__device__ __forceinline__ float siluf_(float v) { return v * sigmoidf_(v); }
__device__ __forceinline__ float gelu_tanh_(float v) { const float t = 1.5957691216057308f * (v + 0.044715f * v * v * v); return v * sigmoidf_(t); }

struct EpiF32 {
    static constexpr bool PERM = false, AFTER_DRAIN = false;
    float* C; int ldc;
    __device__ __forceinline__ void operator()(const f32x4 (&acc)[2][2][4][2], const Unit& u, int wr, int wc, int fr, int fq) const {
        const int row0 = u.pm * BM + wr * 64 + fr, col0 = u.pn * BM + wc * 32 + 4 * fq;
#pragma unroll
        for (int ai = 0; ai < 2; ++ai)
#pragma unroll
            for (int m = 0; m < 4; ++m) { float* rowp = C + (size_t)(row0 + ai * HALF + m * 16) * ldc + col0;
#pragma unroll
                for (int bj = 0; bj < 2; ++bj)
#pragma unroll
                    for (int n = 0; n < 2; ++n) *(f32x4*)(rowp + bj * HALF + n * 16) = acc[ai][bj][m][n]; }
    }
};
struct EpiBf16 {
    static constexpr bool PERM = true, AFTER_DRAIN = false;
    bf16_t* O; int ldc; int split_cols; size_t split_stride;
    __device__ __forceinline__ void operator()(const f32x4 (&acc)[2][2][4][2], const Unit& u, int wr, int wc, int fr, int fq) const {
        const int row0 = u.pm * BM + wr * 64 + fr; int colt = u.pn * BM; bf16_t* base = O;
        if (split_cols) { const int t = colt / split_cols; base += (size_t)t * split_stride; colt -= t * split_cols; }
        const int col0 = colt + wc * 32 + 8 * fq;
#pragma unroll
        for (int ai = 0; ai < 2; ++ai)
#pragma unroll
            for (int m = 0; m < 4; ++m) { bf16_t* rowp = base + (size_t)(row0 + ai * HALF + m * 16) * ldc + col0;
#pragma unroll
                for (int bj = 0; bj < 2; ++bj) { const f32x4 v0 = acc[ai][bj][m][0], v1 = acc[ai][bj][m][1];
                    u32x4 w; w.x = cvt_pk_bf16(v0[0], v0[1]); w.y = cvt_pk_bf16(v0[2], v0[3]); w.z = cvt_pk_bf16(v1[0], v1[1]); w.w = cvt_pk_bf16(v1[2], v1[3]);
                    *(u32x4*)(rowp + bj * HALF) = w; } }
    }
};
struct EpiHead {
    static constexpr bool PERM = true, AFTER_DRAIN = false;
    bf16_t* O0; bf16_t* O1; int hsplit; int seq;
    __device__ __forceinline__ void operator()(const f32x4 (&acc)[2][2][4][2], const Unit& u, int wr, int wc, int fr, int fq) const {
        const bool second = u.pn >= hsplit; bf16_t* base = second ? O1 : O0; const int head = second ? u.pn - hsplit : u.pn;
        const int row0 = u.pm * BM + wr * 64 + fr, d0 = wc * 32 + 8 * fq;
#pragma unroll
        for (int ai = 0; ai < 2; ++ai)
#pragma unroll
            for (int m = 0; m < 4; ++m) { const int r = row0 + ai * HALF + m * 16, b = r / seq, sidx = r - b * seq;
#pragma unroll
                for (int bj = 0; bj < 2; ++bj) { const f32x4 v0 = acc[ai][bj][m][0], v1 = acc[ai][bj][m][1];
                    u32x4 w; w.x = cvt_pk_bf16(v0[0], v0[1]); w.y = cvt_pk_bf16(v0[2], v0[3]); w.z = cvt_pk_bf16(v1[0], v1[1]); w.w = cvt_pk_bf16(v1[2], v1[3]);
                    *(u32x4*)(base + ((size_t)((b * 8 + head) * 2 + bj) * seq + sidx) * 128 + d0) = w; } }
    }
};
struct EpiSwiglu {
    static constexpr bool PERM = true, AFTER_DRAIN = false;
    bf16_t* O; int ldc;
    __device__ __forceinline__ void operator()(const f32x4 (&acc)[2][2][4][2], const Unit& u, int wr, int wc, int fr, int fq) const {
        const int row0 = u.pm * BM + wr * 64 + fr, col0 = u.pn * HALF + wc * 32 + 8 * fq;
#pragma unroll
        for (int ai = 0; ai < 2; ++ai)
#pragma unroll
            for (int m = 0; m < 4; ++m) { bf16_t* rowp = O + (size_t)(row0 + ai * HALF + m * 16) * ldc + col0;
                float o[8];
#pragma unroll
                for (int n = 0; n < 2; ++n)
#pragma unroll
                    for (int i = 0; i < 4; ++i) o[4 * n + i] = siluf_(acc[ai][0][m][n][i]) * acc[ai][1][m][n][i];
                u32x4 w; w.x = cvt_pk_bf16(o[0], o[1]); w.y = cvt_pk_bf16(o[2], o[3]); w.z = cvt_pk_bf16(o[4], o[5]); w.w = cvt_pk_bf16(o[6], o[7]);
                *(u32x4*)rowp = w; }
    }
};
struct EpiLruIn {
    static constexpr bool PERM = true, AFTER_DRAIN = false;
    bf16_t* O0; bf16_t* O1; int ldc; int nsplit;
    __device__ __forceinline__ void operator()(const f32x4 (&acc)[2][2][4][2], const Unit& u, int wr, int wc, int fr, int fq) const {
        const bool act = u.pn < nsplit; bf16_t* base = act ? O0 : O1;
        const int row0 = u.pm * BM + wr * 64 + fr, col0 = (act ? u.pn : u.pn - nsplit) * BM + wc * 32 + 8 * fq;
#pragma unroll
        for (int ai = 0; ai < 2; ++ai)
#pragma unroll
            for (int m = 0; m < 4; ++m) { bf16_t* rowp = base + (size_t)(row0 + ai * HALF + m * 16) * ldc + col0;
#pragma unroll
                for (int bj = 0; bj < 2; ++bj) { f32x4 v0 = acc[ai][bj][m][0], v1 = acc[ai][bj][m][1];
                    if (act) {
#pragma unroll
                        for (int i = 0; i < 4; ++i) { v0[i] = gelu_tanh_(v0[i]); v1[i] = gelu_tanh_(v1[i]); } }
                    u32x4 w; w.x = cvt_pk_bf16(v0[0], v0[1]); w.y = cvt_pk_bf16(v0[2], v0[3]); w.z = cvt_pk_bf16(v1[0], v1[1]); w.w = cvt_pk_bf16(v1[2], v1[3]);
                    *(u32x4*)(rowp + bj * HALF) = w; } }
    }
};
__device__ __forceinline__ float neg_expm1_(float z) {
    const float s = -z * (1.0f + z * (0.5f + z * (0.16666667f + z * (0.041666668f + z * (0.008333334f + z * 0.0013888889f)))));
    const float d = 1.0f - __builtin_amdgcn_exp2f(1.4426950408889634f * z);
    return z > -0.5f ? s : d;
}
struct EpiGates {
    static constexpr bool PERM = true, AFTER_DRAIN = false;
    const bf16_t* X; unsigned* AU; int ldc; const float* gc;
    __device__ __forceinline__ void operator()(const f32x4 (&acc)[2][2][4][2], const Unit& u, int wr, int wc, int fr, int fq) const {
        const int row0 = u.pm * BM + wr * 64 + fr, grp0 = (u.pn >> 1) * BM + (u.pn & 1) * HALF + wc * 32, ch0 = grp0 + 8 * fq;
        f32x4 ba[2], bx[2], sp8[2];
#pragma unroll
        for (int n = 0; n < 2; ++n) { ba[n] = *(const f32x4*)(gc + ch0 + 4 * n); bx[n] = *(const f32x4*)(gc + ldc + ch0 + 4 * n); sp8[n] = *(const f32x4*)(gc + 2 * ldc + ch0 + 4 * n); }
#pragma unroll
        for (int ai = 0; ai < 2; ++ai)
#pragma unroll
            for (int m = 0; m < 4; ++m) { const size_t rowoff = (size_t)(row0 + ai * HALF + m * 16) * ldc;
                const u32x4 xw = *(const u32x4*)(X + rowoff + ch0);
#pragma unroll
                for (int n = 0; n < 2; ++n) {
                    const unsigned w0 = n ? xw.z : xw.x, w1 = n ? xw.w : xw.y;
                    const f32x4 xv = {bf_lo(w0), bf_hi(w0), bf_lo(w1), bf_hi(w1)};
                    u32x4 pw;
#pragma unroll
                    for (int e = 0; e < 4; ++e) { const float r = sigmoidf_(acc[ai][0][m][n][e] + ba[n][e]), ig = sigmoidf_(acc[ai][1][m][n][e] + bx[n][e]), la = -sp8[n][e] * r;
                        pw[e] = cvt_pk_bf16(1.4426950408889634f * la, __builtin_sqrtf(neg_expm1_(2.0f * la)) * (ig * xv[e])); }
                    *(u32x4*)(AU + rowoff + grp0 + 16 * n + 4 * fq) = pw; }
                asm volatile("" ::: "memory"); }
    }
};
struct RowStats {
    float* slots; XcdBarrier bar;
    __device__ __forceinline__ void run(const f32x4 (&v)[2][2][4][2], const Unit& u, int wr, int wc, int fr, int fq, PG8_LAS unsigned char* lds, int wid, int lane) const {
        PG8_LAS float* P = (PG8_LAS float*)lds;
        PG8_LAS float* S = (PG8_LAS float*)(lds + 4096);
#pragma unroll
        for (int ai = 0; ai < 2; ++ai)
#pragma unroll
            for (int m = 0; m < 4; ++m) {
                float s = 0.f;
#pragma unroll
                for (int bj = 0; bj < 2; ++bj)
#pragma unroll
                    for (int n = 0; n < 2; ++n) { const f32x4 x = v[ai][bj][m][n]; s += (x[0] * x[0] + x[1] * x[1]) + (x[2] * x[2] + x[3] * x[3]); }
                s += __shfl_xor(s, 16); s += __shfl_xor(s, 32);
                if (fq == 0) P[(ai * HALF + wr * 64 + m * 16 + fr) * 4 + wc] = s;
            }
        asm volatile("s_waitcnt lgkmcnt(0)" ::: "memory"); __builtin_amdgcn_s_barrier(); asm volatile("" ::: "memory");
        const int row = wid * 32 + (lane & 31);
        if (lane < 32) slots[(size_t)(u.pm * BM + row) * 8 + u.pn] = (P[row * 4 + 0] + P[row * 4 + 1]) + (P[row * 4 + 2] + P[row * 4 + 3]);
        xcd_barrier(bar);
        if (lane < 32) {
            const f32x4 s0 = *(const f32x4*)(slots + (size_t)(u.pm * BM + row) * 8), s1 = *(const f32x4*)(slots + (size_t)(u.pm * BM + row) * 8 + 4);
            const float tot = ((s0[0] + s0[1]) + (s0[2] + s0[3])) + ((s1[0] + s1[1]) + (s1[2] + s1[3]));
            S[row] = 1.0f / __builtin_sqrtf(tot * (1.0f / 2048.0f) + 1e-6f);
        }
        asm volatile("s_waitcnt vmcnt(0) lgkmcnt(0)" ::: "memory"); __builtin_amdgcn_s_barrier(); asm volatile("" ::: "memory");
    }
};
typedef unsigned u32x2v __attribute__((ext_vector_type(2)));
__device__ __forceinline__ void store_h8(bf16_t* p  , const u32x2v (&w)[2], int fq) {
    const bool odd = (fq & 1) != 0;
    const u32x2v snd = odd ? w[0] : w[1]; u32x2v rcv; rcv.x = (unsigned)__shfl_xor((int)snd.x, 16); rcv.y = (unsigned)__shfl_xor((int)snd.y, 16);
    u32x4 o; if (odd) { o.x = rcv.x; o.y = rcv.y; o.z = w[1].x; o.w = w[1].y; } else { o.x = w[0].x; o.y = w[0].y; o.z = rcv.x; o.w = rcv.y; }
    *(u32x4*)(p + (odd ? 12 : 0)) = o;
}
struct EpiNorm {
    static constexpr bool PERM = false, AFTER_DRAIN = true;
    const float* xin; float* xout; bf16_t* h1; bf16_t* h2; float wgt;
    const float *gpost, *gate, *gpre1, *scale1, *shift1, *gpre2, *scale2, *shift2;
    RowStats st1, st2;
    __device__ __forceinline__ void fused(f32x4 (&acc)[2][2][4][2], const Unit& u, int wr, int wc, int fr, int fq, PG8_LAS unsigned char* lds, int wid, int lane) const {
        const PG8_LAS float* S = (const PG8_LAS float*)(lds + 4096);
        const int col0 = u.pn * BM + wc * 32 + 4 * fq;
        f32x4 pre[4][2][2];
#pragma unroll
        for (int m = 0; m < 4; ++m) { const size_t off = (size_t)(u.pm * BM + wr * 64 + m * 16 + fr) * 2048 + col0;
#pragma unroll
            for (int bj = 0; bj < 2; ++bj)
#pragma unroll
                for (int n = 0; n < 2; ++n) pre[m][bj][n] = *(const f32x4*)(xin + off + bj * HALF + n * 16); }
        st1.run(acc, u, wr, wc, fr, fq, lds, wid, lane);
        {
            f32x4 ca[2][2];
#pragma unroll
            for (int bj = 0; bj < 2; ++bj)
#pragma unroll
                for (int n = 0; n < 2; ++n) ca[bj][n] = *(const f32x4*)(gate + col0 + bj * HALF + n * 16) * *(const f32x4*)(gpost + col0 + bj * HALF + n * 16) * wgt;
#pragma unroll
            for (int ai = 0; ai < 2; ++ai)
#pragma unroll
                for (int m = 0; m < 4; ++m) { const int r = ai * HALF + wr * 64 + m * 16 + fr; const float rs = S[r]; const size_t off = (size_t)(u.pm * BM + r) * 2048 + col0;
#pragma unroll
                    for (int bj = 0; bj < 2; ++bj)
#pragma unroll
                        for (int n = 0; n < 2; ++n) { const f32x4 bs = ai == 0 ? pre[m][bj][n] : *(const f32x4*)(xin + off + bj * HALF + n * 16); acc[ai][bj][m][n] = bs + ca[bj][n] * (acc[ai][bj][m][n] * rs); }
                    asm volatile("" : "+v"(acc[ai][0][m][0]), "+v"(acc[ai][0][m][1]), "+v"(acc[ai][1][m][0]), "+v"(acc[ai][1][m][1]));
                    if (m & 1) asm volatile("" ::: "memory"); }
        }
        if (h1 == nullptr && h2 == nullptr) {
#pragma unroll
            for (int ai = 0; ai < 2; ++ai)
#pragma unroll
                for (int m = 0; m < 4; ++m) { const int r = ai * HALF + wr * 64 + m * 16 + fr; const size_t off = (size_t)(u.pm * BM + r) * 2048 + col0;
#pragma unroll
                    for (int bj = 0; bj < 2; ++bj)
#pragma unroll
                        for (int n = 0; n < 2; ++n) *(f32x4*)(xout + off + bj * HALF + n * 16) = acc[ai][bj][m][n]; }
            return;
        }
        st2.run(acc, u, wr, wc, fr, fq, lds, wid, lane);
        {
            f32x4 cb[2][2], cc[2][2];
#pragma unroll
            for (int bj = 0; bj < 2; ++bj)
#pragma unroll
                for (int n = 0; n < 2; ++n) { cb[bj][n] = *(const f32x4*)(gpre1 + col0 + bj * HALF + n * 16) * (*(const f32x4*)(scale1 + col0 + bj * HALF + n * 16) + 1.0f); cc[bj][n] = *(const f32x4*)(shift1 + col0 + bj * HALF + n * 16); }
#pragma unroll
            for (int ai = 0; ai < 2; ++ai)
#pragma unroll
                for (int m = 0; m < 4; ++m) { const int r = ai * HALF + wr * 64 + m * 16 + fr; const float rs = S[r]; const size_t off = (size_t)(u.pm * BM + r) * 2048 + col0;
#pragma unroll
                    for (int bj = 0; bj < 2; ++bj) { u32x2v w[2];
#pragma unroll
                        for (int n = 0; n < 2; ++n) { const f32x4 x1 = acc[ai][bj][m][n]; *(f32x4*)(xout + off + bj * HALF + n * 16) = x1;
                            const f32x4 o = (x1 * rs) * cb[bj][n] + cc[bj][n]; w[n].x = cvt_pk_bf16(o[0], o[1]); w[n].y = cvt_pk_bf16(o[2], o[3]); }
                        store_h8(h1 + off + bj * HALF, w, fq); }
                    asm volatile("" ::: "memory"); }
        }
        if (h2 != nullptr) {
            f32x4 cb[2][2], cc[2][2];
#pragma unroll
            for (int bj = 0; bj < 2; ++bj)
#pragma unroll
                for (int n = 0; n < 2; ++n) { cb[bj][n] = *(const f32x4*)(gpre2 + col0 + bj * HALF + n * 16) * (*(const f32x4*)(scale2 + col0 + bj * HALF + n * 16) + 1.0f); cc[bj][n] = *(const f32x4*)(shift2 + col0 + bj * HALF + n * 16); }
#pragma unroll
            for (int ai = 0; ai < 2; ++ai)
#pragma unroll
                for (int m = 0; m < 4; ++m) { const int r = ai * HALF + wr * 64 + m * 16 + fr; const float rs = S[r]; const size_t off = (size_t)(u.pm * BM + r) * 2048 + col0;
#pragma unroll
                    for (int bj = 0; bj < 2; ++bj) { u32x2v w[2];
#pragma unroll
                        for (int n = 0; n < 2; ++n) { const f32x4 o = (acc[ai][bj][m][n] * rs) * cb[bj][n] + cc[bj][n]; w[n].x = cvt_pk_bf16(o[0], o[1]); w[n].y = cvt_pk_bf16(o[2], o[3]); }
                        store_h8(h2 + off + bj * HALF, w, fq); }
                    asm volatile("" ::: "memory"); }
        }
    }
};
template <class Epi, class Sched, bool ALIGN_EPI, bool SP2 = true>
__device__ __forceinline__ void gemm_phase(PG8_LAS unsigned char* lds, const Gemm g, const Sched& S, const Epi& E) {
    int tid = threadIdx.x; asm volatile("" : "+v"(tid)); const int wid = __builtin_amdgcn_readfirstlane(tid >> 6), lane = tid & 63, wr = wid >> 2, wc = wid & 3, fr = lane & 15, fq = lane >> 4;
    const int K = g.K, nt = K / BK, lda = g.lda;
    unsigned voffA[2], voffB[2];
#pragma unroll
    for (int i = 0; i < 2; ++i) { int R, C; stage_rc(tid * 16 + i * 8192, R, C); const int Rb = Epi::PERM ? ((R & ~31) + perm32(R & 31)) : R;
        voffA[i] = (unsigned)(R * lda + C) * 2u; voffB[i] = (unsigned)(Rb * BK + C) * 2u; }
    const size_t kstep = (size_t)(BK * 2), kstepB = (size_t)BM * BK * 2;
    const size_t hstepA = (size_t)HALF * lda * 2, hstepB = (size_t)HALF * BK * 2;
    const size_t tstepA = 2 * hstepA, tstepB = (size_t)BM * K * 2;
    const unsigned ldsw = (unsigned)wid * 1024u;
    const int aoff = lds_byte(wr * 64 + fr, fq * 8), boff = lds_byte(wc * 32 + fr, fq * 8);
#define PG8_SA(b, h) (((b) * 2 + (h)) * HTB)
#define PG8_SB(b, h) ((4 + (b) * 2 + (h)) * HTB)
#define PG8_STAGE(bufoff, gbase, voff) do { _Pragma("unroll") for (int _i = 0; _i < 2; ++_i) \
        __builtin_amdgcn_global_load_lds((const unsigned*)((const char*)(gbase) + (voff)[_i]), (PG8_LAS unsigned*)(lds + (bufoff) + ldsw + _i * 8192), 16, 0, 0); } while (0)
#define PG8_LDA(dst, b, h) do { _Pragma("unroll") for (int m = 0; m < 4; ++m) _Pragma("unroll") for (int k = 0; k < 2; ++k) dst[m][k] = *(const PG8_LAS bf16x8*)(lds + PG8_SA(b, h) + aoff + m * 2048 + k * 1024); } while (0)
#define PG8_LDB(dst, b, h) do { _Pragma("unroll") for (int n = 0; n < 2; ++n) _Pragma("unroll") for (int k = 0; k < 2; ++k) dst[n][k] = *(const PG8_LAS bf16x8*)(lds + PG8_SB(b, h) + boff + n * 2048 + k * 1024); } while (0)
#define PG8_MMA(ai, bj, At, Bt) do { __builtin_amdgcn_s_setprio(1); _Pragma("unroll") for (int m = 0; m < 4; ++m) _Pragma("unroll") for (int n = 0; n < 2; ++n) _Pragma("unroll") for (int k = 0; k < 2; ++k) \
        acc[ai][bj][m][n] = __builtin_amdgcn_mfma_f32_16x16x32_bf16(Bt[n][k], At[m][k], acc[ai][bj][m][n], 0, 0, 0); __builtin_amdgcn_s_setprio(0); } while (0)
#define PG8_WAIT_V(n) asm volatile("s_waitcnt vmcnt(" #n ")" ::: "memory")
#define PG8_WAIT_L(n) asm volatile("s_waitcnt lgkmcnt(" #n ")" ::: "memory")
#define PG8_BAR __builtin_amdgcn_s_barrier()
#define PG8_SCHED __builtin_amdgcn_sched_barrier(0)
#define PG8_APTR(u_) ((const char*)g.A + (size_t)(u_).pm * tstepA + (size_t)(((u_).pn >> 1) * g.agrp) * 2)
#define PG8_BPTR(u_) ((const char*)g.Bt + (size_t)(u_).pn * tstepB)
    Unit cur, nxt; int ui = 0;
    if (!S.next(0, cur)) return;
    f32x4 acc[2][2][4][2];
#pragma unroll
    for (int a = 0; a < 2; ++a)
#pragma unroll
        for (int b = 0; b < 2; ++b)
#pragma unroll
            for (int m = 0; m < 4; ++m)
#pragma unroll
                for (int n = 0; n < 2; ++n) acc[a][b][m][n] = (f32x4){0.f, 0.f, 0.f, 0.f};
    bf16x8 At[4][2], B0[2][2], B1[2][2];
    const char* cA = PG8_APTR(cur); const char* cB = PG8_BPTR(cur);
    S.a_ready(cur);
    if constexpr (SP2) {
    PG8_STAGE(PG8_SB(0, 0), cB, voffB); PG8_STAGE(PG8_SB(0, 1), cB + hstepB, voffB); PG8_STAGE(PG8_SA(0, 0), cA, voffA); PG8_STAGE(PG8_SA(0, 1), cA + hstepA, voffA);
    if (wr == 1) PG8_BAR;
    PG8_WAIT_V(2); PG8_BAR;
    } else {
    PG8_STAGE(PG8_SB(0, 0), cB, voffB); PG8_STAGE(PG8_SA(0, 0), cA, voffA); PG8_STAGE(PG8_SB(0, 1), cB + hstepB, voffB); PG8_STAGE(PG8_SA(0, 1), cA + hstepA, voffA);
    if (wr == 1) PG8_BAR;
    PG8_WAIT_V(4); PG8_BAR;
    }
    PG8_STAGE(PG8_SB(1, 0), cB + kstepB, voffB); PG8_STAGE(PG8_SA(1, 0), cA + kstep, voffA); PG8_STAGE(PG8_SB(1, 1), cB + hstepB + kstepB, voffB);
    PG8_WAIT_V(6); PG8_BAR;
    for (;;) {
        const bool has_next = S.next(ui + 1, nxt);
        const char* nA = has_next ? PG8_APTR(nxt) : cA; const char* nB = has_next ? PG8_BPTR(nxt) : cB;
        for (int t = 0; t < nt; t += 2) {
            const bool last = (t == nt - 2);
            const char* a1 = cA + (size_t)(t + 1) * kstep;
            const char* a2 = last ? nA : cA + (size_t)(t + 2) * kstep; const char* b2 = last ? nB : cB + (size_t)(t + 2) * kstepB;
            const char* a3 = a2 + kstep; const char* b3 = b2 + kstepB;
            if (last && has_next) S.a_ready(nxt);
            if constexpr (SP2) {
            PG8_LDB(B0, 0, 0); PG8_LDB(B1, 0, 1); PG8_SCHED; PG8_LDA(At, 0, 0); PG8_STAGE(PG8_SA(1, 1), a1 + hstepA, voffA);
            PG8_WAIT_V(8); PG8_WAIT_L(0); PG8_BAR; PG8_MMA(0, 0, At, B0); PG8_MMA(0, 1, At, B1); PG8_BAR; PG8_SCHED;
            PG8_LDA(At, 0, 1); PG8_STAGE(PG8_SB(0, 0), b2, voffB); PG8_STAGE(PG8_SB(0, 1), b2 + hstepB, voffB); PG8_STAGE(PG8_SA(0, 0), a2, voffA);
            PG8_WAIT_V(8); PG8_WAIT_L(0); PG8_BAR; PG8_MMA(1, 0, At, B0); PG8_MMA(1, 1, At, B1); PG8_BAR; PG8_SCHED;
            PG8_LDB(B0, 1, 0); PG8_LDB(B1, 1, 1); PG8_SCHED; PG8_LDA(At, 1, 0); PG8_STAGE(PG8_SA(0, 1), a2 + hstepA, voffA);
            PG8_WAIT_V(8); PG8_WAIT_L(0); PG8_BAR; PG8_MMA(0, 0, At, B0); PG8_MMA(0, 1, At, B1); PG8_BAR; PG8_SCHED;
            PG8_LDA(At, 1, 1); PG8_STAGE(PG8_SB(1, 0), b3, voffB); PG8_STAGE(PG8_SB(1, 1), b3 + hstepB, voffB); PG8_STAGE(PG8_SA(1, 0), a3, voffA);
            PG8_WAIT_V(8); PG8_WAIT_L(0); PG8_BAR; PG8_MMA(1, 0, At, B0); PG8_MMA(1, 1, At, B1); PG8_BAR; PG8_SCHED;
            } else {
            PG8_LDB(B0, 0, 0); PG8_SCHED; PG8_LDA(At, 0, 0); PG8_STAGE(PG8_SA(1, 1), a1 + hstepA, voffA);
            PG8_WAIT_L(8); PG8_BAR; PG8_WAIT_L(0); PG8_MMA(0, 0, At, B0); PG8_BAR; PG8_SCHED;
            PG8_LDB(B1, 0, 1); PG8_STAGE(PG8_SB(0, 0), b2, voffB);
            PG8_BAR; PG8_WAIT_L(0); PG8_MMA(0, 1, At, B1); PG8_BAR;
            PG8_LDA(At, 0, 1); PG8_STAGE(PG8_SA(0, 0), a2, voffA);
            PG8_BAR; PG8_WAIT_L(0); PG8_MMA(1, 0, At, B0); PG8_BAR; PG8_SCHED;
            PG8_STAGE(PG8_SB(0, 1), b2 + hstepB, voffB);
            PG8_WAIT_V(6); PG8_BAR; PG8_MMA(1, 1, At, B1); PG8_BAR;
            PG8_LDB(B0, 1, 0); PG8_SCHED; PG8_LDA(At, 1, 0); PG8_STAGE(PG8_SA(0, 1), a2 + hstepA, voffA);
            PG8_WAIT_L(8); PG8_BAR; PG8_WAIT_L(0); PG8_MMA(0, 0, At, B0); PG8_BAR; PG8_SCHED;
            PG8_LDB(B1, 1, 1); PG8_STAGE(PG8_SB(1, 0), b3, voffB);
            PG8_BAR; PG8_WAIT_L(0); PG8_MMA(0, 1, At, B1); PG8_BAR;
            PG8_LDA(At, 1, 1); PG8_STAGE(PG8_SA(1, 0), a3, voffA);
            PG8_BAR; PG8_WAIT_L(0); PG8_MMA(1, 0, At, B0); PG8_BAR; PG8_SCHED;
            PG8_STAGE(PG8_SB(1, 1), b3 + hstepB, voffB);
            PG8_WAIT_V(6); PG8_BAR; PG8_MMA(1, 1, At, B1); PG8_BAR;
            }
        }
        if constexpr (ALIGN_EPI) { if (wr == 0) PG8_BAR; }
        if constexpr (!Epi::AFTER_DRAIN) { E(acc, cur, wr, wc, fr, fq); S.done(cur); }
        if (!has_next) break;
#pragma unroll
        for (int a = 0; a < 2; ++a)
#pragma unroll
            for (int b = 0; b < 2; ++b)
#pragma unroll
                for (int m = 0; m < 4; ++m)
#pragma unroll
                    for (int n = 0; n < 2; ++n) acc[a][b][m][n] = (f32x4){0.f, 0.f, 0.f, 0.f};
        cur = nxt; cA = nA; cB = nB; ++ui;
        if constexpr (ALIGN_EPI) { if (wr == 1) PG8_BAR; }
    }
    PG8_WAIT_V(0);
    if constexpr (!ALIGN_EPI) { if (wr == 0) PG8_BAR; }
    PG8_BAR;
    if constexpr (Epi::AFTER_DRAIN) { E.fused(acc, cur, wr, wc, fr, fq, lds, wid, lane); S.done(cur); }
#undef PG8_SA
#undef PG8_SB
#undef PG8_STAGE
#undef PG8_LDA
#undef PG8_LDB
#undef PG8_MMA
#undef PG8_WAIT_V
#undef PG8_WAIT_L
#undef PG8_BAR
#undef PG8_SCHED
#undef PG8_APTR
#undef PG8_BPTR
}
}
namespace attn {
using bf16 = __hip_bfloat16;
typedef short bf16x8 __attribute__((ext_vector_type(8)));
typedef short s16x4 __attribute__((ext_vector_type(4)));
typedef float f32x16 __attribute__((ext_vector_type(16)));
typedef float f32x4 __attribute__((ext_vector_type(4)));
typedef unsigned u32x4 __attribute__((ext_vector_type(4)));
template <class A, class Bt> struct same_t { static constexpr bool v = false; };
template <class A> struct same_t<A, A> { static constexpr bool v = true; };
constexpr int D = 128;
constexpr int QP = 128, KVP = 128, OP = 4096;
constexpr int CHUNKM1 = 63;
constexpr float THR = 8.f;
constexpr bool WSKIP = true;
constexpr float SCALE = 0.08838834764831845f;
constexpr int NW = 8, QBLK = 32, KVBLK = 64, QB = NW * QBLK;
constexpr int SHM_V = KVBLK * D * 2, SHM_K = KVBLK * D * 2;
constexpr int NVS = 3;
constexpr int LDS_BYTES = NVS * SHM_V + 2 * SHM_K + NW * 64 * 4;
#define KSWZ(row, colB) ((row) * 256 + ((colB) ^ (((row) & 7) << 4)))
#define SBAR() __builtin_amdgcn_sched_barrier(0)
__device__ __forceinline__ int v_st(int k, int c) { const int kk = (k & ~0xC) | ((k & 4) << 1) | ((k & 8) >> 1); return ((kk >> 3) * 4 + (c >> 5)) * 512 + ((kk & 7) * 32 + (c & 31)) * 2; }
__device__ __forceinline__ int v_rd_base(int lane) { return ((lane & 3) << 3) | (((lane >> 2) & 3) << 6) | (((lane >> 4) & 1) << 5) | (((lane >> 5) & 1) << 8); }
constexpr int v_rd_off(int d0, int ks, int half) { return d0 * 512 + ks * 4096 + half * 2048; }
__device__ __forceinline__ int crow(int r, int hi) { return (r & 3) + 8 * (r >> 2) + 4 * hi; }
__device__ __forceinline__ unsigned cvtpk(float lo, float hi) {
    unsigned r; asm volatile("v_cvt_pk_bf16_f32 %0, %1, %2" : "=v"(r) : "v"(lo), "v"(hi)); return r;
}
__device__ __forceinline__ bf16x8 pack8(f32x4 a, f32x4 b) {
    u32x4 w = {cvtpk(a[0], a[1]), cvtpk(a[2], a[3]), cvtpk(b[0], b[1]), cvtpk(b[2], b[3])};
    return *reinterpret_cast<bf16x8*>(&w);
}
template <class T> __device__ __forceinline__ bf16x8 load8(const T* p) {
    if constexpr (same_t<T, float>::v) { return pack8(*(const f32x4*)p, *(const f32x4*)(p + 4)); }
    else { return *reinterpret_cast<const bf16x8*>(p); }
}
__device__ __forceinline__ void mask_tile(f32x16& p0, f32x16& p1, int dq, unsigned W) {
    const float NEG = -__builtin_inff();
#pragma unroll
    for (int r = 0; r < 16; ++r) {
        const int c = (r & 3) + 8 * (r >> 2);
        if ((unsigned)(dq - c) >= W) p0[r] = NEG;
        if ((unsigned)(dq - c - 32) >= W) p1[r] = NEG;
    }
}
__device__ __forceinline__ void partialSM(f32x16& p0, f32x16& p1, float& m_reg, float& mn, float& alpha) {
    float pmax = p0[0]; for (int r = 1; r < 16; ++r) pmax = fmaxf(pmax, p0[r]); for (int r = 0; r < 16; ++r) pmax = fmaxf(pmax, p1[r]);
    { auto rr = __builtin_amdgcn_permlane32_swap(__float_as_uint(pmax), __float_as_uint(pmax), false, false);
      pmax = fmaxf(__uint_as_float(rr[0]), __uint_as_float(rr[1])); }
    constexpr float C2 = 1.4426950408889634f * SCALE;
    if (__builtin_expect(__all((pmax - m_reg) * SCALE <= THR), 1)) { mn = m_reg; alpha = 1.f; }
    else { mn = fmaxf(m_reg, pmax); alpha = __builtin_amdgcn_exp2f((m_reg - mn) * C2); m_reg = mn; }
    const float mnL = -mn * C2;
    for (int r = 0; r < 16; ++r) p0[r] = fmaf(p0[r], C2, mnL); for (int r = 0; r < 16; ++r) p1[r] = fmaf(p1[r], C2, mnL);
    for (int r = 0; r < 16; ++r) p0[r] = __builtin_amdgcn_exp2f(p0[r]);
}
__device__ __forceinline__ void finishSM(f32x16& p0, f32x16& p1, float alpha, float& l_reg, bf16x8& pa0, bf16x8& pa1, bf16x8& pa2, bf16x8& pa3) {
    for (int r = 0; r < 16; ++r) p1[r] = __builtin_amdgcn_exp2f(p1[r]);
    float ps = 0; for (int r = 0; r < 16; ++r) ps += p0[r]; for (int r = 0; r < 16; ++r) ps += p1[r];
    { auto rr = __builtin_amdgcn_permlane32_swap(__float_as_uint(ps), __float_as_uint(ps), false, false);
      ps = __uint_as_float(rr[0]) + __uint_as_float(rr[1]); }
    l_reg = l_reg * alpha + ps;
#define PK4(P, B_, OUT) do { unsigned a0 = cvtpk(P[B_+0], P[B_+1]), a1 = cvtpk(P[B_+2], P[B_+3]);                          \
        unsigned b0 = cvtpk(P[B_+4], P[B_+5]), b1 = cvtpk(P[B_+6], P[B_+7]);                                             \
        auto r0 = __builtin_amdgcn_permlane32_swap(a0, b0, false, false); auto r1 = __builtin_amdgcn_permlane32_swap(a1, b1, false, false); \
        u32x4 w = {r0[0], r1[0], r0[1], r1[1]}; OUT = *reinterpret_cast<bf16x8*>(&w); } while (0)
    PK4(p0, 0, pa0); PK4(p0, 8, pa1); PK4(p1, 0, pa2); PK4(p1, 8, pa3);
#undef PK4
}
template <int KB, bool SK>
__device__ __forceinline__ void qkt(f32x16& p0, f32x16& p1, const char* K_lds, int r32, int hi, const bf16x8* qr, bool act) {
    if (SK && !act) { const float NEG = -__builtin_inff();
#pragma unroll
        for (int r = 0; r < 16; ++r) { p0[r] = NEG; p1[r] = NEG; } return; }
    p0 = f32x16{}; p1 = f32x16{};
    const char* kb[4];
#pragma unroll
    for (int dd = 0; dd < 4; ++dd) kb[dd] = K_lds + KB * SHM_K + KSWZ(r32, (dd * 16 + hi * 8) * 2);
#pragma unroll
    for (int d0 = 0; d0 < 8; ++d0) { const char* a = kb[d0 & 3] + (d0 >> 2) * 128;
        bf16x8 b0 = *reinterpret_cast<const bf16x8*>(a);
        bf16x8 b1 = *reinterpret_cast<const bf16x8*>(a + 32 * 256);
        p0 = __builtin_amdgcn_mfma_f32_32x32x16_bf16(b0, qr[d0], p0, 0, 0, 0);
        p1 = __builtin_amdgcn_mfma_f32_32x32x16_bf16(b1, qr[d0], p1, 0, 0, 0); }
}
template <int VB, bool SK>
__device__ __forceinline__ void pv_tile(f32x16* o, int vb0, bf16x8 pa0, bf16x8 pa1, bf16x8 pa2, bf16x8 pa3, bool act) {
    if (SK && !act) return;
#define TRRD(dst, off) asm volatile("ds_read_b64_tr_b16 %0, %1 offset:%2" : "=&v"(dst) : "v"(vb0), "i"(off) : "memory")
#define PV_D0(d0) do { s16x4 l0, l1, l2, l3, h0, h1, h2, h3; constexpr int b_ = VB * SHM_V + v_rd_off(d0, 0, 0);     \
        TRRD(l0, b_); TRRD(h0, b_ + 2048); TRRD(l1, b_ + 4096); TRRD(h1, b_ + 6144); TRRD(l2, b_ + 8192); TRRD(h2, b_ + 10240); TRRD(l3, b_ + 12288); TRRD(h3, b_ + 14336); \
        asm volatile("s_waitcnt lgkmcnt(0)" ::: "memory"); SBAR();                 \
        o[d0] = __builtin_amdgcn_mfma_f32_32x32x16_bf16(pa0, (bf16x8){l0[0], l0[1], l0[2], l0[3], h0[0], h0[1], h0[2], h0[3]}, o[d0], 0, 0, 0);   \
        o[d0] = __builtin_amdgcn_mfma_f32_32x32x16_bf16(pa1, (bf16x8){l1[0], l1[1], l1[2], l1[3], h1[0], h1[1], h1[2], h1[3]}, o[d0], 0, 0, 0);   \
        o[d0] = __builtin_amdgcn_mfma_f32_32x32x16_bf16(pa2, (bf16x8){l2[0], l2[1], l2[2], l2[3], h2[0], h2[1], h2[2], h2[3]}, o[d0], 0, 0, 0);   \
        o[d0] = __builtin_amdgcn_mfma_f32_32x32x16_bf16(pa3, (bf16x8){l3[0], l3[1], l3[2], l3[3], h3[0], h3[1], h3[2], h3[3]}, o[d0], 0, 0, 0); } while (0)
    PV_D0(0); PV_D0(1); PV_D0(2); PV_D0(3);
#undef PV_D0
#undef TRRD
}

template <class TIn, class TOut> struct BlockRef { const TIn* Q; const TIn* K; const TIn* V; TOut* O; int P0; };
template <class TIn> struct Seam {
    bf16x8 qr[8];
    bf16x8 st_v0, st_v1, st_k0, st_k1; f32x4 sf0, sf1, sf2, sf3;
    f32x4 tq[16];
};
__device__ __forceinline__ int swa_jlo(int P0, int W) { const int lowk = P0 - W + 1; return lowk > 0 ? lowk / KVBLK : 0; }
#define ROW(p, k0, rr) ((p) + (size_t)((k0) + (rr)) * KVP + sc)
#define VMW() asm volatile("s_waitcnt vmcnt(0)" ::: "memory")
#define VMWN(n) asm volatile("s_waitcnt vmcnt(%0)" :: "i"(n) : "memory")
#define SLOAD_H(Kp, Vp, k0) do { S.st_v0 = load8<TIn>(ROW(Vp, k0, sr)); S.st_v1 = load8<TIn>(ROW(Vp, k0, 32 + sr));              \
                         S.st_k0 = load8<TIn>(ROW(Kp, k0, sr)); S.st_k1 = load8<TIn>(ROW(Kp, k0, 32 + sr)); } while (0)
#define SWRITE_HK(bf) do { *(bf16x8*)(K_lds + (bf) * SHM_K + kws) = S.st_k0; *(bf16x8*)(K_lds + (bf) * SHM_K + kws + 32 * 256) = S.st_k1; } while (0)
#define SWRITE_HV(bf) do { *(bf16x8*)(V_lds + (bf) * SHM_V + vst0) = S.st_v0; *(bf16x8*)(V_lds + (bf) * SHM_V + vst1) = S.st_v1; } while (0)
#define SWRITE_H(bf) do { SWRITE_HV(bf); SWRITE_HK(bf); } while (0)
#define SLOAD_F(p, k0) do { S.sf0 = *(const f32x4*)ROW(p, k0, sr); S.sf1 = *(const f32x4*)(ROW(p, k0, sr) + 4);                \
                            S.sf2 = *(const f32x4*)ROW(p, k0, 32 + sr); S.sf3 = *(const f32x4*)(ROW(p, k0, 32 + sr) + 4); } while (0)
#define SWRITE_KF(bf) do { *(bf16x8*)(K_lds + (bf) * SHM_K + kws) = pack8(S.sf0, S.sf1); *(bf16x8*)(K_lds + (bf) * SHM_K + kws + 32 * 256) = pack8(S.sf2, S.sf3); } while (0)
#define SWRITE_VF(bf) do { *(bf16x8*)(V_lds + (bf) * SHM_V + vst0) = pack8(S.sf0, S.sf1); *(bf16x8*)(V_lds + (bf) * SHM_V + vst1) = pack8(S.sf2, S.sf3); } while (0)
template <class TIn, class TOut>
__device__ __forceinline__ void causal_swa_prime(const BlockRef<TIn, TOut>& cur, int W, char* lds, Seam<TIn>& S) {
    constexpr bool F32 = same_t<TIn, float>::v;
    int tid = threadIdx.x; asm volatile("" : "+v"(tid)); const int wid = __builtin_amdgcn_readfirstlane(tid >> 6), lane = tid & 63, r32 = lane & 31, hi = lane >> 5;
    const int sr = tid >> 4, sc = (tid & 15) * 8, kws = KSWZ(sr, sc * 2); char* K_lds = lds + NVS * SHM_V;
    const int kb0 = swa_jlo(cur.P0, W) * KVBLK;
    for (int d0 = 0; d0 < 8; ++d0) S.qr[d0] = load8<TIn>(cur.Q + (size_t)(wid * QBLK + r32) * QP + d0 * 16 + hi * 8);
    if constexpr (F32) { SLOAD_F((const float*)cur.K, kb0); VMW(); SWRITE_KF(0); SBAR(); SLOAD_F((const float*)cur.V, kb0); }
    else { SLOAD_H(cur.K, cur.V, kb0); VMW(); SWRITE_HK(0); }
    __syncthreads();
}
template <class TIn, class TOut>
__device__ __forceinline__ void causal_swa_block(const BlockRef<TIn, TOut>& cur, const BlockRef<TIn, TOut>& nxt, int skv, int W, char* lds, Seam<TIn>& S) {
    constexpr bool F32 = same_t<TIn, float>::v;
    int tid = threadIdx.x; asm volatile("" : "+v"(tid)); const int wid = __builtin_amdgcn_readfirstlane(tid >> 6), lane = tid & 63, r32 = lane & 31, hi = lane >> 5;
    const int j_lo = swa_jlo(cur.P0, W);
    int j_hi = (cur.P0 + QB - 1) / KVBLK + 1; if (j_hi > skv / KVBLK) j_hi = skv / KVBLK;
    const int NT = j_hi - j_lo;
    const int kbn = swa_jlo(nxt.P0, W) * KVBLK;
    const int qlo = (cur.P0 + wid * QBLK) | (CHUNKM1), qm = qlo - 4 * hi;
    char* V_lds = lds; char* K_lds = lds + NVS * SHM_V;
    float* ws = (float*)(lds + NVS * SHM_V + 2 * SHM_K) + wid * 64; float* li_l = ws, * al_l = ws + 32;
    float m_reg = -1e30f, l_reg = 0; f32x16 o[4] = {};
    const int sr = tid >> 4, sc = (tid & 15) * 8, vst0 = v_st(sr, sc), vst1 = v_st(32 + sr, sc), kws = KSWZ(sr, sc * 2);
    const int vb0 = (int)(uintptr_t)V_lds + v_rd_base(lane);
    const TIn* Kh = cur.K; const TIn* Vh = cur.V;
#define RESC(a) do { if (__any((a) < 1.f)) { if (hi == 0) al_l[r32] = (a); asm volatile("s_waitcnt lgkmcnt(0)" ::: "memory");              \
                     for (int d_ = 0; d_ < 4; ++d_) for (int r = 0; r < 16; ++r) o[d_][r] *= al_l[crow(r, hi)]; } } while (0)
#define KBASE(t) ((j_lo + (t)) * KVBLK)
#define ACT(t) (KBASE(t) <= qlo)
#define MASKT(P0_, P1_, t) do { const int kb_ = KBASE(t); if ((!SK || ACT(t)) && (kb_ + KVBLK - 1 > qlo || kb_ <= qlo + QBLK - 1 - W)) mask_tile(P0_, P1_, qm - kb_, (unsigned)W); } while (0)
    constexpr int NQL = F32 ? 16 : 8;
    constexpr bool SK = WSKIP && !F32;
#define SEAM_K0() do { VMWN(NQL); if constexpr (F32) { SWRITE_KF(0); SBAR(); SLOAD_F((const float*)nxt.V, kbn); } else { SWRITE_HK(0); } SBAR(); } while (0)
    f32x16 pA0, pA1, pB0, pB1; float mnA, mnB, alA, alB; bf16x8 pa0, pa1, pa2, pa3;
    if constexpr (F32) { VMW(); SWRITE_VF(0); SBAR(); } else { SWRITE_HV(0); SBAR(); }
    if (NT > 1) { if constexpr (F32) SLOAD_F((const float*)Kh, KBASE(1)); else SLOAD_H(Kh, Vh, KBASE(1)); }
    SBAR(); qkt<0, SK>(pA0, pA1, K_lds, r32, hi, S.qr, ACT(0));
    if constexpr (F32) { if (NT > 1) { VMW(); SWRITE_KF(1); SBAR(); SLOAD_F((const float*)Vh, KBASE(1)); } }
    MASKT(pA0, pA1, 0); partialSM(pA0, pA1, m_reg, mnA, alA);
    if (NT > 1) { VMW(); if constexpr (F32) { SWRITE_VF(1); SBAR(); if (NT > 2) SLOAD_F((const float*)Kh, KBASE(2)); } else SWRITE_H(1); }
    __syncthreads();
    static_assert(!F32, "the one-barrier V-ring loop is the bf16 path");
    int vs_rd = 0, vs_wr = 2 * SHM_V;
#define VS_NEXT(x) ((x) == (NVS - 1) * SHM_V ? 0 : (x) + SHM_V)
#define HALF_STEP(PX0, PX1, mnX, alX, PY0, PY1, alY, t, KB, SB) do {                                                          \
        SBAR(); qkt<KB, SK>(PX0, PX1, K_lds, r32, hi, S.qr, ACT(t));                                             \
        finishSM(PY0, PY1, alY, l_reg, pa0, pa1, pa2, pa3); SBAR();                                                           \
        if ((t) + 1 < NT) { SLOAD_H(Kh, Vh, KBASE((t) + 1)); SBAR(); }                                                        \
        pv_tile<0, SK>(o, vb0 + vs_rd, pa0, pa1, pa2, pa3, ACT((t) - 1)); MASKT(PX0, PX1, (t)); partialSM(PX0, PX1, m_reg, mnX, alX);              \
        if ((t) + 1 < NT) { VMW(); SWRITE_HK(SB); *(bf16x8*)(V_lds + vs_wr + vst0) = S.st_v0; *(bf16x8*)(V_lds + vs_wr + vst1) = S.st_v1; }      \
        RESC(alX); __syncthreads(); vs_rd = VS_NEXT(vs_rd); vs_wr = VS_NEXT(vs_wr); } while (0)
    for (int t = 1; t + 1 < NT; t += 2) {
        HALF_STEP(pB0, pB1, mnB, alB, pA0, pA1, alA, t, 1, 0);
        HALF_STEP(pA0, pA1, mnA, alA, pB0, pB1, alB, t + 1, 0, 1);
    }
    const bool even = (NT & 1) == 0;
    if (even) { SBAR(); qkt<1, SK>(pB0, pB1, K_lds, r32, hi, S.qr, ACT(NT - 1)); SBAR(); }
#define QROW(e) (nxt.Q + (size_t)(wid * QBLK + r32) * QP + ((e) >> 1) * 16 + hi * 8 + ((e) & 1) * 4)
    if constexpr (F32) { SLOAD_F((const float*)nxt.K, kbn); SBAR();
#pragma unroll
        for (int e = 0; e < 8; ++e) S.tq[e] = *(const f32x4*)QROW(e); }
    else { SLOAD_H(nxt.K, nxt.V, kbn); SBAR();
#pragma unroll
        for (int d0 = 0; d0 < 8; ++d0) S.qr[d0] = load8<TIn>(nxt.Q + (size_t)(wid * QBLK + r32) * QP + d0 * 16 + hi * 8); }
    SBAR();
    finishSM(pA0, pA1, alA, l_reg, pa0, pa1, pa2, pa3); SBAR();
    if constexpr (F32) {
#pragma unroll
        for (int e = 8; e < 16; ++e) S.tq[e] = *(const f32x4*)QROW(e); SBAR(); }
#undef QROW
    pv_tile<0, SK>(o, vb0 + ((even ? NT - 2 : NT - 1) % NVS) * SHM_V, pa0, pa1, pa2, pa3, ACT(even ? NT - 2 : NT - 1));
    if (even) { MASKT(pB0, pB1, NT - 1); partialSM(pB0, pB1, m_reg, mnB, alB); __syncthreads(); RESC(alB);
        finishSM(pB0, pB1, alB, l_reg, pa0, pa1, pa2, pa3); SBAR(); pv_tile<0, SK>(o, vb0 + ((NT - 1) % NVS) * SHM_V, pa0, pa1, pa2, pa3, ACT(NT - 1)); }
    SBAR(); SEAM_K0();
    if (hi == 0) li_l[r32] = l_reg; asm volatile("s_waitcnt lgkmcnt(0)" ::: "memory");
    float rli[16];
#pragma unroll
    for (int r = 0; r < 16; ++r) rli[r] = __builtin_amdgcn_rcpf(li_l[crow(r, hi)]);
    TOut* Ow = cur.O + (size_t)(wid * QBLK) * OP;
#pragma unroll
    for (int r = 0; r < 16; ++r) { const int orow = crow(r, hi);
#pragma unroll
        for (int d0 = 0; d0 < 4; ++d0) { const float v = o[d0][r] * rli[r];
            if constexpr (same_t<TOut, float>::v) { Ow[(size_t)orow * OP + d0 * 32 + r32] = v; }
            else { const float vn = __shfl_xor(v, 1);
                   if ((r32 & 1) == 0) *(unsigned*)(Ow + (size_t)orow * OP + d0 * 32 + r32) = cvtpk(v, vn); } } }
    if constexpr (F32) {
#pragma unroll
        for (int d0 = 0; d0 < 8; ++d0) S.qr[d0] = pack8(S.tq[2 * d0], S.tq[2 * d0 + 1]); }
    __syncthreads();
#undef RESC
#undef KBASE
#undef ACT
#undef MASKT
#undef SEAM_K0
#undef HALF_STEP
}
#undef ROW
#undef VMW
#undef VMWN
#undef SLOAD_H
#undef SWRITE_HK
#undef SWRITE_HV
#undef SWRITE_H
#undef SLOAD_F
#undef SWRITE_KF
#undef SWRITE_VF
}
namespace attn_pc {
using namespace attn;
typedef unsigned short bh16;
struct Block { const bh16* Q; const bh16* K; const bh16* V0; const bh16* V1; bh16* O; int P0; float* T; float lam; const float* gsub; };
constexpr int ONP = 2048; constexpr float LAMI = 0.35550906759096315f;
constexpr int NVSL = 3, LDS_V = 0, LDS_K = NVSL * 32768, LDS_P = LDS_K + 2 * SHM_K, LDS_S = LDS_P + 4 * 4096, PC_LDS_BYTES = LDS_S + 4 * 96 * 4;
#define PCV_RD(dst, off) asm volatile("ds_read_b64_tr_b16 %0, %1 offset:%2" : "=&v"(dst) : "v"(vb), "i"(off) : "memory")
#define PCV_RD8(F, base) do { PCV_RD(F[0], (base)); PCV_RD(F[1], (base) + 2048); PCV_RD(F[2], (base) + 4096); PCV_RD(F[3], (base) + 6144); \
                              PCV_RD(F[4], (base) + 8192); PCV_RD(F[5], (base) + 10240); PCV_RD(F[6], (base) + 12288); PCV_RD(F[7], (base) + 14336); } while (0)
#define PCV_FR(F, k) (bf16x8){F[2 * (k)][0], F[2 * (k)][1], F[2 * (k)][2], F[2 * (k)][3], F[2 * (k) + 1][0], F[2 * (k) + 1][1], F[2 * (k) + 1][2], F[2 * (k) + 1][3]}
#define PCV_MM(X, Y, FX, FY) do { \
        o[X] = __builtin_amdgcn_mfma_f32_32x32x16_bf16(pa0, PCV_FR(FX, 0), o[X], 0, 0, 0); o[Y] = __builtin_amdgcn_mfma_f32_32x32x16_bf16(pa0, PCV_FR(FY, 0), o[Y], 0, 0, 0); \
        o[X] = __builtin_amdgcn_mfma_f32_32x32x16_bf16(pa1, PCV_FR(FX, 1), o[X], 0, 0, 0); o[Y] = __builtin_amdgcn_mfma_f32_32x32x16_bf16(pa1, PCV_FR(FY, 1), o[Y], 0, 0, 0); \
        o[X] = __builtin_amdgcn_mfma_f32_32x32x16_bf16(pa2, PCV_FR(FX, 2), o[X], 0, 0, 0); o[Y] = __builtin_amdgcn_mfma_f32_32x32x16_bf16(pa2, PCV_FR(FY, 2), o[Y], 0, 0, 0); \
        o[X] = __builtin_amdgcn_mfma_f32_32x32x16_bf16(pa3, PCV_FR(FX, 3), o[X], 0, 0, 0); o[Y] = __builtin_amdgcn_mfma_f32_32x32x16_bf16(pa3, PCV_FR(FY, 3), o[Y], 0, 0, 0); } while (0)
#define PCV_WAIT() do { asm volatile("s_waitcnt lgkmcnt(0)" ::: "memory"); SBAR(); } while (0)
__device__ __forceinline__ void pv_both(f32x16 (&o)[8], int vb, bf16x8 pa0, bf16x8 pa1, bf16x8 pa2, bf16x8 pa3) {
    s16x4 A0[8], A1[8], B0[8], B1[8];
    PCV_RD8(A0, 0 * 512); PCV_RD8(A1, 16384 + 0 * 512); PCV_WAIT();
    PCV_RD8(B0, 1 * 512); PCV_RD8(B1, 16384 + 1 * 512); SBAR(); PCV_MM(0, 4, A0, A1); PCV_WAIT();
    PCV_RD8(A0, 2 * 512); PCV_RD8(A1, 16384 + 2 * 512); SBAR(); PCV_MM(1, 5, B0, B1); PCV_WAIT();
    PCV_RD8(B0, 3 * 512); PCV_RD8(B1, 16384 + 3 * 512); SBAR(); PCV_MM(2, 6, A0, A1); PCV_WAIT();
    PCV_MM(3, 7, B0, B1);
}
#undef PCV_RD
#undef PCV_RD8
#undef PCV_FR
#undef PCV_MM
#undef PCV_WAIT
template <int MODE>
__device__ __forceinline__ void block(const Block& it, char* lds) {
    int tid = threadIdx.x; asm volatile("" : "+v"(tid));
    const int wid = __builtin_amdgcn_readfirstlane(tid >> 6), lane = tid & 63, r32 = lane & 31, hi = lane >> 5;
    const bool swave = wid < 4; const int g = wid & 3;
    char* V_lds = lds + LDS_V; char* K_lds = lds + LDS_K; char* P_lds = lds + LDS_P + g * 4096;
    typedef __attribute__((address_space(3))) float lfloat; typedef __attribute__((address_space(3))) unsigned lunsigned;
    lfloat* al_l = (lfloat*)(__attribute__((address_space(3))) char*)lds + (LDS_S / 4) + g * 96; lfloat* li_l = al_l + 32; lunsigned* flag = (lunsigned*)(al_l + 64);
    const int NT = it.P0 / KVBLK + 2;
    const int nvis = it.P0 / KVBLK + (g >> 1) + 1;
#define PC_VMW() asm volatile("s_waitcnt vmcnt(0)" ::: "memory")
#define PC_BAR() asm volatile("s_waitcnt lgkmcnt(0)\n\ts_barrier" ::: "memory")
#define PC_DMA(gsrc, ldst) __builtin_amdgcn_global_load_lds((const unsigned*)(gsrc), (__attribute__((address_space(3))) unsigned*)(__attribute__((address_space(3))) char*)(ldst), 16, 0, 0)
    const int krow = lane >> 4, kpos = lane & 15;
    const int vsub = lane >> 5, vkk = (lane & 31) >> 2, vcc = (lane & 3) * 8;
#define PC_DMA_K(tt, buf, p) do { const int row_ = 4 * (p) + krow; \
        PC_DMA(it.K + (size_t)((tt) * KVBLK + row_) * D + ((kpos ^ (row_ & 7)) << 3), K_lds + (buf) * SHM_K + (p) * 1024); } while (0)
#define PC_DMA_V(tt, off, hq) do { const int st_ = 2 * ((hq) & 15) + vsub, kk_ = (st_ >> 2) * 8 + vkk, k_ = (kk_ & ~0xC) | ((kk_ & 4) << 1) | ((kk_ & 8) >> 1); \
        PC_DMA((((hq) >> 4) ? it.V1 : it.V0) + (size_t)((tt) * KVBLK + k_) * D + (st_ & 3) * 32 + vcc, V_lds + (off) + ((hq) >> 4) * 16384 + ((hq) & 15) * 1024); } while (0)
#define PC_ISSUE_S(tt, kbuf, voff) do { _Pragma("unroll") for (int j = 0; j < 4; ++j) { PC_DMA_K(tt, kbuf, 4 * g + j); PC_DMA_V(tt, voff, 4 * wid + j); } } while (0)
#define PC_ISSUE_PV(tt, voff) do { _Pragma("unroll") for (int j = 0; j < 4; ++j) PC_DMA_V(tt, voff, 4 * wid + j); } while (0)
    if (swave) {
        bf16x8 qr[8]; float l_reg = 0.f, m_reg = -1e30f; int vs_nx = 65536;
#pragma unroll
        for (int d0 = 0; d0 < 8; ++d0) qr[d0] = *reinterpret_cast<const bf16x8*>(it.Q + (size_t)(g * QBLK + r32) * D + d0 * 16 + hi * 8);
        PC_ISSUE_S(0, 0, 0); PC_VMW(); if (NT > 1) PC_ISSUE_S(1, 1, 32768);
        if (lane == 0) *flag = 0u;
        PC_BAR();
#pragma unroll 1
        for (int t = 0; t <= NT; ++t) {
            const int par = t & 1; const bool act = t < nvis;
            bf16x8 pa0 = {}, pa1 = {}, pa2 = {}, pa3 = {}; float alpha = 1.f; bool resc = false;
            if (act) {
                f32x16 p0, p1; float mn;
                qkt<0, false>(p0, p1, K_lds + par * SHM_K, r32, hi, qr, true);
                partialSM(p0, p1, m_reg, mn, alpha);
                finishSM(p0, p1, alpha, l_reg, pa0, pa1, pa2, pa3);
                resc = __any(alpha < 1.f);
            }
            PC_BAR();
            if (act) {
                bf16x8* pp = (bf16x8*)(P_lds + lane * 16); pp[0] = pa0; pp[64] = pa1; pp[128] = pa2; pp[192] = pa3;
                if (resc && hi == 0) al_l[r32] = alpha;
                if (lane == 0) *flag = resc ? 3u : 1u;
            } else { if (lane == 0) *flag = 0u; }
            PC_VMW();
            if (t + 2 < NT) PC_ISSUE_S(t + 2, par, vs_nx);
            vs_nx = (vs_nx == (NVSL - 1) * 32768) ? 0 : vs_nx + 32768;
            asm volatile("" ::: "memory");
            PC_BAR();
        }
        if (hi == 0) li_l[r32] = l_reg;
        PC_BAR();
        PC_BAR();
    } else {
        f32x16 o[8] = {};
        const int vbl = (int)(uintptr_t)V_lds + v_rd_base(lane);
        PC_ISSUE_PV(0, 0); PC_VMW(); if (NT > 1) PC_ISSUE_PV(1, 32768);
        PC_BAR();
        int vs_rd = 0, vs_wr = 65536;
#pragma unroll 1
        for (int t = 0; t <= NT; ++t) {
            asm volatile("" ::: "memory"); const unsigned f = (unsigned)__builtin_amdgcn_readfirstlane((int)*flag);
            if (f & 1u) {
                const bf16x8* pp = (const bf16x8*)(P_lds + lane * 16); const bf16x8 pa0 = pp[0], pa1 = pp[64], pa2 = pp[128], pa3 = pp[192];
                if (f & 2u) { float al[16];
#pragma unroll
                    for (int r = 0; r < 16; ++r) al[r] = al_l[crow(r, hi)];
#pragma unroll
                    for (int d_ = 0; d_ < 8; ++d_)
#pragma unroll
                        for (int r = 0; r < 16; ++r) o[d_][r] *= al[r]; }
                pv_both(o, vbl + vs_rd, pa0, pa1, pa2, pa3);
            }
            PC_BAR();
            PC_VMW(); if (t + 2 < NT) PC_ISSUE_PV(t + 2, vs_wr);
            if (t >= 1) vs_rd = (vs_rd == (NVSL - 1) * 32768) ? 0 : vs_rd + 32768;
            vs_wr = (vs_wr == (NVSL - 1) * 32768) ? 0 : vs_wr + 32768;
            PC_BAR();
        }
        PC_BAR();
        float rli[16];
#pragma unroll
        for (int r = 0; r < 16; ++r) rli[r] = __builtin_amdgcn_rcpf(li_l[crow(r, hi)]);
        float* Tw = it.T + (size_t)g * 8192 + lane * 4;
        if constexpr (MODE == 0) {
#pragma unroll
            for (int d0 = 0; d0 < 8; ++d0)
#pragma unroll
                for (int q = 0; q < 4; ++q) { const f32x4 v = {o[d0][4 * q] * rli[4 * q], o[d0][4 * q + 1] * rli[4 * q + 1], o[d0][4 * q + 2] * rli[4 * q + 2], o[d0][4 * q + 3] * rli[4 * q + 3]};
                    *(f32x4*)(Tw + (d0 * 4 + q) * 256) = v; }
        } else {
#pragma unroll
            for (int dq = 0; dq < 4; ++dq) { f32x4 tv[2][4];
#pragma unroll
                for (int dd = 0; dd < 2; ++dd)
#pragma unroll
                    for (int q = 0; q < 4; ++q) tv[dd][q] = *(const f32x4*)(Tw + ((2 * dq + dd) * 4 + q) * 256);
#pragma unroll
                for (int dd = 0; dd < 2; ++dd)
#pragma unroll
                    for (int q = 0; q < 4; ++q)
#pragma unroll
                        for (int e = 0; e < 4; ++e) o[2 * dq + dd][4 * q + e] = tv[dd][q][e] - it.lam * (o[2 * dq + dd][4 * q + e] * rli[4 * q + e]); }
            float rs[16];
#pragma unroll
            for (int r = 0; r < 16; ++r) { float ss = 0.f;
#pragma unroll
                for (int d0 = 0; d0 < 8; ++d0) ss += o[d0][r] * o[d0][r];
#pragma unroll
                for (int m = 1; m < 32; m <<= 1) ss += __shfl_xor(ss, m);
                rs[r] = 1.0f / __builtin_sqrtf(ss * (1.0f / 256.0f) + 1e-6f); }
            unsigned short* Ow = (unsigned short*)it.O + (size_t)(g * QBLK) * ONP;
            unsigned short* stg = (unsigned short*)(V_lds + g * 16384);
#pragma unroll
            for (int d0 = 0; d0 < 8; ++d0) { const float gs = it.gsub[d0 * 32 + r32] * (1.0f - LAMI);
#pragma unroll
                for (int r = 0; r < 16; ++r) { const float v = o[d0][r] * rs[r] * gs; stg[crow(r, hi) * 256 + d0 * 32 + r32] = (unsigned short)(cvtpk(v, v) & 0xffffu); } }
            asm volatile("s_waitcnt lgkmcnt(0)" ::: "memory");
#pragma unroll
            for (int i = 0; i < 16; ++i) { const int chunk = i * 64 + lane, row = chunk >> 5, cc = chunk & 31;
                const u32x4 val = *(const u32x4*)(stg + row * 256 + cc * 8);
                *(u32x4*)(Ow + (size_t)row * ONP + cc * 8) = val; }
        }
        PC_BAR();
    }
#undef PC_VMW
#undef PC_DMA
#undef PC_DMA_K
#undef PC_DMA_V
#undef PC_ISSUE_S
#undef PC_ISSUE_PV
#undef PC_BAR
}
}
struct Ctx {
    LAS unsigned char* lds;
    int tid, lane, wave, G, vcu, gw, NGW;
};

__device__ __forceinline__ void transpose_item(const float* W, int ldw, int k0, int n0, bf16* WT, int Kdst, int dst_row0, LAS float* scr, int lane) {
    {
        f32x4 v[8]; const int r = lane >> 3, n4 = (lane & 7) * 4;
#pragma unroll
        for (int i = 0; i < 8; ++i) v[i] = __builtin_nontemporal_load((const GAS f32x4*)(W + (size_t)(k0 + 8 * i + r) * ldw + n0 + n4));
#pragma unroll
        for (int i = 0; i < 8; ++i) { LAS float* d = scr + (8 * i + r) * 33 + n4; d[0] = v[i].x; d[1] = v[i].y; d[2] = v[i].z; d[3] = v[i].w; }
    }
    LDS_WAIT(); asm volatile("" ::: "memory");
    const int c = lane & 7;
#pragma unroll
    for (int j = 0; j < 4; ++j) { const int n = (lane >> 3) + 8 * j; const LAS float* s = scr + (8 * c) * 33 + n;
        v4u o; o.x = pk2(s[0 * 33], s[1 * 33]); o.y = pk2(s[2 * 33], s[3 * 33]); o.z = pk2(s[4 * 33], s[5 * 33]); o.w = pk2(s[6 * 33], s[7 * 33]);
        *(GAS v4u*)(WT + (((size_t)(dst_row0 >> 8) * (Kdst >> 6) + (k0 >> 6)) * 256 + (dst_row0 & 255) + n) * 64 + 8 * c) = o; }
    LDS_WAIT(); asm volatile("" ::: "memory");
}
typedef const float* const __attribute__((address_space(4)))* InTab;
__device__ __forceinline__ void p0_prologue(const Ctx& X, InTab in, unsigned char* ws) {
    LAS float* scr = (LAS float*)(X.lds + RING_OFF + X.wave * 16384);
    constexpr int I_MOD = (NMODT / 256) * 16;
    constexpr int I_FIN = (DM / 64) * (2 * DFF / 32), I_FOUT = (DFF / 64) * (DM / 32), I_LIN = (DM / 64) * (2 * DM / 32), I_G = 16 * 32;
    constexpr int I_SQ = (DM / 64) * (DM / 32), I_KV = (DM / 64) * (2 * DM / 32);
    constexpr int NITEMS = I_MOD + 4 * I_FIN + 4 * I_FOUT + I_LIN + I_G + I_SQ + I_KV + I_SQ + I_SQ;
    for (int it = X.gw; it < NITEMS; it += X.NGW) {
        int r = it;
        if (r < I_MOD) {
            const int cg = r >> 4, kc = r & 15; const float* W; int ldw, cc;
            if (cg < 72) { W = in[2]; ldw = NMOD; cc = cg * 256; } else if (cg < 144) { W = in[2] + (size_t)DM * NMOD; ldw = NMOD; cc = (cg - 72) * 256; } else { W = in[17]; ldw = 4096; cc = (cg - 144) * 256; }
            const int kb = kc * 128;
            float ca[2][2];
#pragma unroll
            for (int b = 0; b < 2; ++b)
#pragma unroll
                for (int hh = 0; hh < 2; ++hh) ca[b][hh] = silu_f(in[1][b * DM + kb + hh * 64 + X.lane]);
            f32x4 acc0 = {0.f, 0.f, 0.f, 0.f}, acc1 = {0.f, 0.f, 0.f, 0.f};
            const float* wp = W + (size_t)kb * ldw + cc + 4 * X.lane;
#pragma unroll
            for (int hh = 0; hh < 2; ++hh) {
#pragma unroll 16
                for (int kk = 0; kk < 64; ++kk) {
                    const f32x4 w = __builtin_nontemporal_load((const GAS f32x4*)(wp + (size_t)(hh * 64 + kk) * ldw));
                    const float s0 = __uint_as_float(__builtin_amdgcn_readlane(__float_as_uint(ca[0][hh]), kk));
                    const float s1 = __uint_as_float(__builtin_amdgcn_readlane(__float_as_uint(ca[1][hh]), kk));
                    acc0 += w * s0; acc1 += w * s1; }
            }
            *(GAS f32x4*)((float*)(ws + WS_MODP) + (size_t)(kc * 2 + 0) * NMODT + cg * 256 + 4 * X.lane) = acc0;
            *(GAS f32x4*)((float*)(ws + WS_MODP) + (size_t)(kc * 2 + 1) * NMODT + cg * 256 + 4 * X.lane) = acc1;
            continue; }
        r -= I_MOD;
        if (r < 3 * I_FOUT) { const int mi = 1 + r / I_FOUT, q = r % I_FOUT; constexpr int nblk = DM / 32; const int kb = q / nblk, nb = q % nblk;
            transpose_item(in[6] + (size_t)mi * DFF * DM, DM, 64 * kb, 32 * nb, (bf16*)(ws + WS_WFOUT) + (size_t)mi * DM * DFF, DFF, 32 * nb, scr, X.lane); continue; }
        r -= 3 * I_FOUT;
        if (r < 3 * I_FIN) {
            const int mi = 1 + r / I_FIN, q = r % I_FIN; constexpr int nblk = 2 * DFF / 32; const int kb = q / nblk, nb = q % nblk, n0 = 32 * nb;
            const int nn = n0 < DFF ? n0 : n0 - DFF; const int drow = (nn >> 7) * 256 + (n0 < DFF ? 0 : 128) + (nn & 127);
            transpose_item(in[5] + (size_t)mi * DM * 2 * DFF, 2 * DFF, 64 * kb, n0, (bf16*)(ws + WS_WFIN) + (size_t)mi * 2 * DFF * DM, DM, drow, scr, X.lane); continue; }
        r -= 3 * I_FIN;
        if (r < I_SQ) { constexpr int nblk = DM / 32; const int kb = r / nblk, nb = r % nblk; transpose_item(in[23], DM, 64 * kb, 32 * nb, (bf16*)(ws + WS_WO), DM, 32 * nb, scr, X.lane); continue; }
        r -= I_SQ;
        if (r < I_SQ) { constexpr int nblk = DM / 32; const int kb = r / nblk, nb = r % nblk; transpose_item(in[20], DM, 64 * kb, 32 * nb, (bf16*)(ws + WS_WQ), DM, 32 * nb, scr, X.lane); continue; }
        r -= I_SQ;
        if (r < I_KV) { constexpr int nblk = 2 * DM / 32; const int kb = r / nblk, nb = r % nblk; transpose_item(in[19], 2 * DM, 64 * kb, 32 * nb, (bf16*)(ws + WS_WKV), DM, 32 * nb, scr, X.lane); continue; }
        r -= I_KV;
        if (r < I_SQ) { constexpr int nblk = DM / 32; const int kb = r / nblk, nb = r % nblk; transpose_item(in[15], DM, 64 * kb, 32 * nb, (bf16*)(ws + WS_WLOUT), DM, 32 * nb, scr, X.lane); continue; }
        r -= I_SQ;
        if (r < I_G) { const int g = r >> 5, q = r & 31, head = g >> 1, which = g & 1, kb = q >> 3, nb = q & 7, n0 = 32 * nb;
            const float* W = (which ? in[12] : in[10]) + (size_t)head * LRUB * LRUB;
            const int drow = (head * 2 + (n0 >> 7)) * 256 + which * 128 + (n0 & 127);
            transpose_item(W, LRUB, 64 * kb, n0, (bf16*)(ws + WS_WG), LRUB, drow, scr, X.lane); continue; }
        r -= I_G;
        if (r < I_LIN) { constexpr int nblk = 2 * DM / 32; const int kb = r / nblk, nb = r % nblk;
            transpose_item(in[7], 2 * DM, 64 * kb, 32 * nb, (bf16*)(ws + WS_WLIN), DM, 32 * nb, scr, X.lane); continue; }
        r -= I_LIN;
        if (r < I_FOUT) { const int q = r; constexpr int nblk = DM / 32; const int kb = q / nblk, nb = q % nblk;
            transpose_item(in[6], DM, 64 * kb, 32 * nb, (bf16*)(ws + WS_WFOUT), DFF, 32 * nb, scr, X.lane); continue; }
        r -= I_FOUT;
        { const int q = r; constexpr int nblk = 2 * DFF / 32; const int kb = q / nblk, nb = q % nblk, n0 = 32 * nb;
            const int nn = n0 < DFF ? n0 : n0 - DFF; const int drow = (nn >> 7) * 256 + (n0 < DFF ? 0 : 128) + (nn & 127);
            transpose_item(in[5], 2 * DFF, 64 * kb, n0, (bf16*)(ws + WS_WFIN), DM, drow, scr, X.lane); }
    }
}
__device__ __forceinline__ void p1_modreduce(const Ctx& X, const float* modp, const float* b_mod, const float* kv_b_mod, float* mod,
                                             const float* b_a, const float* b_x, const float* lam, float* gc) {
    for (int idx = blockIdx.x * (NWAVES * 64) + X.tid; idx < 2 * NMODT; idx += X.G * NWAVES * 64) {
        const int b = idx / NMODT, col = idx % NMODT;
        float s = col < 2 * NMOD ? b_mod[col] : kv_b_mod[col - 2 * NMOD];
#pragma unroll
        for (int kc = 0; kc < 16; ++kc) s += modp[(size_t)(kc * 2 + b) * NMODT + col];
        mod[idx] = s;
    }
    for (int ch = blockIdx.x * (NWAVES * 64) + X.tid; ch < DM; ch += X.G * NWAVES * 64) {
        const float z = -lam[ch];
        gc[ch] = b_a[ch]; gc[DM + ch] = b_x[ch]; gc[2 * DM + ch] = 8.0f * (fmaxf(z, 0.f) + log1pf(expf(-fabsf(z))));
    }
}

struct NormArgs { const float* xin; const float* y; float* xout; bf16* h1; bf16* h2; float wgt;
                  const float *gpost, *gate;
                  const float *gpre1, *scale1, *shift1, *gpre2, *scale2, *shift2; };
__device__ __forceinline__ void norm_phase(const Ctx& X, const NormArgs& a) {
    LAS float* V = (LAS float*)(X.lds + RING_OFF);
    for (int it = blockIdx.x; it < M / 32; it += X.G) {
        const int b = (it * 32) / SEQ;
        for (int c = X.tid; c < DM; c += NWAVES * 64) {
            if (a.y)  V[c] = a.wgt * a.gate[(size_t)b * NMODT + c] * a.gpost[c];
            if (a.h1) { V[DM + c] = a.gpre1[c] * (1.0f + a.scale1[(size_t)b * NMODT + c]); V[2 * DM + c] = a.shift1[(size_t)b * NMODT + c]; }
            if (a.h2) { V[3 * DM + c] = a.gpre2[c] * (1.0f + a.scale2[(size_t)b * NMODT + c]); V[4 * DM + c] = a.shift2[(size_t)b * NMODT + c]; }
        }
        __syncthreads();
#pragma unroll 1
        for (int rr = 0; rr < 4; ++rr) {
            const size_t row = (size_t)it * 32 + X.wave * 4 + rr;
            f32x4 xv[8];
#pragma unroll
            for (int j = 0; j < 8; ++j) xv[j] = *(const GAS f32x4*)(a.xin + row * DM + 256 * j + 4 * X.lane);
            if (a.y) {
                f32x4 yv[8]; float ss = 0.f;
#pragma unroll
                for (int j = 0; j < 8; ++j) { yv[j] = *(const GAS f32x4*)(a.y + row * DM + 256 * j + 4 * X.lane); ss += (yv[j].x * yv[j].x + yv[j].y * yv[j].y) + (yv[j].z * yv[j].z + yv[j].w * yv[j].w); }
                const float rs = 1.0f / sqrtf(wave_sum(ss) * (1.0f / DM) + NORM_EPS);
#pragma unroll
                for (int j = 0; j < 8; ++j) { const f32x4 ca = *(const LAS f32x4*)(V + 256 * j + 4 * X.lane); xv[j] += ca * (yv[j] * rs); }
            }
            asm volatile("" ::: "memory");
            if (a.xout) {
#pragma unroll
                for (int j = 0; j < 8; ++j) *(GAS f32x4*)(a.xout + row * DM + 256 * j + 4 * X.lane) = xv[j];
            }
            if (a.h1 || a.h2) {
                float ss = 0.f;
#pragma unroll
                for (int j = 0; j < 8; ++j) ss += (xv[j].x * xv[j].x + xv[j].y * xv[j].y) + (xv[j].z * xv[j].z + xv[j].w * xv[j].w);
                const float rs = 1.0f / sqrtf(wave_sum(ss) * (1.0f / DM) + NORM_EPS);
                asm volatile("" ::: "memory");
                if (a.h1) {
#pragma unroll
                    for (int j = 0; j < 8; ++j) { const f32x4 cb = *(const LAS f32x4*)(V + DM + 256 * j + 4 * X.lane), cc = *(const LAS f32x4*)(V + 2 * DM + 256 * j + 4 * X.lane);
                        const f32x4 h = xv[j] * rs * cb + cc; v2u o; o.x = pk2(h.x, h.y); o.y = pk2(h.z, h.w);
                        *(GAS v2u*)(a.h1 + row * DM + 256 * j + 4 * X.lane) = o; }
                }
                asm volatile("" ::: "memory");
                if (a.h2) {
#pragma unroll
                    for (int j = 0; j < 8; ++j) { const f32x4 cb = *(const LAS f32x4*)(V + 3 * DM + 256 * j + 4 * X.lane), cc = *(const LAS f32x4*)(V + 4 * DM + 256 * j + 4 * X.lane);
                        const f32x4 h = xv[j] * rs * cb + cc; v2u o; o.x = pk2(h.x, h.y); o.y = pk2(h.z, h.w);
                        *(GAS v2u*)(a.h2 + row * DM + 256 * j + 4 * X.lane) = o; }
                }
            }
        }
        __syncthreads();
    }
}

__device__ __forceinline__ void norm0_phase(const Ctx& X, const float* xin, bf16* h1, const float* gpre1, const float* scale1, const float* shift1) {
    LAS float* V = (LAS float*)(X.lds + RING_OFF);
    for (int it = blockIdx.x; it < M / 32; it += X.G) {
        const int b = (it * 32) / SEQ;
        f32x4 xv[4][4][2];
#pragma unroll
        for (int rr = 0; rr < 4; ++rr) { const size_t row = (size_t)it * 32 + X.wave * 4 + rr;
#pragma unroll
            for (int j = 0; j < 4; ++j) { xv[rr][j][0] = *(const GAS f32x4*)(xin + row * DM + 512 * j + 8 * X.lane); xv[rr][j][1] = *(const GAS f32x4*)(xin + row * DM + 512 * j + 8 * X.lane + 4); } }
        for (int c = X.tid; c < DM; c += NWAVES * 64) { V[c] = gpre1[c] * (1.0f + scale1[(size_t)b * NMODT + c]); V[DM + c] = shift1[(size_t)b * NMODT + c]; }
        __syncthreads();
#pragma unroll
        for (int rr = 0; rr < 4; ++rr) { const size_t row = (size_t)it * 32 + X.wave * 4 + rr;
            float ss = 0.f;
#pragma unroll
            for (int j = 0; j < 4; ++j)
#pragma unroll
                for (int e = 0; e < 2; ++e) { const f32x4 v = xv[rr][j][e]; ss += (v.x * v.x + v.y * v.y) + (v.z * v.z + v.w * v.w); }
            const float rs = 1.0f / sqrtf(wave_sum(ss) * (1.0f / DM) + NORM_EPS);
#pragma unroll
            for (int j = 0; j < 4; ++j) { v4u o;
#pragma unroll
                for (int e = 0; e < 2; ++e) { const f32x4 cb = *(const LAS f32x4*)(V + 512 * j + 8 * X.lane + 4 * e), cc = *(const LAS f32x4*)(V + DM + 512 * j + 8 * X.lane + 4 * e);
                    const f32x4 h = xv[rr][j][e] * rs * cb + cc; if (e == 0) { o.x = pk2(h.x, h.y); o.y = pk2(h.z, h.w); } else { o.z = pk2(h.x, h.y); o.w = pk2(h.z, h.w); } }
                *(GAS v4u*)(h1 + row * DM + 512 * j + 8 * X.lane) = o; }
            asm volatile("" ::: "memory");
        }
        __syncthreads();
    }
}

__device__ __forceinline__ void conv_phase(const Ctx& X, const bf16* xr, const float* cw, const float* cb, bf16* xrc) {
    for (int w4 = X.gw; w4 < M / 4; w4 += X.NGW) {
        const int row0 = 4 * w4, t0 = row0 % SEQ;
#pragma unroll 1
        for (int j = 0; j < 4; ++j) {
            const int ch0 = j * 512 + 8 * X.lane;
            float wv[4][8], bv[8];
#pragma unroll
            for (int k = 0; k < 4; ++k) { const f32x4 w0 = *(const GAS f32x4*)(cw + k * DM + ch0), w1 = *(const GAS f32x4*)(cw + k * DM + ch0 + 4);
                wv[k][0] = w0.x; wv[k][1] = w0.y; wv[k][2] = w0.z; wv[k][3] = w0.w; wv[k][4] = w1.x; wv[k][5] = w1.y; wv[k][6] = w1.z; wv[k][7] = w1.w; }
            { const f32x4 b0 = *(const GAS f32x4*)(cb + ch0), b1 = *(const GAS f32x4*)(cb + ch0 + 4); bv[0] = b0.x; bv[1] = b0.y; bv[2] = b0.z; bv[3] = b0.w; bv[4] = b1.x; bv[5] = b1.y; bv[6] = b1.z; bv[7] = b1.w; }
            float xin[7][8];
#pragma unroll
            for (int i = 0; i < 7; ++i) {
                v4u w = {0u, 0u, 0u, 0u};
                if (t0 - 3 + i >= 0) w = *(const GAS v4u*)(xr + (size_t)(row0 - 3 + i) * DM + ch0);
                xin[i][0] = bflo(w.x); xin[i][1] = bfhi(w.x); xin[i][2] = bflo(w.y); xin[i][3] = bfhi(w.y); xin[i][4] = bflo(w.z); xin[i][5] = bfhi(w.z); xin[i][6] = bflo(w.w); xin[i][7] = bfhi(w.w); }
#pragma unroll
            for (int r = 0; r < 4; ++r) { float o[8];
#pragma unroll
                for (int e = 0; e < 8; ++e) { float s = bv[e];
#pragma unroll
                    for (int k = 0; k < 4; ++k) s += wv[k][e] * xin[r + k][e];
                    o[e] = s; }
                v4u w; w.x = pk2(o[0], o[1]); w.y = pk2(o[2], o[3]); w.z = pk2(o[4], o[5]); w.w = pk2(o[6], o[7]);
                *(GAS v4u*)(xrc + (size_t)(row0 + r) * DM + ch0) = w; }
        }
    }
}

__device__ __forceinline__ void scan_a_phase(const Ctx& X, const unsigned* AU, float* agp, float* agh, float* sagp, float* sagh) {
    LAS float* Pl = (LAS float*)(X.lds + RING_OFF); LAS float* Hl = Pl + 8 * 256;
    for (int bi = blockIdx.x; bi < 256; bi += X.G) {
        const int b = bi >> 7, sc = (bi >> 3) & 15, cg = bi & 7, chunk = sc * 8 + X.wave, ch = cg * 256 + 4 * X.lane;
        const size_t row0 = (size_t)b * SEQ + chunk * 32;
        f32x4 P = {1.f, 1.f, 1.f, 1.f}, H = {0.f, 0.f, 0.f, 0.f};
#pragma unroll 1
        for (int tb = 0; tb < 4; ++tb) {
            v4u wv[8];
#pragma unroll
            for (int i = 0; i < 8; ++i) wv[i] = *(const GAS v4u*)(AU + (row0 + tb * 8 + i) * DM + ch);
#pragma unroll
            for (int i = 0; i < 8; ++i) { const f32x4 a = {__builtin_amdgcn_exp2f(bflo(wv[i].x)), __builtin_amdgcn_exp2f(bflo(wv[i].y)), __builtin_amdgcn_exp2f(bflo(wv[i].z)), __builtin_amdgcn_exp2f(bflo(wv[i].w))};
                const f32x4 u = {bfhi(wv[i].x), bfhi(wv[i].y), bfhi(wv[i].z), bfhi(wv[i].w)}; H = a * H + u; P = P * a; }
        }
        *(GAS f32x4*)(agp + ((size_t)b * 128 + chunk) * DM + ch) = P; *(GAS f32x4*)(agh + ((size_t)b * 128 + chunk) * DM + ch) = H;
        *(LAS f32x4*)(Pl + X.wave * 256 + 4 * X.lane) = P; *(LAS f32x4*)(Hl + X.wave * 256 + 4 * X.lane) = H;
        __syncthreads();
        if (X.tid < 256) { float p = 1.f, h = 0.f;
#pragma unroll
            for (int w = 0; w < 8; ++w) { const float pw = Pl[w * 256 + X.tid], hw = Hl[w * 256 + X.tid]; h = pw * h + hw; p *= pw; }
            sagp[((size_t)b * 16 + sc) * DM + cg * 256 + X.tid] = p; sagh[((size_t)b * 16 + sc) * DM + cg * 256 + X.tid] = h; }
        __syncthreads();
    }
}
__device__ __forceinline__ void scan_b_phase(const Ctx& X, const unsigned* AU, const float* agp, const float* agh, const float* sagp, const float* sagh, const bf16* yg, bf16* hg) {
    for (int bi = blockIdx.x; bi < 256; bi += X.G) {
        const int b = bi >> 7, sc = (bi >> 3) & 15, cg = bi & 7, chunk = sc * 8 + X.wave, ch = cg * 256 + 4 * X.lane;
        const int chy = cg * 256 + (X.lane >> 3) * 32 + 8 * (X.lane & 3) + 4 * ((X.lane >> 2) & 1);
        const size_t row0 = (size_t)b * SEQ + chunk * 32;
        f32x4 h = {0.f, 0.f, 0.f, 0.f};
        {
            f32x4 pv[15], hv[15];
#pragma unroll
            for (int s = 0; s < 15; ++s) { const int ss = s < sc ? s : 0; pv[s] = *(const GAS f32x4*)(sagp + ((size_t)b * 16 + ss) * DM + ch); hv[s] = *(const GAS f32x4*)(sagh + ((size_t)b * 16 + ss) * DM + ch); }
#pragma unroll
            for (int s = 0; s < 15; ++s) if (s < sc) h = pv[s] * h + hv[s];
        }
        {
            f32x4 pv[7], hv[7];
#pragma unroll
            for (int w = 0; w < 7; ++w) { const int ww = w < X.wave ? w : 0; pv[w] = *(const GAS f32x4*)(agp + ((size_t)b * 128 + sc * 8 + ww) * DM + ch); hv[w] = *(const GAS f32x4*)(agh + ((size_t)b * 128 + sc * 8 + ww) * DM + ch); }
#pragma unroll
            for (int w = 0; w < 7; ++w) if (w < X.wave) h = pv[w] * h + hv[w];
        }
#pragma unroll 1
        for (int tb = 0; tb < 4; ++tb) {
            v4u wv[8]; v2u gv[8];
#pragma unroll
            for (int i = 0; i < 8; ++i) { const size_t o = (row0 + tb * 8 + i) * DM + ch; wv[i] = *(const GAS v4u*)(AU + o); gv[i] = *(const GAS v2u*)(yg + (row0 + tb * 8 + i) * DM + chy); }
#pragma unroll
            for (int i = 0; i < 8; ++i) { const f32x4 a = {__builtin_amdgcn_exp2f(bflo(wv[i].x)), __builtin_amdgcn_exp2f(bflo(wv[i].y)), __builtin_amdgcn_exp2f(bflo(wv[i].z)), __builtin_amdgcn_exp2f(bflo(wv[i].w))};
                const f32x4 u = {bfhi(wv[i].x), bfhi(wv[i].y), bfhi(wv[i].z), bfhi(wv[i].w)}; h = a * h + u;
                v2u o; o.x = pk2(h.x * bflo(gv[i].x), h.y * bfhi(gv[i].x)); o.y = pk2(h.z * bflo(gv[i].y), h.w * bfhi(gv[i].y));
                *(GAS v2u*)(hg + (row0 + tb * 8 + i) * DM + chy) = o; }
        }
    }
}

__device__ __forceinline__ void headnorm_phase(const Ctx& X, const bf16* oc, const float* lqk, const float* gsub, bf16* on) {
    float d01 = lqk[X.lane] * lqk[128 + X.lane] + lqk[64 + X.lane] * lqk[192 + X.lane];
    float d23 = lqk[256 + X.lane] * lqk[384 + X.lane] + lqk[320 + X.lane] * lqk[448 + X.lane];
    d01 = wave_sum(d01); d23 = wave_sum(d23);
    const float lam = expf(d01) - expf(d23) + LAM_INIT;
    const int l32 = X.lane & 31, hsel = X.lane >> 5;
    const f32x4 gs0 = *(const GAS f32x4*)(gsub + 8 * l32) * (1.0f - LAM_INIT), gs1 = *(const GAS f32x4*)(gsub + 8 * l32 + 4) * (1.0f - LAM_INIT);
    for (int w4 = X.gw; w4 < M / 4; w4 += X.NGW) {
#pragma unroll 1
        for (int rr = 0; rr < 4; ++rr) { const size_t row = (size_t)w4 * 4 + rr;
            v4u a0[4], a1[4];
#pragma unroll
            for (int hp = 0; hp < 4; ++hp) { const size_t o = row * 4096 + (size_t)(2 * hp + hsel) * 512 + 8 * l32; a0[hp] = *(const GAS v4u*)(oc + o); a1[hp] = *(const GAS v4u*)(oc + o + 256); }
#pragma unroll
            for (int hp = 0; hp < 4; ++hp) {
                f32x4 o0 = {bflo(a0[hp].x) - lam * bflo(a1[hp].x), bfhi(a0[hp].x) - lam * bfhi(a1[hp].x), bflo(a0[hp].y) - lam * bflo(a1[hp].y), bfhi(a0[hp].y) - lam * bfhi(a1[hp].y)};
                f32x4 o1 = {bflo(a0[hp].z) - lam * bflo(a1[hp].z), bfhi(a0[hp].z) - lam * bfhi(a1[hp].z), bflo(a0[hp].w) - lam * bflo(a1[hp].w), bfhi(a0[hp].w) - lam * bfhi(a1[hp].w)};
                float ss = ((o0.x * o0.x + o0.y * o0.y) + (o0.z * o0.z + o0.w * o0.w)) + ((o1.x * o1.x + o1.y * o1.y) + (o1.z * o1.z + o1.w * o1.w));
#pragma unroll
                for (int s = 1; s < 32; s <<= 1) ss += __shfl_xor(ss, s);
                const float rs = 1.0f / sqrtf(ss * (1.0f / VD) + NORM_EPS);
                o0 = o0 * rs * gs0; o1 = o1 * rs * gs1;
                v4u w; w.x = pk2(o0.x, o0.y); w.y = pk2(o0.z, o0.w); w.z = pk2(o1.x, o1.y); w.w = pk2(o1.z, o1.w);
                *(GAS v4u*)(on + row * DM + (size_t)(2 * hp + hsel) * VD + 8 * l32) = w; }
        }
    }
}

__device__ __forceinline__ void attn_phase(const Ctx& X, const bf16* Q, const bf16* K, const bf16* V, float* T, bf16* ON, const float* lqk, const float* gsub, char* lds) {
    float d01 = lqk[X.lane] * lqk[128 + X.lane] + lqk[64 + X.lane] * lqk[192 + X.lane];
    float d23 = lqk[256 + X.lane] * lqk[384 + X.lane] + lqk[320 + X.lane] * lqk[448 + X.lane];
    d01 = wave_sum(d01); d23 = wave_sum(d23);
    const float lam = expf(d01) - expf(d23) + LAM_INIT;
    for (int L = X.vcu; L < 512; L += X.G) {
        const int r = L >> 8, hd = (L >> 5) & 7, i = L & 31, b = r, qb = r ? 31 - i : i;
        attn_pc::Block it;
        it.V0 = (V + (size_t)((b * 8 + hd) * 2 + 0) * SEQ * 128);
        it.V1 = (V + (size_t)((b * 8 + hd) * 2 + 1) * SEQ * 128);
        it.O = (ON + ((size_t)b * SEQ + (size_t)qb * 128) * DM + hd * 256);
        it.P0 = qb * 128; it.T = T + (size_t)(((b * 8 + hd) * 32 + qb) * 4) * 8192; it.lam = lam; it.gsub = gsub;
        it.Q = (Q + ((size_t)((b * 8 + hd) * 2 + 0) * SEQ + (size_t)qb * 128) * 128); it.K = (K + (size_t)((b * 8 + hd) * 2 + 0) * SEQ * 128);
        attn_pc::block<0>(it, lds);
        it.Q = (Q + ((size_t)((b * 8 + hd) * 2 + 1) * SEQ + (size_t)qb * 128) * 128); it.K = (K + (size_t)((b * 8 + hd) * 2 + 1) * SEQ * 128);
        attn_pc::block<1>(it, lds);
    }
}
struct Args { const float* in[24]; float* out; unsigned char* ws; int ph_lo, ph_hi; };
typedef const Args __attribute__((address_space(4)))* ArgP;
__device__ __forceinline__ Ctx make_ctx(LAS unsigned char* lds) {
    Ctx X; X.lds = lds; int t = threadIdx.x; asm volatile("" : "+v"(t));
    X.tid = t; X.lane = t & 63; X.wave = __builtin_amdgcn_readfirstlane(t >> 6);
    X.G = gridDim.x; { const int bx = blockIdx.x; X.vcu = (X.G % 8 == 0) ? (bx % 8) * (X.G / 8) + bx / 8 : bx; }
    X.gw = X.vcu * NWAVES + X.wave; X.NGW = X.G * NWAVES; return X;
}
__global__ void __launch_bounds__(NWAVES * 64, 2) trunk_fwd(Args args_by_value) {
    extern __shared__ __attribute__((aligned(16))) unsigned char lds[];
    LAS unsigned char* const ldsb = (LAS unsigned char*)lds;
    volatile LAS unsigned* MISC = (volatile LAS unsigned*)(ldsb + MISC_OFF);
    ArgP ap0 = (ArgP)__builtin_amdgcn_kernarg_segment_ptr();
    for (int u = threadIdx.x; u < (LDS_BYTES - LDSCTL_OFF) / 4; u += NWAVES * 64) ((LAS unsigned*)(ldsb + LDSCTL_OFF))[u] = 0u;
    __syncthreads();
    const int lo = ap0->ph_lo; int hi = ap0->ph_hi;
    XcdBarrier bar; bar.bar = (unsigned*)(ap0->ws + WS_CTL) + CW_BAR; bar.x = 0; bar.st = nullptr;
    if (!MK_PER_PHASE) bar = xcd_barrier_post((unsigned*)(ap0->ws + WS_CTL) + CW_BAR, MISC + 8);
#define GRID_BAR() do { if (!MK_PER_PHASE) xcd_barrier(bar); } while (0)
#ifndef PH_MASK
#define PH_MASK 0xFFFFFFFFu
#endif
#define IN(k) (((PH_MASK >> (k)) & 1u) && lo <= (k) && (k) < hi)
#define SEAM(k) do { if (lo <= (k) + 1 && (k) + 1 < hi) GRID_BAR(); } while (0)
#ifndef REP_MASK
#define REP_MASK 0u
#endif
#ifdef PROBE_STAMP_LO
    unsigned long long pt0 = 0ull, pt1 = 0ull, pc0 = 0ull, pc1 = 0ull;
#define STAMP_BEGIN(k) do { if ((k) == PROBE_STAMP_LO && blockIdx.x == 0) { pt0 = __builtin_amdgcn_s_memrealtime(); pc0 = __builtin_amdgcn_s_memtime(); } } while (0)
#define STAMP_END(k) do { if ((k) == PROBE_STAMP_HI && blockIdx.x == 0) { pt1 = __builtin_amdgcn_s_memrealtime(); pc1 = __builtin_amdgcn_s_memtime(); } } while (0)
#else
#define STAMP_BEGIN(k) do { } while (0)
#define STAMP_END(k) do { } while (0)
#endif
#define PHASE(k, ...) STAMP_BEGIN(k); if (IN(k)) { PH_BEGIN(k); __VA_ARGS__ } if (((REP_MASK >> (k)) & 1u) && IN(k)) { GRID_BAR(); { PH_BEGIN(k); __VA_ARGS__ } } if ((k) + 1 < NPH) SEAM(k); STAMP_END(k);
#define PH_BEGIN(k) asm volatile("; ===PHASE " #k); const Ctx X = make_ctx(ldsb); ArgP ap = ap0; asm volatile("" : "+s"(ap)); InTab in = (InTab)ap; unsigned char* const ws = ap->ws; (void)in; (void)ws; (void)X
#define WSF(off) ((float*)(ws + (off)))
#define WSB(off) ((bf16*)(ws + (off)))
#define MODV(l, j, k) ((const float*)WSF(WS_MOD) + (size_t)(l) * NMOD + ((j) * 3 + (k)) * DM)
#define GAIN(l, i) (in[4] + ((l) * 6 + (i)) * DM)
#ifndef SWIGLU_SP2
#define SWIGLU_SP2 true
#endif
#define GEMM_SWIGLU(mi) do { pg8::Gemm g{WSB(WS_H), WSB(WS_WFIN) + (size_t)(mi) * 2 * DFF * DM, M, 2 * DFF, DM, DM, 0}; pg8::StaticOrder S; S.init(M, 2 * DFF, X.G, (int)blockIdx.x); \
        pg8::EpiSwiglu E{WSB(WS_ACT), DFF}; pg8::gemm_phase<pg8::EpiSwiglu, pg8::StaticOrder, true, SWIGLU_SP2>(X.lds + RING_OFF, g, S, E); } while (0)
#define GEMM_F32(Aop, Wt, Kdim) do { pg8::Gemm g{Aop, Wt, M, DM, Kdim, Kdim, 0}; pg8::StaticOrder S; S.init(M, DM, X.G, (int)blockIdx.x); \
        pg8::EpiF32 E{WSF(WS_Y), DM}; pg8::gemm_phase<pg8::EpiF32, pg8::StaticOrder, false>(X.lds + RING_OFF, g, S, E); } while (0)
#define NORM(xin_, y_, xout_, h1_, h2_, wgt_, gpost_, gate_, gpre1_, scale1_, shift1_, gpre2_, scale2_, shift2_) do { \
        NormArgs a{xin_, y_, xout_, h1_, h2_, wgt_, gpost_, gate_, gpre1_, scale1_, shift1_, gpre2_, scale2_, shift2_}; norm_phase(X, a); } while (0)

#define OFFP(p_, bo_) ((p_) ? (p_) + (bo_) : nullptr)
#define GEMM_NORM(bank, Aop, Wt, Kdim, xin_, xout_, h1_, h2_, wgt_, gpost_, gate_, gpre1_, scale1_, shift1_, gpre2_, scale2_, shift2_) do { \
        if (X.G == 256) { pg8::Gemm g{Aop, Wt, M, DM, Kdim, Kdim, 0}; pg8::StaticOrder S; S.init(M, DM, X.G, (int)blockIdx.x); \
            pg8::Unit u0; (void)S.next(0, u0); const size_t bo = (size_t)(u0.pm >> 4) * NMODT; \
            pg8::RowStats s1{WSF(WS_XSLOT) + (size_t)(2 * (bank)) * 65536, bar}; \
            pg8::RowStats s2{WSF(WS_XSLOT) + (size_t)(2 * (bank) + 1) * 65536, bar}; \
            pg8::EpiNorm E{xin_, xout_, h1_, h2_, wgt_, gpost_, (gate_) + bo, gpre1_, OFFP(scale1_, bo), OFFP(shift1_, bo), gpre2_, OFFP(scale2_, bo), OFFP(shift2_, bo), s1, s2}; \
            pg8::gemm_phase<pg8::EpiNorm, pg8::StaticOrder, false>(X.lds + RING_OFF, g, S, E); } \
        else { GEMM_F32(Aop, Wt, Kdim); GRID_BAR(); NORM(xin_, WSF(WS_Y), xout_, h1_, h2_, wgt_, gpost_, gate_, gpre1_, scale1_, shift1_, gpre2_, scale2_, shift2_); } } while (0)
#define NOF ((const float*)nullptr)
#define NOB ((bf16*)nullptr)

#ifdef PROBE_HI2
    for (int pass = 0; pass < 2; ++pass) { if (pass == 1) { GRID_BAR(); hi = PROBE_HI2; }
#endif
    PHASE(0, p0_prologue(X, in, ws);)
    PHASE(1, p1_modreduce(X, WSF(WS_MODP), in[3], in[18], WSF(WS_MOD), in[11], in[13], in[14], WSF(WS_GC));)
    PHASE(2, norm0_phase(X, in[0], WSB(WS_H), GAIN(0, 0), MODV(0, 0, 1), MODV(0, 0, 0));)
    PHASE(3, GEMM_SWIGLU(0);)
    PHASE(4, GEMM_NORM(0, WSB(WS_ACT), WSB(WS_WFOUT) + (size_t)0 * DM * DFF, DFF, in[0], WSF(WS_XS), WSB(WS_H), NOB, 0.5f, GAIN(0, 1), MODV(0, 0, 2), GAIN(0, 2), MODV(0, 1, 1), MODV(0, 1, 0), NOF, NOF, NOF);)
    PHASE(5, pg8::Gemm g{WSB(WS_H), WSB(WS_WLIN), M, 2 * DM, DM, DM, 0}; pg8::StaticOrder S; S.init(M, 2 * DM, X.G, (int)blockIdx.x);
        pg8::EpiLruIn E{WSB(WS_YG), WSB(WS_XR), DM, DM / 256}; pg8::gemm_phase<pg8::EpiLruIn, pg8::StaticOrder, true>(X.lds + RING_OFF, g, S, E);)
    PHASE(6, conv_phase(X, WSB(WS_XR), in[8], in[9], WSB(WS_XRC));)
    PHASE(7, int kdim = LRUB; asm volatile("" : "+s"(kdim));
        pg8::Gemm g{WSB(WS_XRC), WSB(WS_WG), M, 2 * DM, kdim, DM, LRUB}; pg8::StaticOrder S; S.init(M, 2 * DM, X.G, (int)blockIdx.x);
        pg8::EpiGates E{WSB(WS_XRC), (unsigned*)(ws + WS_A), DM, WSF(WS_GC)}; pg8::gemm_phase<pg8::EpiGates, pg8::StaticOrder, true>(X.lds + RING_OFF, g, S, E);)
    PHASE(8, scan_a_phase(X, (const unsigned*)(ws + WS_A), WSF(WS_AGP), WSF(WS_AGH), WSF(WS_SAGP), WSF(WS_SAGH));)
    PHASE(9, scan_b_phase(X, (const unsigned*)(ws + WS_A), WSF(WS_AGP), WSF(WS_AGH), WSF(WS_SAGP), WSF(WS_SAGH), WSB(WS_YG), WSB(WS_HG));)
    PHASE(10, GEMM_NORM(1, WSB(WS_HG), WSB(WS_WLOUT), DM, WSF(WS_XS), WSF(WS_XS), WSB(WS_H), NOB, 1.0f, GAIN(0, 3), MODV(0, 1, 2), GAIN(0, 4), MODV(0, 2, 1), MODV(0, 2, 0), NOF, NOF, NOF);)
    PHASE(11, GEMM_SWIGLU(1);)
    PHASE(12, GEMM_NORM(2, WSB(WS_ACT), WSB(WS_WFOUT) + (size_t)1 * DM * DFF, DFF, WSF(WS_XS), WSF(WS_XS), WSB(WS_H), WSB(WS_HKV), 0.5f, GAIN(0, 5), MODV(0, 2, 2), GAIN(1, 0), MODV(1, 0, 1), MODV(1, 0, 0),
                        in[16], WSF(WS_MOD) + 2 * NMOD + DM, WSF(WS_MOD) + 2 * NMOD);)
    PHASE(13, { pg8::Gemm g{WSB(WS_HKV), WSB(WS_WKV), M, 2 * DM, DM, DM, 0}; pg8::StaticOrder S; S.init(M, 2 * DM, X.G, (int)blockIdx.x);
          pg8::EpiHead E{WSB(WS_K), WSB(WS_V), 8, SEQ}; pg8::gemm_phase<pg8::EpiHead, pg8::StaticOrder, true>(X.lds + RING_OFF, g, S, E); }
        GEMM_SWIGLU(2);)
    PHASE(14, GEMM_NORM(3, WSB(WS_ACT), WSB(WS_WFOUT) + (size_t)2 * DM * DFF, DFF, WSF(WS_XS), WSF(WS_XS), WSB(WS_H), NOB, 0.5f, GAIN(1, 1), MODV(1, 0, 2), GAIN(1, 2), MODV(1, 1, 1), MODV(1, 1, 0), NOF, NOF, NOF);)
    PHASE(15, pg8::Gemm g{WSB(WS_H), WSB(WS_WQ), M, DM, DM, DM, 0}; pg8::StaticOrder S; S.init(M, DM, X.G, (int)blockIdx.x);
        pg8::EpiHead E{WSB(WS_Q), WSB(WS_Q), 8, SEQ}; pg8::gemm_phase<pg8::EpiHead, pg8::StaticOrder, false>(X.lds + RING_OFF, g, S, E);)
    PHASE(16, attn_phase(X, WSB(WS_Q), WSB(WS_K), WSB(WS_V), WSF(WS_OC), WSB(WS_ON), in[21], in[22], (char*)lds + RING_OFF);)
    PHASE(18, GEMM_NORM(4, WSB(WS_ON), WSB(WS_WO), DM, WSF(WS_XS), WSF(WS_XS), WSB(WS_H), NOB, 1.0f, GAIN(1, 3), MODV(1, 1, 2), GAIN(1, 4), MODV(1, 2, 1), MODV(1, 2, 0), NOF, NOF, NOF);)
    PHASE(19, GEMM_SWIGLU(3);)
    PHASE(20, GEMM_NORM(5, WSB(WS_ACT), WSB(WS_WFOUT) + (size_t)3 * DM * DFF, DFF, WSF(WS_XS), ap->out, NOB, NOB, 0.5f, GAIN(1, 5), MODV(1, 2, 2), NOF, NOF, NOF, NOF, NOF, NOF);)
#ifdef PROBE_HI2
    }
#endif
#ifdef PROBE_STAMP_LO
#ifdef PROBE_ATTN_SEG
    if (blockIdx.x == 0 && threadIdx.x == 0) { const unsigned long long w = (unsigned long long)(*(LAS unsigned*)(ldsb + 151552 + 512)) / 8ull, te = __builtin_amdgcn_s_memrealtime();
#elif defined(PROBE_CLOCK)
    if (blockIdx.x == 0 && threadIdx.x == 0) { const unsigned long long w = ((pc1 - pc0) * 100ull / (pt1 - pt0)) * 50ull, te = __builtin_amdgcn_s_memrealtime();
#else
    if (blockIdx.x == 0 && threadIdx.x == 0) { const unsigned long long w = (pt1 - pt0) * (unsigned long long)PROBE_MULT, te = __builtin_amdgcn_s_memrealtime();
#endif
        while (__builtin_amdgcn_s_memrealtime() - te < w) __builtin_amdgcn_s_sleep(16); }
#endif
#ifdef PROBE_EXTRA_BARRIERS
    for (int eb = 0; eb < PROBE_EXTRA_BARRIERS; ++eb) GRID_BAR();
#endif
#undef IN
#undef SEAM
#undef GRID_BAR
}

extern "C" void kernel_launch(void* const* d_in, const int* in_sizes, int n_in, void* d_out, int out_size, void* d_ws, size_t ws_size, hipStream_t stream) {
    static int grid = 0;
    if (grid == 0) {
        if (n_in != 24 || in_sizes[0] != M * DM || out_size != M * DM || ws_size < WS_END) { fprintf(stderr, "kernel_launch: unexpected shapes (n_in %d, in0 %d, out %d, ws %zu)\n", n_in, n_in > 0 ? in_sizes[0] : -1, out_size, ws_size); grid = -1; return; }
        int dev = 0, cus = 0, per_cu = 0;
        if (hipGetDevice(&dev) != hipSuccess || hipDeviceGetAttribute(&cus, hipDeviceAttributeMultiprocessorCount, dev) != hipSuccess) { fprintf(stderr, "kernel_launch: device query failed\n"); grid = -1; return; }
        if (hipFuncSetAttribute((const void*)trunk_fwd, hipFuncAttributeMaxDynamicSharedMemorySize, LDS_BYTES) != hipSuccess) { fprintf(stderr, "kernel_launch: hipFuncSetAttribute failed\n"); grid = -1; return; }
        if (hipOccupancyMaxActiveBlocksPerMultiprocessor(&per_cu, (const void*)trunk_fwd, NWAVES * 64, LDS_BYTES) != hipSuccess || per_cu < 1) { fprintf(stderr, "kernel_launch: occupancy query reports %d workgroups per CU\n", per_cu); }
        (void)hipGetLastError();
        grid = cus;
    }
    if (grid < 0) return;
    if (hipMemsetAsync((char*)d_ws + WS_CTL, 0, CTL_ZERO_BYTES, stream) != hipSuccess) { fprintf(stderr, "kernel_launch: hipMemsetAsync failed\n"); return; }
    Args a{};
    for (int i = 0; i < 24; ++i) a.in[i] = (const float*)d_in[i];
    a.out = (float*)d_out; a.ws = (unsigned char*)d_ws;
#if MK_PER_PHASE
    for (int p = 0; p <= MK_STOP_AFTER; ++p) { a.ph_lo = p; a.ph_hi = p + 1; hipLaunchKernelGGL(trunk_fwd, dim3(grid), dim3(NWAVES * 64), LDS_BYTES, stream, a); }
#else
    a.ph_lo = 0; a.ph_hi = MK_STOP_AFTER + 1;
    hipLaunchKernelGGL(trunk_fwd, dim3(grid), dim3(NWAVES * 64), LDS_BYTES, stream, a);
#endif
    const hipError_t le = hipPeekAtLastError();
    if (le != hipSuccess) fprintf(stderr, "kernel_launch: launch failed: %s\n", hipGetErrorName(le));
}
```

```cpp
#include <hip/hip_runtime.h>
#include <hip/hip_bf16.h>
#include <cstdio>
#include <cstdint>
#define MK_PER_PHASE 0
constexpr int NWAVES = 8;
constexpr int NPH = 21;
#ifndef MK_PER_PHASE
#define MK_PER_PHASE 0
#endif
#ifndef MK_STOP_AFTER
#define MK_STOP_AFTER (NPH - 1)
#endif

constexpr int BATCH = 2, SEQ = 4096, DM = 2048, M = BATCH * SEQ, DFF = 6144, NMOD = 18432, NMODT = 2 * NMOD + 4096;
constexpr int NH = 8, VD = 256, LRUB = 256;
constexpr float NORM_EPS = 1e-6f;
constexpr float LAM_INIT = 0.35550906759096315f;

constexpr size_t MiB = 1u << 20;
constexpr size_t WS_CTL = 0, CTL_ZERO_BYTES = 1 * MiB;
constexpr size_t WS_MODP = 2 * MiB, WS_MOD = 8 * MiB, WS_AGP = 9 * MiB, WS_AGH = 11 * MiB, WS_SAGP = 13 * MiB, WS_SAGH = 14 * MiB, WS_GC = 15 * MiB;
constexpr size_t WS_WG = 16 * MiB, WS_WLIN = 18 * MiB, WS_WLOUT = 34 * MiB, WS_WKV = 42 * MiB, WS_WQ = 58 * MiB, WS_WO = 66 * MiB;
constexpr size_t WS_WFIN = 74 * MiB, WS_WFOUT = 266 * MiB;
constexpr size_t WS_XS = 362 * MiB, WS_Y = 426 * MiB, WS_H = 490 * MiB, WS_HKV = 522 * MiB, WS_ACT = 554 * MiB;
constexpr size_t WS_YG = 650 * MiB, WS_XR = 682 * MiB, WS_XRC = 714 * MiB, WS_A = 746 * MiB, WS_U = 810 * MiB, WS_HG = 874 * MiB;
constexpr size_t WS_Q = 906 * MiB, WS_K = 938 * MiB, WS_V = 970 * MiB, WS_OC = 1002 * MiB, WS_ON = 1066 * MiB, WS_XSLOT = 1098 * MiB, WS_END = 1102 * MiB;
constexpr int CW_BAR = 4096, CW_XCNT = 16384;

constexpr int RING_OFF = 0, RING_BYTES = 151552;
constexpr int LDSCTL_OFF = RING_BYTES, MISC_OFF = LDSCTL_OFF + 320;
constexpr int LDS_BYTES = 155648;

#define GAS __attribute__((address_space(1)))
#define LAS __attribute__((address_space(3)))
typedef unsigned short bf16;
typedef unsigned v4u __attribute__((ext_vector_type(4)));
typedef unsigned v2u __attribute__((ext_vector_type(2)));
typedef float f32x4 __attribute__((ext_vector_type(4)));
#define LDS_WAIT() asm volatile("s_waitcnt lgkmcnt(0)" ::: "memory")
#define VM_WAIT() asm volatile("s_waitcnt vmcnt(0)" ::: "memory")
__device__ __forceinline__ unsigned f2bf(float f) { unsigned u = __builtin_bit_cast(unsigned, f); return (u + 0x7fffu + ((u >> 16) & 1u)) >> 16; }
typedef __bf16 bf2v_t __attribute__((ext_vector_type(2)));
typedef float f2v_t __attribute__((ext_vector_type(2)));
__device__ __forceinline__ unsigned pk2(float lo, float hi) { const f2v_t f = {lo, hi}; return __builtin_bit_cast(unsigned, __builtin_convertvector(f, bf2v_t)); }
__device__ __forceinline__ float bflo(unsigned w) { return __uint_as_float(w << 16); }
__device__ __forceinline__ float bfhi(unsigned w) { return __uint_as_float(w & 0xffff0000u); }
__device__ __forceinline__ float wave_sum(float v) {
#pragma unroll
    for (int o = 1; o < 64; o <<= 1) v += __shfl_xor(v, o);
    return v;
}
__device__ __forceinline__ float silu_f(float v) { return v / (1.0f + __expf(-v)); }
#define XB_TMO      128
#define XB_XCNT(j)  (256  + 64 * (j))
#define XB_XSUB(j)  (1280 + 64 * (j))
#define XB_XGEN(j)  (2304 + 64 * (j))
#define XB_TOP      3328
#define XB_TOPGEN   3392
#define XCD_BAR_WORDS 3456
#define XB_SPIN_CAP (1u << 18)

__device__ __forceinline__ unsigned xb_ld(unsigned* p)              { return __hip_atomic_load(p, __ATOMIC_RELAXED, __HIP_MEMORY_SCOPE_AGENT); }
__device__ __forceinline__ unsigned xb_add(unsigned* p, unsigned v) { return __hip_atomic_fetch_add(p, v, __ATOMIC_RELAXED, __HIP_MEMORY_SCOPE_AGENT); }
__device__ __forceinline__ unsigned xb_xcc_id() { return (unsigned)__builtin_amdgcn_s_getreg((3 << 11) | 20) & 0xFu; }
#define XB_SPIN(cond, bar) do { unsigned _sp = 0; while (cond) { __builtin_amdgcn_s_sleep(1); \
    if ((++_sp & 255u) == 0u) { if (xb_ld(&(bar)[XB_TMO])) break; if (_sp > XB_SPIN_CAP) { atomicAdd(&(bar)[XB_TMO], 1u); break; } } } } while (0)

struct XcdBarrier {
    unsigned* bar; unsigned x;
    volatile LAS unsigned* st;
};

__device__ __forceinline__ XcdBarrier xcd_barrier_post(unsigned* bar, volatile LAS unsigned* st) {
    XcdBarrier b; b.bar = bar; b.x = xb_xcc_id(); b.st = st;
    if (threadIdx.x == 0) (void)xb_add(&bar[XB_XCNT(b.x)], 1u);
    return b;
}
__device__ __forceinline__ void xcd_barrier_complete(unsigned* bar, unsigned x, unsigned& nloc, unsigned& nx) {
    const unsigned G = gridDim.x * gridDim.y * gridDim.z;
    unsigned sum, cnt, mine, sp = 0u;
    for (;;) {
        sum = 0u; cnt = 0u; mine = 0u;
#pragma unroll
        for (unsigned j = 0; j < 16; ++j) { const unsigned c = xb_ld(&bar[XB_XCNT(j)]); sum += c; cnt += (c > 0u) ? 1u : 0u; mine = (j == x) ? c : mine; }
        if (sum == G) break;
        __builtin_amdgcn_s_sleep(1);
        if ((++sp & 255u) == 0u) { if (xb_ld(&bar[XB_TMO])) break; if (sp > XB_SPIN_CAP) { atomicAdd(&bar[XB_TMO], 1u); break; } }
    }
    nloc = mine > 0u ? mine : 1u; nx = cnt > 0u ? cnt : 1u;
}

__device__ __forceinline__ void xcd_barrier(const XcdBarrier& b) {
    asm volatile("s_waitcnt vmcnt(0)" ::: "memory");
    __syncthreads();
    if (threadIdx.x == 0) {
        unsigned* bar = b.bar;
        __builtin_amdgcn_s_waitcnt(0);
        unsigned nloc = b.st[0], nx = b.st[1];
        if (nloc == 0u) { xcd_barrier_complete(bar, b.x, nloc, nx); b.st[0] = nloc; b.st[1] = nx; }
        const unsigned old = xb_add(&bar[XB_XSUB(b.x)], 1u);
        const unsigned gen = old / nloc;
        if (old + 1u == (gen + 1u) * nloc) {
            __builtin_amdgcn_fence(__ATOMIC_RELEASE, "agent");
            asm volatile("s_waitcnt vmcnt(0)" ::: "memory");
            const unsigned og = xb_add(&bar[XB_TOP], 1u);
            const unsigned tg = og / nx;
            if (og + 1u == (tg + 1u) * nx) xb_add(&bar[XB_TOPGEN], 1u);
            else XB_SPIN(xb_ld(&bar[XB_TOPGEN]) == tg, bar);
            __builtin_amdgcn_fence(__ATOMIC_ACQUIRE, "agent");
            xb_add(&bar[XB_XGEN(b.x)], 1u);
            asm volatile("s_waitcnt vmcnt(0)" ::: "memory");
        } else {
            XB_SPIN(xb_ld(&bar[XB_XGEN(b.x)]) == gen, bar);
            __builtin_amdgcn_fence(__ATOMIC_ACQUIRE, "agent");
            asm volatile("s_waitcnt vmcnt(0)" ::: "memory");
        }
    }
    __syncthreads();
}
namespace pg8 {
#define PG8_LAS __attribute__((address_space(3)))
typedef unsigned short bf16_t;
typedef short bf16x8 __attribute__((ext_vector_type(8)));
typedef float f32x4 __attribute__((ext_vector_type(4)));
typedef float f32x2 __attribute__((ext_vector_type(2)));
typedef unsigned u32x4 __attribute__((ext_vector_type(4)));
constexpr int BM = 256, BK = 64, HALF = 128, HTB = HALF * BK * 2  , STAGE_BYTES = 8 * HTB, NXCD = 8, WGM = 8;

__host__ __device__ __forceinline__ int lds_byte(int r, int c) { const int st = (r >> 4) * 2 + (c >> 5), rr = r & 15, cc = c & 31, ob = rr * 64 + cc * 2; return st * 1024 + (ob ^ (((ob >> 9) & 1) << 5)); }
__host__ __device__ __forceinline__ void stage_rc(int b, int& R, int& C) { const int st = b / 1024, sb = b % 1024, swz = sb ^ (((sb >> 9) & 1) << 5); R = (st >> 1) * 16 + swz / 64; C = (st & 1) * 32 + (swz % 64) / 2; }
__host__ __device__ __forceinline__ int perm32(int rho) { const int n = rho >> 4, i = rho & 15; return 8 * (i >> 2) + 4 * n + (i & 3); }

struct Unit { int pm, pn; };
struct Gemm { const bf16_t* A; const bf16_t* Bt; int M, N, K, lda, agrp; };

struct StaticOrder {
    int nM, nN, nwg, G, c;
    __host__ __device__ __forceinline__ void init(int M, int N, int G_, int c_) { nM = M / BM; nN = N / BM; nwg = nM * nN; G = G_; c = c_; }
    __host__ __device__ __forceinline__ bool next(int i, Unit& u) const {
        const long L = (long)i * G + c; if (L >= nwg) return false;
        int wgid = (int)L; { const int q = nwg / NXCD, r = nwg % NXCD, xcd = wgid % NXCD, off = wgid / NXCD; wgid = (xcd < r ? xcd * (q + 1) : r * (q + 1) + (xcd - r) * q) + off; }
        const int nig = WGM * nN, gid = wgid / nig, fm = gid * WGM, gsz = (nM - fm) < WGM ? (nM - fm) : WGM;
        u.pm = fm + ((wgid % nig) % gsz); u.pn = (wgid % nig) / gsz; return true;
    }
    __device__ __forceinline__ void a_ready(const Unit&) const {}
    __device__ __forceinline__ void done(const Unit&) const {}
};

__device__ __forceinline__ unsigned cvt_pk_bf16(float lo, float hi) { unsigned r; asm volatile("v_cvt_pk_bf16_f32 %0, %1, %2" : "=v"(r) : "v"(lo), "v"(hi)); return r; }
__device__ __forceinline__ float bf_lo(unsigned w) { return __uint_as_float(w << 16); }
__device__ __forceinline__ float bf_hi(unsigned w) { return __uint_as_float(w & 0xffff0000u); }
__device__ __forceinline__ float sigmoidf_(float v) { return __builtin_amdgcn_rcpf(1.0f + __builtin_amdgcn_exp2f(-1.4426950408889634f * v)); }
__device__ __forceinline__ float siluf_(float v) { return v * sigmoidf_(v); }
__device__ __forceinline__ float gelu_tanh_(float v) { const float t = 1.5957691216057308f * (v + 0.044715f * v * v * v); return v * sigmoidf_(t); }

struct EpiF32 {
    static constexpr bool PERM = false, AFTER_DRAIN = false;
    float* C; int ldc;
    __device__ __forceinline__ void operator()(const f32x4 (&acc)[2][2][4][2], const Unit& u, int wr, int wc, int fr, int fq) const {
        const int row0 = u.pm * BM + wr * 64 + fr, col0 = u.pn * BM + wc * 32 + 4 * fq;
#pragma unroll
        for (int ai = 0; ai < 2; ++ai)
#pragma unroll
            for (int m = 0; m < 4; ++m) { float* rowp = C + (size_t)(row0 + ai * HALF + m * 16) * ldc + col0;
#pragma unroll
                for (int bj = 0; bj < 2; ++bj)
#pragma unroll
                    for (int n = 0; n < 2; ++n) *(f32x4*)(rowp + bj * HALF + n * 16) = acc[ai][bj][m][n]; }
    }
};
struct EpiBf16 {
    static constexpr bool PERM = true, AFTER_DRAIN = false;
    bf16_t* O; int ldc; int split_cols; size_t split_stride;
    __device__ __forceinline__ void operator()(const f32x4 (&acc)[2][2][4][2], const Unit& u, int wr, int wc, int fr, int fq) const {
        const int row0 = u.pm * BM + wr * 64 + fr; int colt = u.pn * BM; bf16_t* base = O;
        if (split_cols) { const int t = colt / split_cols; base += (size_t)t * split_stride; colt -= t * split_cols; }
        const int col0 = colt + wc * 32 + 8 * fq;
#pragma unroll
        for (int ai = 0; ai < 2; ++ai)
#pragma unroll
            for (int m = 0; m < 4; ++m) { bf16_t* rowp = base + (size_t)(row0 + ai * HALF + m * 16) * ldc + col0;
#pragma unroll
                for (int bj = 0; bj < 2; ++bj) { const f32x4 v0 = acc[ai][bj][m][0], v1 = acc[ai][bj][m][1];
                    u32x4 w; w.x = cvt_pk_bf16(v0[0], v0[1]); w.y = cvt_pk_bf16(v0[2], v0[3]); w.z = cvt_pk_bf16(v1[0], v1[1]); w.w = cvt_pk_bf16(v1[2], v1[3]);
                    *(u32x4*)(rowp + bj * HALF) = w; } }
    }
};
struct EpiHead {
    static constexpr bool PERM = true, AFTER_DRAIN = false;
    bf16_t* O0; bf16_t* O1; int hsplit; int seq;
    __device__ __forceinline__ void operator()(const f32x4 (&acc)[2][2][4][2], const Unit& u, int wr, int wc, int fr, int fq) const {
        const bool second = u.pn >= hsplit; bf16_t* base = second ? O1 : O0; const int head = second ? u.pn - hsplit : u.pn;
        const int row0 = u.pm * BM + wr * 64 + fr, d0 = wc * 32 + 8 * fq;
#pragma unroll
        for (int ai = 0; ai < 2; ++ai)
#pragma unroll
            for (int m = 0; m < 4; ++m) { const int r = row0 + ai * HALF + m * 16, b = r / seq, sidx = r - b * seq;
#pragma unroll
                for (int bj = 0; bj < 2; ++bj) { const f32x4 v0 = acc[ai][bj][m][0], v1 = acc[ai][bj][m][1];
                    u32x4 w; w.x = cvt_pk_bf16(v0[0], v0[1]); w.y = cvt_pk_bf16(v0[2], v0[3]); w.z = cvt_pk_bf16(v1[0], v1[1]); w.w = cvt_pk_bf16(v1[2], v1[3]);
                    *(u32x4*)(base + ((size_t)((b * 8 + head) * 2 + bj) * seq + sidx) * 128 + d0) = w; } }
    }
};
struct EpiSwiglu {
    static constexpr bool PERM = true, AFTER_DRAIN = false;
    bf16_t* O; int ldc;
    __device__ __forceinline__ void operator()(const f32x4 (&acc)[2][2][4][2], const Unit& u, int wr, int wc, int fr, int fq) const {
        const int row0 = u.pm * BM + wr * 64 + fr, col0 = u.pn * HALF + wc * 32 + 8 * fq;
#pragma unroll
        for (int ai = 0; ai < 2; ++ai)
#pragma unroll
            for (int m = 0; m < 4; ++m) { bf16_t* rowp = O + (size_t)(row0 + ai * HALF + m * 16) * ldc + col0;
                float o[8];
#pragma unroll
                for (int n = 0; n < 2; ++n)
#pragma unroll
                    for (int i = 0; i < 4; ++i) o[4 * n + i] = siluf_(acc[ai][0][m][n][i]) * acc[ai][1][m][n][i];
                u32x4 w; w.x = cvt_pk_bf16(o[0], o[1]); w.y = cvt_pk_bf16(o[2], o[3]); w.z = cvt_pk_bf16(o[4], o[5]); w.w = cvt_pk_bf16(o[6], o[7]);
                *(u32x4*)rowp = w; }
    }
};
struct EpiLruIn {
    static constexpr bool PERM = true, AFTER_DRAIN = false;
    bf16_t* O0; bf16_t* O1; int ldc; int nsplit;
    __device__ __forceinline__ void operator()(const f32x4 (&acc)[2][2][4][2], const Unit& u, int wr, int wc, int fr, int fq) const {
        const bool act = u.pn < nsplit; bf16_t* base = act ? O0 : O1;
        const int row0 = u.pm * BM + wr * 64 + fr, col0 = (act ? u.pn : u.pn - nsplit) * BM + wc * 32 + 8 * fq;
#pragma unroll
        for (int ai = 0; ai < 2; ++ai)
#pragma unroll
            for (int m = 0; m < 4; ++m) { bf16_t* rowp = base + (size_t)(row0 + ai * HALF + m * 16) * ldc + col0;
#pragma unroll
                for (int bj = 0; bj < 2; ++bj) { f32x4 v0 = acc[ai][bj][m][0], v1 = acc[ai][bj][m][1];
                    if (act) {
#pragma unroll
                        for (int i = 0; i < 4; ++i) { v0[i] = gelu_tanh_(v0[i]); v1[i] = gelu_tanh_(v1[i]); } }
                    u32x4 w; w.x = cvt_pk_bf16(v0[0], v0[1]); w.y = cvt_pk_bf16(v0[2], v0[3]); w.z = cvt_pk_bf16(v1[0], v1[1]); w.w = cvt_pk_bf16(v1[2], v1[3]);
                    *(u32x4*)(rowp + bj * HALF) = w; } }
    }
};
__device__ __forceinline__ float neg_expm1_(float z) {
    const float s = -z * (1.0f + z * (0.5f + z * (0.16666667f + z * (0.041666668f + z * (0.008333334f + z * 0.0013888889f)))));
    const float d = 1.0f - __builtin_amdgcn_exp2f(1.4426950408889634f * z);
    return z > -0.5f ? s : d;
}
struct EpiGates {
    static constexpr bool PERM = true, AFTER_DRAIN = false;
    const bf16_t* X; unsigned* AU; int ldc; const float* gc;
    __device__ __forceinline__ void operator()(const f32x4 (&acc)[2][2][4][2], const Unit& u, int wr, int wc, int fr, int fq) const {
        const int row0 = u.pm * BM + wr * 64 + fr, grp0 = (u.pn >> 1) * BM + (u.pn & 1) * HALF + wc * 32, ch0 = grp0 + 8 * fq;
        f32x4 ba[2], bx[2], sp8[2];
#pragma unroll
        for (int n = 0; n < 2; ++n) { ba[n] = *(const f32x4*)(gc + ch0 + 4 * n); bx[n] = *(const f32x4*)(gc + ldc + ch0 + 4 * n); sp8[n] = *(const f32x4*)(gc + 2 * ldc + ch0 + 4 * n); }
#pragma unroll
        for (int ai = 0; ai < 2; ++ai)
#pragma unroll
            for (int m = 0; m < 4; ++m) { const size_t rowoff = (size_t)(row0 + ai * HALF + m * 16) * ldc;
                const u32x4 xw = *(const u32x4*)(X + rowoff + ch0);
#pragma unroll
                for (int n = 0; n < 2; ++n) {
                    const unsigned w0 = n ? xw.z : xw.x, w1 = n ? xw.w : xw.y;
                    const f32x4 xv = {bf_lo(w0), bf_hi(w0), bf_lo(w1), bf_hi(w1)};
                    u32x4 pw;
#pragma unroll
                    for (int e = 0; e < 4; ++e) { const float r = sigmoidf_(acc[ai][0][m][n][e] + ba[n][e]), ig = sigmoidf_(acc[ai][1][m][n][e] + bx[n][e]), la = -sp8[n][e] * r;
                        pw[e] = cvt_pk_bf16(1.4426950408889634f * la, __builtin_sqrtf(neg_expm1_(2.0f * la)) * (ig * xv[e])); }
                    *(u32x4*)(AU + rowoff + grp0 + 16 * n + 4 * fq) = pw; }
                asm volatile("" ::: "memory"); }
    }
};
struct RowStats {
    float* slots; XcdBarrier bar;
    __device__ __forceinline__ void run(const f32x4 (&v)[2][2][4][2], const Unit& u, int wr, int wc, int fr, int fq, PG8_LAS unsigned char* lds, int wid, int lane) const {
        PG8_LAS float* P = (PG8_LAS float*)lds;
        PG8_LAS float* S = (PG8_LAS float*)(lds + 4096);
#pragma unroll
        for (int ai = 0; ai < 2; ++ai)
#pragma unroll
            for (int m = 0; m < 4; ++m) {
                float s = 0.f;
#pragma unroll
                for (int bj = 0; bj < 2; ++bj)
#pragma unroll
                    for (int n = 0; n < 2; ++n) { const f32x4 x = v[ai][bj][m][n]; s += (x[0] * x[0] + x[1] * x[1]) + (x[2] * x[2] + x[3] * x[3]); }
                s += __shfl_xor(s, 16); s += __shfl_xor(s, 32);
                if (fq == 0) P[(ai * HALF + wr * 64 + m * 16 + fr) * 4 + wc] = s;
            }
        asm volatile("s_waitcnt lgkmcnt(0)" ::: "memory"); __builtin_amdgcn_s_barrier(); asm volatile("" ::: "memory");
        const int row = wid * 32 + (lane & 31);
        if (lane < 32) slots[(size_t)(u.pm * BM + row) * 8 + u.pn] = (P[row * 4 + 0] + P[row * 4 + 1]) + (P[row * 4 + 2] + P[row * 4 + 3]);
        xcd_barrier(bar);
        if (lane < 32) {
            const f32x4 s0 = *(const f32x4*)(slots + (size_t)(u.pm * BM + row) * 8), s1 = *(const f32x4*)(slots + (size_t)(u.pm * BM + row) * 8 + 4);
            const float tot = ((s0[0] + s0[1]) + (s0[2] + s0[3])) + ((s1[0] + s1[1]) + (s1[2] + s1[3]));
            S[row] = 1.0f / __builtin_sqrtf(tot * (1.0f / 2048.0f) + 1e-6f);
        }
        asm volatile("s_waitcnt vmcnt(0) lgkmcnt(0)" ::: "memory"); __builtin_amdgcn_s_barrier(); asm volatile("" ::: "memory");
    }
};
typedef unsigned u32x2v __attribute__((ext_vector_type(2)));
__device__ __forceinline__ void store_h8(bf16_t* p  , const u32x2v (&w)[2], int fq) {
    const bool odd = (fq & 1) != 0;
    const u32x2v snd = odd ? w[0] : w[1]; u32x2v rcv; rcv.x = (unsigned)__shfl_xor((int)snd.x, 16); rcv.y = (unsigned)__shfl_xor((int)snd.y, 16);
    u32x4 o; if (odd) { o.x = rcv.x; o.y = rcv.y; o.z = w[1].x; o.w = w[1].y; } else { o.x = w[0].x; o.y = w[0].y; o.z = rcv.x; o.w = rcv.y; }
    *(u32x4*)(p + (odd ? 12 : 0)) = o;
}
__device__ __forceinline__ void load_h8(const u32x4& r, int fq, f32x4& b0, f32x4& b1) {
    const bool odd = (fq & 1) != 0;
    u32x2v snd; snd.x = odd ? r.x : r.z; snd.y = odd ? r.y : r.w;
    u32x2v rcv; rcv.x = (unsigned)__shfl_xor((int)snd.x, 16); rcv.y = (unsigned)__shfl_xor((int)snd.y, 16);
    const unsigned a0 = odd ? rcv.x : r.x, a1 = odd ? rcv.y : r.y, c0 = odd ? r.z : rcv.x, c1 = odd ? r.w : rcv.y;
    b0 = f32x4{bf_lo(a0), bf_hi(a0), bf_lo(a1), bf_hi(a1)}; b1 = f32x4{bf_lo(c0), bf_hi(c0), bf_lo(c1), bf_hi(c1)};
}
template <bool XIN_BF>
struct EpiNormT {
    static constexpr bool PERM = false, AFTER_DRAIN = true;
    const void* xin_; void* xout_; bf16_t* h1; bf16_t* h2; float wgt;
    const float *gpost, *gate, *gpre1, *scale1, *shift1, *gpre2, *scale2, *shift2;
    RowStats st1, st2;
    __device__ __forceinline__ void fused(f32x4 (&acc)[2][2][4][2], const Unit& u, int wr, int wc, int fr, int fq, PG8_LAS unsigned char* lds, int wid, int lane) const {
        const PG8_LAS float* S = (const PG8_LAS float*)(lds + 4096);
        const int col0 = u.pn * BM + wc * 32 + 4 * fq;
        const float* xin = (const float*)xin_; const bf16_t* xinh = (const bf16_t*)xin_; float* xout = (float*)xout_; bf16_t* xouth = (bf16_t*)xout_;
        const int hoff = (fq & 1) ? 12 : 0;
        f32x4 pre[XIN_BF ? 1 : 4][2][2]; constexpr int NPRE1 = 2; u32x4 preh[XIN_BF ? 4 + NPRE1 : 1][2];
#pragma unroll
        for (int m = 0; m < 4; ++m) { const size_t off = (size_t)(u.pm * BM + wr * 64 + m * 16 + fr) * 2048 + col0;
#pragma unroll
            for (int bj = 0; bj < 2; ++bj) {
                if constexpr (XIN_BF) { preh[m][bj] = *(const u32x4*)(xinh + off + bj * HALF + hoff); if (m < NPRE1) preh[4 + m][bj] = *(const u32x4*)(xinh + off + (size_t)HALF * 2048 + bj * HALF + hoff); }
                else {
#pragma unroll
                    for (int n = 0; n < 2; ++n) pre[m][bj][n] = *(const f32x4*)(xin + off + bj * HALF + n * 16); } } }
        st1.run(acc, u, wr, wc, fr, fq, lds, wid, lane);
        {
            f32x4 ca[2][2];
#pragma unroll
            for (int bj = 0; bj < 2; ++bj)
#pragma unroll
                for (int n = 0; n < 2; ++n) ca[bj][n] = *(const f32x4*)(gate + col0 + bj * HALF + n * 16) * *(const f32x4*)(gpost + col0 + bj * HALF + n * 16) * wgt;
#pragma unroll
            for (int ai = 0; ai < 2; ++ai)
#pragma unroll
                for (int m = 0; m < 4; ++m) { const int r = ai * HALF + wr * 64 + m * 16 + fr; const float rs = S[r]; const size_t off = (size_t)(u.pm * BM + r) * 2048 + col0;
#pragma unroll
                    for (int bj = 0; bj < 2; ++bj) { f32x4 bs[2];
                        if constexpr (XIN_BF) { const u32x4 raw = (ai == 0 || m < NPRE1) ? preh[(ai * 4 + m) < 4 + NPRE1 ? ai * 4 + m : 0][bj] : *(const u32x4*)(xinh + off + bj * HALF + hoff); load_h8(raw, fq, bs[0], bs[1]); }
                        else {
#pragma unroll
                            for (int n = 0; n < 2; ++n) bs[n] = ai == 0 ? pre[m][bj][n] : *(const f32x4*)(xin + off + bj * HALF + n * 16); }
#pragma unroll
                        for (int n = 0; n < 2; ++n) { acc[ai][bj][m][n] = bs[n] + ca[bj][n] * (acc[ai][bj][m][n] * rs); } }
                    asm volatile("" : "+v"(acc[ai][0][m][0]), "+v"(acc[ai][0][m][1]), "+v"(acc[ai][1][m][0]), "+v"(acc[ai][1][m][1]));
                    if (m & 1) asm volatile("" ::: "memory"); }
        }
        if (h1 == nullptr && h2 == nullptr) {
#pragma unroll
            for (int ai = 0; ai < 2; ++ai)
#pragma unroll
                for (int m = 0; m < 4; ++m) { const int r = ai * HALF + wr * 64 + m * 16 + fr; const size_t off = (size_t)(u.pm * BM + r) * 2048 + col0;
#pragma unroll
                    for (int bj = 0; bj < 2; ++bj)
#pragma unroll
                        for (int n = 0; n < 2; ++n) __builtin_nontemporal_store(acc[ai][bj][m][n], (f32x4*)(xout + off + bj * HALF + n * 16)); }
            return;
        }
        st2.run(acc, u, wr, wc, fr, fq, lds, wid, lane);
        {
            f32x4 cb[2][2], cc[2][2];
#pragma unroll
            for (int bj = 0; bj < 2; ++bj)
#pragma unroll
                for (int n = 0; n < 2; ++n) { cb[bj][n] = *(const f32x4*)(gpre1 + col0 + bj * HALF + n * 16) * (*(const f32x4*)(scale1 + col0 + bj * HALF + n * 16) + 1.0f); cc[bj][n] = *(const f32x4*)(shift1 + col0 + bj * HALF + n * 16); }
#pragma unroll
            for (int ai = 0; ai < 2; ++ai)
#pragma unroll
                for (int m = 0; m < 4; ++m) { const int r = ai * HALF + wr * 64 + m * 16 + fr; const float rs = S[r]; const size_t off = (size_t)(u.pm * BM + r) * 2048 + col0;
#pragma unroll
                    for (int bj = 0; bj < 2; ++bj) { u32x2v w[2], wx[2];
#pragma unroll
                        for (int n = 0; n < 2; ++n) { const f32x4 x1 = acc[ai][bj][m][n]; wx[n].x = cvt_pk_bf16(x1[0], x1[1]); wx[n].y = cvt_pk_bf16(x1[2], x1[3]);
                            const f32x4 o = (x1 * rs) * cb[bj][n] + cc[bj][n]; w[n].x = cvt_pk_bf16(o[0], o[1]); w[n].y = cvt_pk_bf16(o[2], o[3]); }
                        store_h8(xouth + off + bj * HALF, wx, fq); store_h8(h1 + off + bj * HALF, w, fq); }
                    asm volatile("" ::: "memory"); }
        }
        if (h2 != nullptr) {
            f32x4 cb[2][2], cc[2][2];
#pragma unroll
            for (int bj = 0; bj < 2; ++bj)
#pragma unroll
                for (int n = 0; n < 2; ++n) { cb[bj][n] = *(const f32x4*)(gpre2 + col0 + bj * HALF + n * 16) * (*(const f32x4*)(scale2 + col0 + bj * HALF + n * 16) + 1.0f); cc[bj][n] = *(const f32x4*)(shift2 + col0 + bj * HALF + n * 16); }
#pragma unroll
            for (int ai = 0; ai < 2; ++ai)
#pragma unroll
                for (int m = 0; m < 4; ++m) { const int r = ai * HALF + wr * 64 + m * 16 + fr; const float rs = S[r]; const size_t off = (size_t)(u.pm * BM + r) * 2048 + col0;
#pragma unroll
                    for (int bj = 0; bj < 2; ++bj) { u32x2v w[2];
#pragma unroll
                        for (int n = 0; n < 2; ++n) { const f32x4 o = (acc[ai][bj][m][n] * rs) * cb[bj][n] + cc[bj][n]; w[n].x = cvt_pk_bf16(o[0], o[1]); w[n].y = cvt_pk_bf16(o[2], o[3]); }
                        store_h8(h2 + off + bj * HALF, w, fq); }
                    asm volatile("" ::: "memory"); }
        }
    }
};
template <class Epi, class Sched, bool ALIGN_EPI, bool SP2 = true>
__device__ __forceinline__ void gemm_phase(PG8_LAS unsigned char* lds, const Gemm g, const Sched& S, const Epi& E) {
    int tid = threadIdx.x; asm volatile("" : "+v"(tid)); const int wid = __builtin_amdgcn_readfirstlane(tid >> 6), lane = tid & 63, wr = wid >> 2, wc = wid & 3, fr = lane & 15, fq = lane >> 4;
    const int K = g.K, nt = K / BK, lda = g.lda;
    unsigned voffA[2], voffB[2];
#pragma unroll
    for (int i = 0; i < 2; ++i) { int R, C; stage_rc(tid * 16 + i * 8192, R, C); const int Rb = Epi::PERM ? ((R & ~31) + perm32(R & 31)) : R;
        voffA[i] = (unsigned)(R * lda + C) * 2u; voffB[i] = (unsigned)(Rb * BK + C) * 2u; }
    const size_t kstep = (size_t)(BK * 2), kstepB = (size_t)BM * BK * 2;
    const size_t hstepA = (size_t)HALF * lda * 2, hstepB = (size_t)HALF * BK * 2;
    const size_t tstepA = 2 * hstepA, tstepB = (size_t)BM * K * 2;
    const unsigned ldsw = (unsigned)wid * 1024u;
    const int aoff = lds_byte(wr * 64 + fr, fq * 8), boff = lds_byte(wc * 32 + fr, fq * 8);
#define PG8_SA(b, h) (((b) * 2 + (h)) * HTB)
#define PG8_SB(b, h) ((4 + (b) * 2 + (h)) * HTB)
#define PG8_STAGE(bufoff, gbase, voff) do { _Pragma("unroll") for (int _i = 0; _i < 2; ++_i) \
        __builtin_amdgcn_global_load_lds((const unsigned*)((const char*)(gbase) + (voff)[_i]), (PG8_LAS unsigned*)(lds + (bufoff) + ldsw + _i * 8192), 16, 0, 0); } while (0)
#define PG8_LDA(dst, b, h) do { _Pragma("unroll") for (int m = 0; m < 4; ++m) _Pragma("unroll") for (int k = 0; k < 2; ++k) dst[m][k] = *(const PG8_LAS bf16x8*)(lds + PG8_SA(b, h) + aoff + m * 2048 + k * 1024); } while (0)
#define PG8_LDB(dst, b, h) do { _Pragma("unroll") for (int n = 0; n < 2; ++n) _Pragma("unroll") for (int k = 0; k < 2; ++k) dst[n][k] = *(const PG8_LAS bf16x8*)(lds + PG8_SB(b, h) + boff + n * 2048 + k * 1024); } while (0)
#define PG8_MMA(ai, bj, At, Bt) do { __builtin_amdgcn_s_setprio(1); _Pragma("unroll") for (int m = 0; m < 4; ++m) _Pragma("unroll") for (int n = 0; n < 2; ++n) _Pragma("unroll") for (int k = 0; k < 2; ++k) \
        acc[ai][bj][m][n] = __builtin_amdgcn_mfma_f32_16x16x32_bf16(Bt[n][k], At[m][k], acc[ai][bj][m][n], 0, 0, 0); __builtin_amdgcn_s_setprio(0); } while (0)
#define PG8_WAIT_V(n) asm volatile("s_waitcnt vmcnt(" #n ")" ::: "memory")
#define PG8_WAIT_L(n) asm volatile("s_waitcnt lgkmcnt(" #n ")" ::: "memory")
#define PG8_BAR __builtin_amdgcn_s_barrier()
#define PG8_SCHED __builtin_amdgcn_sched_barrier(0)
#define PG8_APTR(u_) ((const char*)g.A + (size_t)(u_).pm * tstepA + (size_t)(((u_).pn >> 1) * g.agrp) * 2)
#define PG8_BPTR(u_) ((const char*)g.Bt + (size_t)(u_).pn * tstepB)
    Unit cur, nxt; int ui = 0;
    if (!S.next(0, cur)) return;
    f32x4 acc[2][2][4][2];
#pragma unroll
    for (int a = 0; a < 2; ++a)
#pragma unroll
        for (int b = 0; b < 2; ++b)
#pragma unroll
            for (int m = 0; m < 4; ++m)
#pragma unroll
                for (int n = 0; n < 2; ++n) acc[a][b][m][n] = (f32x4){0.f, 0.f, 0.f, 0.f};
    bf16x8 At[4][2], B0[2][2], B1[2][2];
    const char* cA = PG8_APTR(cur); const char* cB = PG8_BPTR(cur);
    S.a_ready(cur);
    if constexpr (SP2) {
    PG8_STAGE(PG8_SB(0, 0), cB, voffB); PG8_STAGE(PG8_SB(0, 1), cB + hstepB, voffB); PG8_STAGE(PG8_SA(0, 0), cA, voffA); PG8_STAGE(PG8_SA(0, 1), cA + hstepA, voffA);
    if (wr == 1) PG8_BAR;
    PG8_WAIT_V(2); PG8_BAR;
    } else {
    PG8_STAGE(PG8_SB(0, 0), cB, voffB); PG8_STAGE(PG8_SA(0, 0), cA, voffA); PG8_STAGE(PG8_SB(0, 1), cB + hstepB, voffB); PG8_STAGE(PG8_SA(0, 1), cA + hstepA, voffA);
    if (wr == 1) PG8_BAR;
    PG8_WAIT_V(4); PG8_BAR;
    }
    PG8_STAGE(PG8_SB(1, 0), cB + kstepB, voffB); PG8_STAGE(PG8_SA(1, 0), cA + kstep, voffA); PG8_STAGE(PG8_SB(1, 1), cB + hstepB + kstepB, voffB);
    PG8_WAIT_V(6); PG8_BAR;
    for (;;) {
        const bool has_next = S.next(ui + 1, nxt);
        const char* nA = has_next ? PG8_APTR(nxt) : cA; const char* nB = has_next ? PG8_BPTR(nxt) : cB;
        for (int t = 0; t < nt; t += 2) {
            const bool last = (t == nt - 2);
            const char* a1 = cA + (size_t)(t + 1) * kstep;
            const char* a2 = last ? nA : cA + (size_t)(t + 2) * kstep; const char* b2 = last ? nB : cB + (size_t)(t + 2) * kstepB;
            const char* a3 = a2 + kstep; const char* b3 = b2 + kstepB;
            if (last && has_next) S.a_ready(nxt);
            if constexpr (SP2) {
            PG8_LDB(B0, 0, 0); PG8_LDB(B1, 0, 1); PG8_SCHED; PG8_LDA(At, 0, 0); PG8_STAGE(PG8_SA(1, 1), a1 + hstepA, voffA);
            PG8_WAIT_V(8); PG8_WAIT_L(0); PG8_BAR; PG8_MMA(0, 0, At, B0); PG8_MMA(0, 1, At, B1); PG8_BAR; PG8_SCHED;
            PG8_LDA(At, 0, 1); PG8_STAGE(PG8_SB(0, 0), b2, voffB); PG8_STAGE(PG8_SB(0, 1), b2 + hstepB, voffB); PG8_STAGE(PG8_SA(0, 0), a2, voffA);
            PG8_WAIT_V(8); PG8_WAIT_L(0); PG8_BAR; PG8_MMA(1, 0, At, B0); PG8_MMA(1, 1, At, B1); PG8_BAR; PG8_SCHED;
            PG8_LDB(B0, 1, 0); PG8_LDB(B1, 1, 1); PG8_SCHED; PG8_LDA(At, 1, 0); PG8_STAGE(PG8_SA(0, 1), a2 + hstepA, voffA);
            PG8_WAIT_V(8); PG8_WAIT_L(0); PG8_BAR; PG8_MMA(0, 0, At, B0); PG8_MMA(0, 1, At, B1); PG8_BAR; PG8_SCHED;
            PG8_LDA(At, 1, 1); PG8_STAGE(PG8_SB(1, 0), b3, voffB); PG8_STAGE(PG8_SB(1, 1), b3 + hstepB, voffB); PG8_STAGE(PG8_SA(1, 0), a3, voffA);
            PG8_WAIT_V(8); PG8_WAIT_L(0); PG8_BAR; PG8_MMA(1, 0, At, B0); PG8_MMA(1, 1, At, B1); PG8_BAR; PG8_SCHED;
            } else {
            PG8_LDB(B0, 0, 0); PG8_SCHED; PG8_LDA(At, 0, 0); PG8_STAGE(PG8_SA(1, 1), a1 + hstepA, voffA);
            PG8_WAIT_L(8); PG8_BAR; PG8_WAIT_L(0); PG8_MMA(0, 0, At, B0); PG8_BAR; PG8_SCHED;
            PG8_LDB(B1, 0, 1); PG8_STAGE(PG8_SB(0, 0), b2, voffB);
            PG8_BAR; PG8_WAIT_L(0); PG8_MMA(0, 1, At, B1); PG8_BAR;
            PG8_LDA(At, 0, 1); PG8_STAGE(PG8_SA(0, 0), a2, voffA);
            PG8_BAR; PG8_WAIT_L(0); PG8_MMA(1, 0, At, B0); PG8_BAR; PG8_SCHED;
            PG8_STAGE(PG8_SB(0, 1), b2 + hstepB, voffB);
            PG8_WAIT_V(6); PG8_BAR; PG8_MMA(1, 1, At, B1); PG8_BAR;
            PG8_LDB(B0, 1, 0); PG8_SCHED; PG8_LDA(At, 1, 0); PG8_STAGE(PG8_SA(0, 1), a2 + hstepA, voffA);
            PG8_WAIT_L(8); PG8_BAR; PG8_WAIT_L(0); PG8_MMA(0, 0, At, B0); PG8_BAR; PG8_SCHED;
            PG8_LDB(B1, 1, 1); PG8_STAGE(PG8_SB(1, 0), b3, voffB);
            PG8_BAR; PG8_WAIT_L(0); PG8_MMA(0, 1, At, B1); PG8_BAR;
            PG8_LDA(At, 1, 1); PG8_STAGE(PG8_SA(1, 0), a3, voffA);
            PG8_BAR; PG8_WAIT_L(0); PG8_MMA(1, 0, At, B0); PG8_BAR; PG8_SCHED;
            PG8_STAGE(PG8_SB(1, 1), b3 + hstepB, voffB);
            PG8_WAIT_V(6); PG8_BAR; PG8_MMA(1, 1, At, B1); PG8_BAR;
            }
        }
        if constexpr (ALIGN_EPI) { if (wr == 0) PG8_BAR; }
        if constexpr (!Epi::AFTER_DRAIN) { E(acc, cur, wr, wc, fr, fq); S.done(cur); }
        if (!has_next) break;
#pragma unroll
        for (int a = 0; a < 2; ++a)
#pragma unroll
            for (int b = 0; b < 2; ++b)
#pragma unroll
                for (int m = 0; m < 4; ++m)
#pragma unroll
                    for (int n = 0; n < 2; ++n) acc[a][b][m][n] = (f32x4){0.f, 0.f, 0.f, 0.f};
        cur = nxt; cA = nA; cB = nB; ++ui;
        if constexpr (ALIGN_EPI) { if (wr == 1) PG8_BAR; }
    }
    PG8_WAIT_V(0);
    if constexpr (!ALIGN_EPI) { if (wr == 0) PG8_BAR; }
    PG8_BAR;
    if constexpr (Epi::AFTER_DRAIN) { E.fused(acc, cur, wr, wc, fr, fq, lds, wid, lane); S.done(cur); }
#undef PG8_SA
#undef PG8_SB
#undef PG8_STAGE
#undef PG8_LDA
#undef PG8_LDB
#undef PG8_MMA
#undef PG8_WAIT_V
#undef PG8_WAIT_L
#undef PG8_BAR
#undef PG8_SCHED
#undef PG8_APTR
#undef PG8_BPTR
}
}
namespace attn {
using bf16 = __hip_bfloat16;
typedef short bf16x8 __attribute__((ext_vector_type(8)));
typedef short s16x4 __attribute__((ext_vector_type(4)));
typedef float f32x16 __attribute__((ext_vector_type(16)));
typedef float f32x4 __attribute__((ext_vector_type(4)));
typedef unsigned u32x4 __attribute__((ext_vector_type(4)));
template <class A, class Bt> struct same_t { static constexpr bool v = false; };
template <class A> struct same_t<A, A> { static constexpr bool v = true; };
constexpr int D = 128;
constexpr int QP = 128, KVP = 128, OP = 4096;
constexpr int CHUNKM1 = 63;
constexpr float THR = 8.f;
constexpr bool WSKIP = true;
constexpr float SCALE = 0.08838834764831845f;
constexpr int NW = 8, QBLK = 32, KVBLK = 64, QB = NW * QBLK;
constexpr int SHM_V = KVBLK * D * 2, SHM_K = KVBLK * D * 2;
constexpr int NVS = 3;
constexpr int LDS_BYTES = NVS * SHM_V + 2 * SHM_K + NW * 64 * 4;
#define KSWZ(row, colB) ((row) * 256 + ((colB) ^ (((row) & 7) << 4)))
#define SBAR() __builtin_amdgcn_sched_barrier(0)
__device__ __forceinline__ int v_st(int k, int c) { const int kk = (k & ~0xC) | ((k & 4) << 1) | ((k & 8) >> 1); return ((kk >> 3) * 4 + (c >> 5)) * 512 + ((kk & 7) * 32 + (c & 31)) * 2; }
__device__ __forceinline__ int v_rd_base(int lane) { return ((lane & 3) << 3) | (((lane >> 2) & 3) << 6) | (((lane >> 4) & 1) << 5) | (((lane >> 5) & 1) << 8); }
constexpr int v_rd_off(int d0, int ks, int half) { return d0 * 512 + ks * 4096 + half * 2048; }
__device__ __forceinline__ int crow(int r, int hi) { return (r & 3) + 8 * (r >> 2) + 4 * hi; }
__device__ __forceinline__ unsigned cvtpk(float lo, float hi) {
    unsigned r; asm volatile("v_cvt_pk_bf16_f32 %0, %1, %2" : "=v"(r) : "v"(lo), "v"(hi)); return r;
}
__device__ __forceinline__ bf16x8 pack8(f32x4 a, f32x4 b) {
    u32x4 w = {cvtpk(a[0], a[1]), cvtpk(a[2], a[3]), cvtpk(b[0], b[1]), cvtpk(b[2], b[3])};
    return *reinterpret_cast<bf16x8*>(&w);
}
template <class T> __device__ __forceinline__ bf16x8 load8(const T* p) {
    if constexpr (same_t<T, float>::v) { return pack8(*(const f32x4*)p, *(const f32x4*)(p + 4)); }
    else { return *reinterpret_cast<const bf16x8*>(p); }
}
__device__ __forceinline__ void mask_tile(f32x16& p0, f32x16& p1, int dq, unsigned W) {
    const float NEG = -__builtin_inff();
#pragma unroll
    for (int r = 0; r < 16; ++r) {
        const int c = (r & 3) + 8 * (r >> 2);
        if ((unsigned)(dq - c) >= W) p0[r] = NEG;
        if ((unsigned)(dq - c - 32) >= W) p1[r] = NEG;
    }
}
__device__ __forceinline__ void partialSM(f32x16& p0, f32x16& p1, float& m_reg, float& mn, float& alpha) {
    float pmax = p0[0]; for (int r = 1; r < 16; ++r) pmax = fmaxf(pmax, p0[r]); for (int r = 0; r < 16; ++r) pmax = fmaxf(pmax, p1[r]);
    { auto rr = __builtin_amdgcn_permlane32_swap(__float_as_uint(pmax), __float_as_uint(pmax), false, false);
      pmax = fmaxf(__uint_as_float(rr[0]), __uint_as_float(rr[1])); }
    constexpr float C2 = 1.4426950408889634f * SCALE;
    if (__builtin_expect(__all((pmax - m_reg) * SCALE <= THR), 1)) { mn = m_reg; alpha = 1.f; }
    else { mn = fmaxf(m_reg, pmax); alpha = __builtin_amdgcn_exp2f((m_reg - mn) * C2); m_reg = mn; }
    const float mnL = -mn * C2;
    for (int r = 0; r < 16; ++r) p0[r] = fmaf(p0[r], C2, mnL); for (int r = 0; r < 16; ++r) p1[r] = fmaf(p1[r], C2, mnL);
    for (int r = 0; r < 16; ++r) p0[r] = __builtin_amdgcn_exp2f(p0[r]);
}
__device__ __forceinline__ void finishSM(f32x16& p0, f32x16& p1, float alpha, float& l_reg, bf16x8& pa0, bf16x8& pa1, bf16x8& pa2, bf16x8& pa3) {
    for (int r = 0; r < 16; ++r) p1[r] = __builtin_amdgcn_exp2f(p1[r]);
    float ps = 0; for (int r = 0; r < 16; ++r) ps += p0[r]; for (int r = 0; r < 16; ++r) ps += p1[r];
    { auto rr = __builtin_amdgcn_permlane32_swap(__float_as_uint(ps), __float_as_uint(ps), false, false);
      ps = __uint_as_float(rr[0]) + __uint_as_float(rr[1]); }
    l_reg = l_reg * alpha + ps;
#define PK4(P, B_, OUT) do { unsigned a0 = cvtpk(P[B_+0], P[B_+1]), a1 = cvtpk(P[B_+2], P[B_+3]);                          \
        unsigned b0 = cvtpk(P[B_+4], P[B_+5]), b1 = cvtpk(P[B_+6], P[B_+7]);                                             \
        auto r0 = __builtin_amdgcn_permlane32_swap(a0, b0, false, false); auto r1 = __builtin_amdgcn_permlane32_swap(a1, b1, false, false); \
        u32x4 w = {r0[0], r1[0], r0[1], r1[1]}; OUT = *reinterpret_cast<bf16x8*>(&w); } while (0)
    PK4(p0, 0, pa0); PK4(p0, 8, pa1); PK4(p1, 0, pa2); PK4(p1, 8, pa3);
#undef PK4
}
template <int KB, bool SK>
__device__ __forceinline__ void qkt(f32x16& p0, f32x16& p1, const char* K_lds, int r32, int hi, const bf16x8* qr, bool act) {
    if (SK && !act) { const float NEG = -__builtin_inff();
#pragma unroll
        for (int r = 0; r < 16; ++r) { p0[r] = NEG; p1[r] = NEG; } return; }
    p0 = f32x16{}; p1 = f32x16{};
    const char* kb[4];
#pragma unroll
    for (int dd = 0; dd < 4; ++dd) kb[dd] = K_lds + KB * SHM_K + KSWZ(r32, (dd * 16 + hi * 8) * 2);
#pragma unroll
    for (int d0 = 0; d0 < 8; ++d0) { const char* a = kb[d0 & 3] + (d0 >> 2) * 128;
        bf16x8 b0 = *reinterpret_cast<const bf16x8*>(a);
        bf16x8 b1 = *reinterpret_cast<const bf16x8*>(a + 32 * 256);
        p0 = __builtin_amdgcn_mfma_f32_32x32x16_bf16(b0, qr[d0], p0, 0, 0, 0);
        p1 = __builtin_amdgcn_mfma_f32_32x32x16_bf16(b1, qr[d0], p1, 0, 0, 0); }
}
template <int VB, bool SK>
__device__ __forceinline__ void pv_tile(f32x16* o, int vb0, bf16x8 pa0, bf16x8 pa1, bf16x8 pa2, bf16x8 pa3, bool act) {
    if (SK && !act) return;
#define TRRD(dst, off) asm volatile("ds_read_b64_tr_b16 %0, %1 offset:%2" : "=&v"(dst) : "v"(vb0), "i"(off) : "memory")
#define PV_D0(d0) do { s16x4 l0, l1, l2, l3, h0, h1, h2, h3; constexpr int b_ = VB * SHM_V + v_rd_off(d0, 0, 0);     \
        TRRD(l0, b_); TRRD(h0, b_ + 2048); TRRD(l1, b_ + 4096); TRRD(h1, b_ + 6144); TRRD(l2, b_ + 8192); TRRD(h2, b_ + 10240); TRRD(l3, b_ + 12288); TRRD(h3, b_ + 14336); \
        asm volatile("s_waitcnt lgkmcnt(0)" ::: "memory"); SBAR();                 \
        o[d0] = __builtin_amdgcn_mfma_f32_32x32x16_bf16(pa0, (bf16x8){l0[0], l0[1], l0[2], l0[3], h0[0], h0[1], h0[2], h0[3]}, o[d0], 0, 0, 0);   \
        o[d0] = __builtin_amdgcn_mfma_f32_32x32x16_bf16(pa1, (bf16x8){l1[0], l1[1], l1[2], l1[3], h1[0], h1[1], h1[2], h1[3]}, o[d0], 0, 0, 0);   \
        o[d0] = __builtin_amdgcn_mfma_f32_32x32x16_bf16(pa2, (bf16x8){l2[0], l2[1], l2[2], l2[3], h2[0], h2[1], h2[2], h2[3]}, o[d0], 0, 0, 0);   \
        o[d0] = __builtin_amdgcn_mfma_f32_32x32x16_bf16(pa3, (bf16x8){l3[0], l3[1], l3[2], l3[3], h3[0], h3[1], h3[2], h3[3]}, o[d0], 0, 0, 0); } while (0)
    PV_D0(0); PV_D0(1); PV_D0(2); PV_D0(3);
#undef PV_D0
#undef TRRD
}

template <class TIn, class TOut> struct BlockRef { const TIn* Q; const TIn* K; const TIn* V; TOut* O; int P0; };
template <class TIn> struct Seam {
    bf16x8 qr[8];
    bf16x8 st_v0, st_v1, st_k0, st_k1; f32x4 sf0, sf1, sf2, sf3;
    f32x4 tq[16];
};
__device__ __forceinline__ int swa_jlo(int P0, int W) { const int lowk = P0 - W + 1; return lowk > 0 ? lowk / KVBLK : 0; }
#define ROW(p, k0, rr) ((p) + (size_t)((k0) + (rr)) * KVP + sc)
#define VMW() asm volatile("s_waitcnt vmcnt(0)" ::: "memory")
#define VMWN(n) asm volatile("s_waitcnt vmcnt(%0)" :: "i"(n) : "memory")
#define SLOAD_H(Kp, Vp, k0) do { S.st_v0 = load8<TIn>(ROW(Vp, k0, sr)); S.st_v1 = load8<TIn>(ROW(Vp, k0, 32 + sr));              \
                         S.st_k0 = load8<TIn>(ROW(Kp, k0, sr)); S.st_k1 = load8<TIn>(ROW(Kp, k0, 32 + sr)); } while (0)
#define SWRITE_HK(bf) do { *(bf16x8*)(K_lds + (bf) * SHM_K + kws) = S.st_k0; *(bf16x8*)(K_lds + (bf) * SHM_K + kws + 32 * 256) = S.st_k1; } while (0)
#define SWRITE_HV(bf) do { *(bf16x8*)(V_lds + (bf) * SHM_V + vst0) = S.st_v0; *(bf16x8*)(V_lds + (bf) * SHM_V + vst1) = S.st_v1; } while (0)
#define SWRITE_H(bf) do { SWRITE_HV(bf); SWRITE_HK(bf); } while (0)
#define SLOAD_F(p, k0) do { S.sf0 = *(const f32x4*)ROW(p, k0, sr); S.sf1 = *(const f32x4*)(ROW(p, k0, sr) + 4);                \
                            S.sf2 = *(const f32x4*)ROW(p, k0, 32 + sr); S.sf3 = *(const f32x4*)(ROW(p, k0, 32 + sr) + 4); } while (0)
#define SWRITE_KF(bf) do { *(bf16x8*)(K_lds + (bf) * SHM_K + kws) = pack8(S.sf0, S.sf1); *(bf16x8*)(K_lds + (bf) * SHM_K + kws + 32 * 256) = pack8(S.sf2, S.sf3); } while (0)
#define SWRITE_VF(bf) do { *(bf16x8*)(V_lds + (bf) * SHM_V + vst0) = pack8(S.sf0, S.sf1); *(bf16x8*)(V_lds + (bf) * SHM_V + vst1) = pack8(S.sf2, S.sf3); } while (0)
template <class TIn, class TOut>
__device__ __forceinline__ void causal_swa_prime(const BlockRef<TIn, TOut>& cur, int W, char* lds, Seam<TIn>& S) {
    constexpr bool F32 = same_t<TIn, float>::v;
    int tid = threadIdx.x; asm volatile("" : "+v"(tid)); const int wid = __builtin_amdgcn_readfirstlane(tid >> 6), lane = tid & 63, r32 = lane & 31, hi = lane >> 5;
    const int sr = tid >> 4, sc = (tid & 15) * 8, kws = KSWZ(sr, sc * 2); char* K_lds = lds + NVS * SHM_V;
    const int kb0 = swa_jlo(cur.P0, W) * KVBLK;
    for (int d0 = 0; d0 < 8; ++d0) S.qr[d0] = load8<TIn>(cur.Q + (size_t)(wid * QBLK + r32) * QP + d0 * 16 + hi * 8);
    if constexpr (F32) { SLOAD_F((const float*)cur.K, kb0); VMW(); SWRITE_KF(0); SBAR(); SLOAD_F((const float*)cur.V, kb0); }
    else { SLOAD_H(cur.K, cur.V, kb0); VMW(); SWRITE_HK(0); }
    __syncthreads();
}
template <class TIn, class TOut>
__device__ __forceinline__ void causal_swa_block(const BlockRef<TIn, TOut>& cur, const BlockRef<TIn, TOut>& nxt, int skv, int W, char* lds, Seam<TIn>& S) {
    constexpr bool F32 = same_t<TIn, float>::v;
    int tid = threadIdx.x; asm volatile("" : "+v"(tid)); const int wid = __builtin_amdgcn_readfirstlane(tid >> 6), lane = tid & 63, r32 = lane & 31, hi = lane >> 5;
    const int j_lo = swa_jlo(cur.P0, W);
    int j_hi = (cur.P0 + QB - 1) / KVBLK + 1; if (j_hi > skv / KVBLK) j_hi = skv / KVBLK;
    const int NT = j_hi - j_lo;
    const int kbn = swa_jlo(nxt.P0, W) * KVBLK;
    const int qlo = (cur.P0 + wid * QBLK) | (CHUNKM1), qm = qlo - 4 * hi;
    char* V_lds = lds; char* K_lds = lds + NVS * SHM_V;
    float* ws = (float*)(lds + NVS * SHM_V + 2 * SHM_K) + wid * 64; float* li_l = ws, * al_l = ws + 32;
    float m_reg = -1e30f, l_reg = 0; f32x16 o[4] = {};
    const int sr = tid >> 4, sc = (tid & 15) * 8, vst0 = v_st(sr, sc), vst1 = v_st(32 + sr, sc), kws = KSWZ(sr, sc * 2);
    const int vb0 = (int)(uintptr_t)V_lds + v_rd_base(lane);
    const TIn* Kh = cur.K; const TIn* Vh = cur.V;
#define RESC(a) do { if (__any((a) < 1.f)) { if (hi == 0) al_l[r32] = (a); asm volatile("s_waitcnt lgkmcnt(0)" ::: "memory");              \
                     for (int d_ = 0; d_ < 4; ++d_) for (int r = 0; r < 16; ++r) o[d_][r] *= al_l[crow(r, hi)]; } } while (0)
#define KBASE(t) ((j_lo + (t)) * KVBLK)
#define ACT(t) (KBASE(t) <= qlo)
#define MASKT(P0_, P1_, t) do { const int kb_ = KBASE(t); if ((!SK || ACT(t)) && (kb_ + KVBLK - 1 > qlo || kb_ <= qlo + QBLK - 1 - W)) mask_tile(P0_, P1_, qm - kb_, (unsigned)W); } while (0)
    constexpr int NQL = F32 ? 16 : 8;
    constexpr bool SK = WSKIP && !F32;
#define SEAM_K0() do { VMWN(NQL); if constexpr (F32) { SWRITE_KF(0); SBAR(); SLOAD_F((const float*)nxt.V, kbn); } else { SWRITE_HK(0); } SBAR(); } while (0)
    f32x16 pA0, pA1, pB0, pB1; float mnA, mnB, alA, alB; bf16x8 pa0, pa1, pa2, pa3;
    if constexpr (F32) { VMW(); SWRITE_VF(0); SBAR(); } else { SWRITE_HV(0); SBAR(); }
    if (NT > 1) { if constexpr (F32) SLOAD_F((const float*)Kh, KBASE(1)); else SLOAD_H(Kh, Vh, KBASE(1)); }
    SBAR(); qkt<0, SK>(pA0, pA1, K_lds, r32, hi, S.qr, ACT(0));
    if constexpr (F32) { if (NT > 1) { VMW(); SWRITE_KF(1); SBAR(); SLOAD_F((const float*)Vh, KBASE(1)); } }
    MASKT(pA0, pA1, 0); partialSM(pA0, pA1, m_reg, mnA, alA);
    if (NT > 1) { VMW(); if constexpr (F32) { SWRITE_VF(1); SBAR(); if (NT > 2) SLOAD_F((const float*)Kh, KBASE(2)); } else SWRITE_H(1); }
    __syncthreads();
    static_assert(!F32, "the one-barrier V-ring loop is the bf16 path");
    int vs_rd = 0, vs_wr = 2 * SHM_V;
#define VS_NEXT(x) ((x) == (NVS - 1) * SHM_V ? 0 : (x) + SHM_V)
#define HALF_STEP(PX0, PX1, mnX, alX, PY0, PY1, alY, t, KB, SB) do {                                                          \
        SBAR(); qkt<KB, SK>(PX0, PX1, K_lds, r32, hi, S.qr, ACT(t));                                             \
        finishSM(PY0, PY1, alY, l_reg, pa0, pa1, pa2, pa3); SBAR();                                                           \
        if ((t) + 1 < NT) { SLOAD_H(Kh, Vh, KBASE((t) + 1)); SBAR(); }                                                        \
        pv_tile<0, SK>(o, vb0 + vs_rd, pa0, pa1, pa2, pa3, ACT((t) - 1)); MASKT(PX0, PX1, (t)); partialSM(PX0, PX1, m_reg, mnX, alX);              \
        if ((t) + 1 < NT) { VMW(); SWRITE_HK(SB); *(bf16x8*)(V_lds + vs_wr + vst0) = S.st_v0; *(bf16x8*)(V_lds + vs_wr + vst1) = S.st_v1; }      \
        RESC(alX); __syncthreads(); vs_rd = VS_NEXT(vs_rd); vs_wr = VS_NEXT(vs_wr); } while (0)
    for (int t = 1; t + 1 < NT; t += 2) {
        HALF_STEP(pB0, pB1, mnB, alB, pA0, pA1, alA, t, 1, 0);
        HALF_STEP(pA0, pA1, mnA, alA, pB0, pB1, alB, t + 1, 0, 1);
    }
    const bool even = (NT & 1) == 0;
    if (even) { SBAR(); qkt<1, SK>(pB0, pB1, K_lds, r32, hi, S.qr, ACT(NT - 1)); SBAR(); }
#define QROW(e) (nxt.Q + (size_t)(wid * QBLK + r32) * QP + ((e) >> 1) * 16 + hi * 8 + ((e) & 1) * 4)
    if constexpr (F32) { SLOAD_F((const float*)nxt.K, kbn); SBAR();
#pragma unroll
        for (int e = 0; e < 8; ++e) S.tq[e] = *(const f32x4*)QROW(e); }
    else { SLOAD_H(nxt.K, nxt.V, kbn); SBAR();
#pragma unroll
        for (int d0 = 0; d0 < 8; ++d0) S.qr[d0] = load8<TIn>(nxt.Q + (size_t)(wid * QBLK + r32) * QP + d0 * 16 + hi * 8); }
    SBAR();
    finishSM(pA0, pA1, alA, l_reg, pa0, pa1, pa2, pa3); SBAR();
    if constexpr (F32) {
#pragma unroll
        for (int e = 8; e < 16; ++e) S.tq[e] = *(const f32x4*)QROW(e); SBAR(); }
#undef QROW
    pv_tile<0, SK>(o, vb0 + ((even ? NT - 2 : NT - 1) % NVS) * SHM_V, pa0, pa1, pa2, pa3, ACT(even ? NT - 2 : NT - 1));
    if (even) { MASKT(pB0, pB1, NT - 1); partialSM(pB0, pB1, m_reg, mnB, alB); __syncthreads(); RESC(alB);
        finishSM(pB0, pB1, alB, l_reg, pa0, pa1, pa2, pa3); SBAR(); pv_tile<0, SK>(o, vb0 + ((NT - 1) % NVS) * SHM_V, pa0, pa1, pa2, pa3, ACT(NT - 1)); }
    SBAR(); SEAM_K0();
    if (hi == 0) li_l[r32] = l_reg; asm volatile("s_waitcnt lgkmcnt(0)" ::: "memory");
    float rli[16];
#pragma unroll
    for (int r = 0; r < 16; ++r) rli[r] = __builtin_amdgcn_rcpf(li_l[crow(r, hi)]);
    TOut* Ow = cur.O + (size_t)(wid * QBLK) * OP;
#pragma unroll
    for (int r = 0; r < 16; ++r) { const int orow = crow(r, hi);
#pragma unroll
        for (int d0 = 0; d0 < 4; ++d0) { const float v = o[d0][r] * rli[r];
            if constexpr (same_t<TOut, float>::v) { Ow[(size_t)orow * OP + d0 * 32 + r32] = v; }
            else { const float vn = __shfl_xor(v, 1);
                   if ((r32 & 1) == 0) *(unsigned*)(Ow + (size_t)orow * OP + d0 * 32 + r32) = cvtpk(v, vn); } } }
    if constexpr (F32) {
#pragma unroll
        for (int d0 = 0; d0 < 8; ++d0) S.qr[d0] = pack8(S.tq[2 * d0], S.tq[2 * d0 + 1]); }
    __syncthreads();
#undef RESC
#undef KBASE
#undef ACT
#undef MASKT
#undef SEAM_K0
#undef HALF_STEP
}
#undef ROW
#undef VMW
#undef VMWN
#undef SLOAD_H
#undef SWRITE_HK
#undef SWRITE_HV
#undef SWRITE_H
#undef SLOAD_F
#undef SWRITE_KF
#undef SWRITE_VF
}
namespace attn_pc {
using namespace attn;
typedef unsigned short bh16;
struct Block { const bh16* Q; const bh16* K; const bh16* V0; const bh16* V1; bh16* O; int P0; float* T; float lam; const float* gsub; };
constexpr int ONP = 2048; constexpr float LAMI = 0.35550906759096315f;
constexpr int NVSL = 3, LDS_V = 0, LDS_K = NVSL * 32768, LDS_P = LDS_K + 2 * SHM_K, LDS_S = LDS_P + 4 * 4096, PC_LDS_BYTES = LDS_S + 4 * 96 * 4;
#define PCV_RD(dst, off) asm volatile("ds_read_b64_tr_b16 %0, %1 offset:%2" : "=&v"(dst) : "v"(vb), "i"(off) : "memory")
#define PCV_RD8(F, base) do { PCV_RD(F[0], (base)); PCV_RD(F[1], (base) + 2048); PCV_RD(F[2], (base) + 4096); PCV_RD(F[3], (base) + 6144); \
                              PCV_RD(F[4], (base) + 8192); PCV_RD(F[5], (base) + 10240); PCV_RD(F[6], (base) + 12288); PCV_RD(F[7], (base) + 14336); } while (0)
#define PCV_FR(F, k) (bf16x8){F[2 * (k)][0], F[2 * (k)][1], F[2 * (k)][2], F[2 * (k)][3], F[2 * (k) + 1][0], F[2 * (k) + 1][1], F[2 * (k) + 1][2], F[2 * (k) + 1][3]}
#define PCV_MM(X, Y, FX, FY) do { \
        o[X] = __builtin_amdgcn_mfma_f32_32x32x16_bf16(pa0, PCV_FR(FX, 0), o[X], 0, 0, 0); o[Y] = __builtin_amdgcn_mfma_f32_32x32x16_bf16(pa0, PCV_FR(FY, 0), o[Y], 0, 0, 0); \
        o[X] = __builtin_amdgcn_mfma_f32_32x32x16_bf16(pa1, PCV_FR(FX, 1), o[X], 0, 0, 0); o[Y] = __builtin_amdgcn_mfma_f32_32x32x16_bf16(pa1, PCV_FR(FY, 1), o[Y], 0, 0, 0); \
        o[X] = __builtin_amdgcn_mfma_f32_32x32x16_bf16(pa2, PCV_FR(FX, 2), o[X], 0, 0, 0); o[Y] = __builtin_amdgcn_mfma_f32_32x32x16_bf16(pa2, PCV_FR(FY, 2), o[Y], 0, 0, 0); \
        o[X] = __builtin_amdgcn_mfma_f32_32x32x16_bf16(pa3, PCV_FR(FX, 3), o[X], 0, 0, 0); o[Y] = __builtin_amdgcn_mfma_f32_32x32x16_bf16(pa3, PCV_FR(FY, 3), o[Y], 0, 0, 0); } while (0)
#define PCV_WAIT() do { asm volatile("s_waitcnt lgkmcnt(0)" ::: "memory"); SBAR(); } while (0)
__device__ __forceinline__ void pv_both(f32x16 (&o)[8], int vb, bf16x8 pa0, bf16x8 pa1, bf16x8 pa2, bf16x8 pa3) {
    s16x4 A0[8], A1[8], B0[8], B1[8];
    PCV_RD8(A0, 0 * 512); PCV_RD8(A1, 16384 + 0 * 512); PCV_WAIT();
    PCV_RD8(B0, 1 * 512); PCV_RD8(B1, 16384 + 1 * 512); SBAR(); PCV_MM(0, 4, A0, A1); PCV_WAIT();
    PCV_RD8(A0, 2 * 512); PCV_RD8(A1, 16384 + 2 * 512); SBAR(); PCV_MM(1, 5, B0, B1); PCV_WAIT();
    PCV_RD8(B0, 3 * 512); PCV_RD8(B1, 16384 + 3 * 512); SBAR(); PCV_MM(2, 6, A0, A1); PCV_WAIT();
    PCV_MM(3, 7, B0, B1);
}
#undef PCV_RD
#undef PCV_RD8
#undef PCV_FR
#undef PCV_MM
#undef PCV_WAIT
template <int MODE>
__device__ __forceinline__ void block(const Block& it, char* lds) {
    int tid = threadIdx.x; asm volatile("" : "+v"(tid));
    const int wid = __builtin_amdgcn_readfirstlane(tid >> 6), lane = tid & 63, r32 = lane & 31, hi = lane >> 5;
    const bool swave = wid < 4; const int g = wid & 3;
    char* V_lds = lds + LDS_V; char* K_lds = lds + LDS_K; char* P_lds = lds + LDS_P + g * 4096;
    typedef __attribute__((address_space(3))) float lfloat; typedef __attribute__((address_space(3))) unsigned lunsigned;
    lfloat* al_l = (lfloat*)(__attribute__((address_space(3))) char*)lds + (LDS_S / 4) + g * 96; lfloat* li_l = al_l + 32; lunsigned* flag = (lunsigned*)(al_l + 64);
    const int NT = it.P0 / KVBLK + 2;
    const int nvis = it.P0 / KVBLK + (g >> 1) + 1;
#define PC_VMW() asm volatile("s_waitcnt vmcnt(0)" ::: "memory")
#define PC_BAR() asm volatile("s_waitcnt lgkmcnt(0)\n\ts_barrier" ::: "memory")
#define PC_DMA(gsrc, ldst) __builtin_amdgcn_global_load_lds((const unsigned*)(gsrc), (__attribute__((address_space(3))) unsigned*)(__attribute__((address_space(3))) char*)(ldst), 16, 0, 0)
    const int krow = lane >> 4, kpos = lane & 15;
    const int vsub = lane >> 5, vkk = (lane & 31) >> 2, vcc = (lane & 3) * 8;
#define PC_DMA_K(tt, buf, p) do { const int row_ = 4 * (p) + krow; \
        PC_DMA(it.K + (size_t)((tt) * KVBLK + row_) * D + ((kpos ^ (row_ & 7)) << 3), K_lds + (buf) * SHM_K + (p) * 1024); } while (0)
#define PC_DMA_V(tt, off, hq) do { const int st_ = 2 * ((hq) & 15) + vsub, kk_ = (st_ >> 2) * 8 + vkk, k_ = (kk_ & ~0xC) | ((kk_ & 4) << 1) | ((kk_ & 8) >> 1); \
        PC_DMA((((hq) >> 4) ? it.V1 : it.V0) + (size_t)((tt) * KVBLK + k_) * D + (st_ & 3) * 32 + vcc, V_lds + (off) + ((hq) >> 4) * 16384 + ((hq) & 15) * 1024); } while (0)
    int kofs[4], vofs[4];
#pragma unroll
    for (int j = 0; j < 4; ++j) { const int row_ = 4 * (4 * g + j) + krow; kofs[j] = row_ * D + ((kpos ^ (row_ & 7)) << 3);
        const int hq = 4 * wid + j, st_ = 2 * (hq & 15) + vsub, kk_ = (st_ >> 2) * 8 + vkk, k_ = (kk_ & ~0xC) | ((kk_ & 4) << 1) | ((kk_ & 8) >> 1); vofs[j] = k_ * D + (st_ & 3) * 32 + vcc; }
    const bh16* const Vmine = swave ? it.V0 : it.V1;
#define PC_ISSUE_S(tt, kbuf, voff) do { _Pragma("unroll") for (int j = 0; j < 4; ++j) { PC_DMA(it.K + (size_t)(tt) * KVBLK * D + kofs[j], K_lds + (kbuf) * SHM_K + (4 * g + j) * 1024); \
                                                                                       PC_DMA(Vmine + (size_t)(tt) * KVBLK * D + vofs[j], V_lds + (voff) + (4 * g + j) * 1024); } } while (0)
#define PC_ISSUE_PV(tt, voff) do { _Pragma("unroll") for (int j = 0; j < 4; ++j) PC_DMA(Vmine + (size_t)(tt) * KVBLK * D + vofs[j], V_lds + (voff) + 16384 + (4 * g + j) * 1024); } while (0)
    if (swave) {
        bf16x8 qr[8]; float l_reg = 0.f, m_reg = -1e30f; int vs_nx = 65536;
#pragma unroll
        for (int d0 = 0; d0 < 8; ++d0) qr[d0] = *reinterpret_cast<const bf16x8*>(it.Q + (size_t)(g * QBLK + r32) * D + d0 * 16 + hi * 8);
        PC_ISSUE_S(0, 0, 0); PC_VMW(); if (NT > 1) PC_ISSUE_S(1, 1, 32768);
        if (lane == 0) *flag = 0u;
        PC_BAR();
#pragma unroll 1
        for (int t = 0; t <= NT; ++t) {
            const int par = t & 1; const bool act = t < nvis;
            bf16x8 pa0 = {}, pa1 = {}, pa2 = {}, pa3 = {}; float alpha = 1.f; bool resc = false;
            if (act) {
                f32x16 p0, p1; float mn;
                qkt<0, false>(p0, p1, K_lds + par * SHM_K, r32, hi, qr, true);
                partialSM(p0, p1, m_reg, mn, alpha);
                finishSM(p0, p1, alpha, l_reg, pa0, pa1, pa2, pa3);
                resc = __any(alpha < 1.f);
            }
            PC_BAR();
            if (act) {
                bf16x8* pp = (bf16x8*)(P_lds + lane * 16); pp[0] = pa0; pp[64] = pa1; pp[128] = pa2; pp[192] = pa3;
                if (resc && hi == 0) al_l[r32] = alpha;
                if (lane == 0) *flag = resc ? 3u : 1u;
            } else { if (lane == 0) *flag = 0u; }
            PC_VMW();
            if (t + 2 < NT) PC_ISSUE_S(t + 2, par, vs_nx);
            vs_nx = (vs_nx == (NVSL - 1) * 32768) ? 0 : vs_nx + 32768;
            asm volatile("" ::: "memory");
            PC_BAR();
        }
        if (hi == 0) li_l[r32] = l_reg;
        PC_BAR();
        PC_BAR();
    } else {
        f32x16 o[8] = {};
        const int vbl = (int)(uintptr_t)V_lds + v_rd_base(lane);
        PC_ISSUE_PV(0, 0); PC_VMW(); if (NT > 1) PC_ISSUE_PV(1, 32768);
        PC_BAR();
        int vs_rd = 0, vs_wr = 65536;
#pragma unroll 1
        for (int t = 0; t <= NT; ++t) {
            asm volatile("" ::: "memory"); const unsigned f = (unsigned)__builtin_amdgcn_readfirstlane((int)*flag);
            if (f & 1u) {
                const bf16x8* pp = (const bf16x8*)(P_lds + lane * 16); const bf16x8 pa0 = pp[0], pa1 = pp[64], pa2 = pp[128], pa3 = pp[192];
                if (f & 2u) { float al[16];
#pragma unroll
                    for (int r = 0; r < 16; ++r) al[r] = al_l[crow(r, hi)];
#pragma unroll
                    for (int d_ = 0; d_ < 8; ++d_)
#pragma unroll
                        for (int r = 0; r < 16; ++r) o[d_][r] *= al[r]; }
                pv_both(o, vbl + vs_rd, pa0, pa1, pa2, pa3);
            }
            PC_BAR();
            PC_VMW(); if (t + 2 < NT) PC_ISSUE_PV(t + 2, vs_wr);
            if (t >= 1) vs_rd = (vs_rd == (NVSL - 1) * 32768) ? 0 : vs_rd + 32768;
            vs_wr = (vs_wr == (NVSL - 1) * 32768) ? 0 : vs_wr + 32768;
            PC_BAR();
        }
        PC_BAR();
        float rli[16];
#pragma unroll
        for (int r = 0; r < 16; ++r) rli[r] = __builtin_amdgcn_rcpf(li_l[crow(r, hi)]);
        float* Tw = it.T + (size_t)g * 8192 + lane * 4;
        if constexpr (MODE == 0) {
#pragma unroll
            for (int d0 = 0; d0 < 8; ++d0)
#pragma unroll
                for (int q = 0; q < 4; ++q) { const f32x4 v = {o[d0][4 * q] * rli[4 * q], o[d0][4 * q + 1] * rli[4 * q + 1], o[d0][4 * q + 2] * rli[4 * q + 2], o[d0][4 * q + 3] * rli[4 * q + 3]};
                    *(f32x4*)(Tw + (d0 * 4 + q) * 256) = v; }
        } else {
#pragma unroll
            for (int dq = 0; dq < 4; ++dq) { f32x4 tv[2][4];
#pragma unroll
                for (int dd = 0; dd < 2; ++dd)
#pragma unroll
                    for (int q = 0; q < 4; ++q) tv[dd][q] = *(const f32x4*)(Tw + ((2 * dq + dd) * 4 + q) * 256);
#pragma unroll
                for (int dd = 0; dd < 2; ++dd)
#pragma unroll
                    for (int q = 0; q < 4; ++q)
#pragma unroll
                        for (int e = 0; e < 4; ++e) o[2 * dq + dd][4 * q + e] = tv[dd][q][e] - it.lam * (o[2 * dq + dd][4 * q + e] * rli[4 * q + e]); }
            float rs[16];
#pragma unroll
            for (int r = 0; r < 16; ++r) { float ss = 0.f;
#pragma unroll
                for (int d0 = 0; d0 < 8; ++d0) ss += o[d0][r] * o[d0][r];
#pragma unroll
                for (int m = 1; m < 32; m <<= 1) ss += __shfl_xor(ss, m);
                rs[r] = 1.0f / __builtin_sqrtf(ss * (1.0f / 256.0f) + 1e-6f); }
            unsigned short* Ow = (unsigned short*)it.O + (size_t)(g * QBLK) * ONP;
            unsigned short* stg = (unsigned short*)(V_lds + g * 16384);
#pragma unroll
            for (int d0 = 0; d0 < 8; ++d0) { const float gs = it.gsub[d0 * 32 + r32] * (1.0f - LAMI);
#pragma unroll
                for (int r = 0; r < 16; ++r) { const float v = o[d0][r] * rs[r] * gs; stg[crow(r, hi) * 256 + d0 * 32 + r32] = (unsigned short)(cvtpk(v, v) & 0xffffu); } }
            asm volatile("s_waitcnt lgkmcnt(0)" ::: "memory");
#pragma unroll
            for (int i = 0; i < 16; ++i) { const int chunk = i * 64 + lane, row = chunk >> 5, cc = chunk & 31;
                const u32x4 val = *(const u32x4*)(stg + row * 256 + cc * 8);
                *(u32x4*)(Ow + (size_t)row * ONP + cc * 8) = val; }
        }
        PC_BAR();
    }
#undef PC_VMW
#undef PC_DMA
#undef PC_DMA_K
#undef PC_DMA_V
#undef PC_ISSUE_S
#undef PC_ISSUE_PV
#undef PC_BAR
}
}
struct Ctx {
    LAS unsigned char* lds;
    int tid, lane, wave, G, vcu, gw, NGW;
};

__device__ __forceinline__ void transpose_item(const float* W, int ldw, int k0, int n0, bf16* WT, int Kdst, int dst_row0, LAS float* scr, int lane) {
    {
        f32x4 v[8]; const int r = lane >> 3, n4 = (lane & 7) * 4;
#pragma unroll
        for (int i = 0; i < 8; ++i) v[i] = __builtin_nontemporal_load((const GAS f32x4*)(W + (size_t)(k0 + 8 * i + r) * ldw + n0 + n4));
#pragma unroll
        for (int i = 0; i < 8; ++i) { LAS float* d = scr + (8 * i + r) * 33 + n4; d[0] = v[i].x; d[1] = v[i].y; d[2] = v[i].z; d[3] = v[i].w; }
    }
    LDS_WAIT(); asm volatile("" ::: "memory");
    const int c = lane & 7;
#pragma unroll
    for (int j = 0; j < 4; ++j) { const int n = (lane >> 3) + 8 * j; const LAS float* s = scr + (8 * c) * 33 + n;
        v4u o; o.x = pk2(s[0 * 33], s[1 * 33]); o.y = pk2(s[2 * 33], s[3 * 33]); o.z = pk2(s[4 * 33], s[5 * 33]); o.w = pk2(s[6 * 33], s[7 * 33]);
        *(GAS v4u*)(WT + (((size_t)(dst_row0 >> 8) * (Kdst >> 6) + (k0 >> 6)) * 256 + (dst_row0 & 255) + n) * 64 + 8 * c) = o; }
    LDS_WAIT(); asm volatile("" ::: "memory");
}
typedef const float* const __attribute__((address_space(4)))* InTab;
struct TItem { const float* W; bf16* WT; int ldw, k0, n0, Kdst, drow; };
template <int PART>
__device__ __forceinline__ constexpr int titem_count() {
    constexpr int I_FIN = (DM / 64) * (2 * DFF / 32), I_FOUT = (DFF / 64) * (DM / 32), I_LIN = (DM / 64) * (2 * DM / 32), I_G = 16 * 32, I_SQ = (DM / 64) * (DM / 32), I_KV = (DM / 64) * (2 * DM / 32);
    return PART == 0 ? I_FIN : PART == 1 ? I_FOUT + I_FIN + I_SQ + I_G + I_LIN : PART == 2 ? 2 * I_FOUT + I_FIN + I_KV : I_FOUT + I_FIN + 2 * I_SQ;
}
template <int PART>
__device__ __forceinline__ TItem decode_titem(int r, InTab in, unsigned char* ws) {
    constexpr int I_FIN = (DM / 64) * (2 * DFF / 32), I_FOUT = (DFF / 64) * (DM / 32), I_LIN = (DM / 64) * (2 * DM / 32), I_G = 16 * 32, I_SQ = (DM / 64) * (DM / 32), I_KV = (DM / 64) * (2 * DM / 32);
    TItem t;
#define TI_FOUT(mi_) { constexpr int nblk = DM / 32; const int kb = r / nblk, nb = r % nblk; \
        t.W = in[6] + (size_t)(mi_) * DFF * DM; t.ldw = DM; t.k0 = 64 * kb; t.n0 = 32 * nb; t.WT = (bf16*)(ws + WS_WFOUT) + (size_t)(mi_) * DM * DFF; t.Kdst = DFF; t.drow = 32 * nb; return t; }
#define TI_FIN(mi_) { constexpr int nblk = 2 * DFF / 32; const int kb = r / nblk, nb = r % nblk, n0 = 32 * nb; const int nn = n0 < DFF ? n0 : n0 - DFF;     \
        t.W = in[5] + (size_t)(mi_) * DM * 2 * DFF; t.ldw = 2 * DFF; t.k0 = 64 * kb; t.n0 = n0; t.WT = (bf16*)(ws + WS_WFIN) + (size_t)(mi_) * 2 * DFF * DM; t.Kdst = DM; t.drow = (nn >> 7) * 256 + (n0 < DFF ? 0 : 128) + (nn & 127); return t; }
#define TI_RECT(src_, N_, dst_) { constexpr int nblk = (N_) / 32; const int kb = r / nblk, nb = r % nblk; \
        t.W = (src_); t.ldw = (N_); t.k0 = 64 * kb; t.n0 = 32 * nb; t.WT = (bf16*)(ws + (dst_)); t.Kdst = DM; t.drow = 32 * nb; return t; }
    if constexpr (PART == 0) { TI_FIN(0) }
    else if constexpr (PART == 1) {
        if (r < I_FIN) TI_FIN(1) r -= I_FIN;
        if (r < I_SQ) TI_RECT(in[15], DM, WS_WLOUT) r -= I_SQ;
        if (r < I_G) { const int g = r >> 5, q = r & 31, head = g >> 1, which = g & 1, kb = q >> 3, nb = q & 7, n0 = 32 * nb;
            t.W = (which ? in[12] : in[10]) + (size_t)head * LRUB * LRUB; t.ldw = LRUB; t.k0 = 64 * kb; t.n0 = n0; t.WT = (bf16*)(ws + WS_WG); t.Kdst = LRUB;
            t.drow = (head * 2 + (n0 >> 7)) * 256 + which * 128 + (n0 & 127); return t; }
        r -= I_G;
        if (r < I_LIN) TI_RECT(in[7], 2 * DM, WS_WLIN) r -= I_LIN;
        TI_FOUT(0)
    } else if constexpr (PART == 2) {
        if (r < I_FOUT) TI_FOUT(2) r -= I_FOUT;
        if (r < I_FIN) TI_FIN(2) r -= I_FIN;
        if (r < I_KV) TI_RECT(in[19], 2 * DM, WS_WKV) r -= I_KV;
        TI_FOUT(1)
    } else {
        if (r < I_FOUT) TI_FOUT(3) r -= I_FOUT;
        if (r < I_SQ) TI_RECT(in[23], DM, WS_WO) r -= I_SQ;
        if (r < I_SQ) TI_RECT(in[20], DM, WS_WQ) r -= I_SQ;
        TI_FIN(3)
    }
#undef TI_FOUT
#undef TI_FIN
#undef TI_RECT
}
typedef __bf16 bf2_t __attribute__((ext_vector_type(2)));
typedef float f32x2_t __attribute__((ext_vector_type(2)));
__device__ __forceinline__ unsigned cvt2(float lo, float hi) { const f32x2_t f = {lo, hi}; return __builtin_bit_cast(unsigned, __builtin_convertvector(f, bf2_t)); }
__device__ __forceinline__ void titem_load(f32x4 (&v)[8], const TItem& t, int lane) {
    const float* p = t.W + (size_t)(t.k0 + (lane >> 3)) * t.ldw + t.n0 + (lane & 7) * 4;
#pragma unroll
    for (int i = 0; i < 8; ++i) v[i] = __builtin_nontemporal_load((const GAS f32x4*)(p + (size_t)(8 * i) * t.ldw));
}
__device__ __forceinline__ void titem_finish(const f32x4 (&v)[8], const TItem& t, LAS float* scr, int lane) {
    { const int r = lane >> 3, n4 = (lane & 7) * 4;
#pragma unroll
      for (int i = 0; i < 8; ++i) { LAS float* d = scr + (8 * i + r) * 33 + n4; d[0] = v[i].x; d[1] = v[i].y; d[2] = v[i].z; d[3] = v[i].w; } }
    LDS_WAIT(); asm volatile("" ::: "memory");
    const int c = lane & 7;
#pragma unroll
    for (int j = 0; j < 4; ++j) { const int n = (lane >> 3) + 8 * j; const LAS float* s = scr + (8 * c) * 33 + n;
        v4u o; o.x = cvt2(s[0 * 33], s[1 * 33]); o.y = cvt2(s[2 * 33], s[3 * 33]); o.z = cvt2(s[4 * 33], s[5 * 33]); o.w = cvt2(s[6 * 33], s[7 * 33]);
        *(GAS v4u*)(t.WT + (((size_t)(t.drow >> 8) * (t.Kdst >> 6) + (t.k0 >> 6)) * 256 + (t.drow & 255) + n) * 64 + 8 * c) = o; }
    LDS_WAIT(); asm volatile("" ::: "memory");
}
template <int PART>
__device__ __forceinline__ void weight_copies(const Ctx& X, InTab in, unsigned char* ws, int gw, int NGW) {
    LAS float* scr = (LAS float*)(X.lds + RING_OFF + X.wave * 16384);
    constexpr int NT_ = titem_count<PART>();
    int it = gw;
    if (it < NT_) {
        TItem cur = decode_titem<PART>(it, in, ws); f32x4 va[8], vb[8];
        titem_load(va, cur, X.lane);
        for (;;) {
            const int itn = it + NGW; const bool more = itn < NT_;
            TItem nxt = cur;
            if (more) { nxt = decode_titem<PART>(itn, in, ws); titem_load(vb, nxt, X.lane); }
            titem_finish(va, cur, scr, X.lane);
            if (!more) break;
#pragma unroll
            for (int i = 0; i < 8; ++i) va[i] = vb[i];
            cur = nxt; it = itn;
        }
    }
}
template <int UNR = 16>
__device__ __forceinline__ void mod_partials(const Ctx& X, InTab in, unsigned char* ws, int lo, int hi, int gw, int NGW) {
    for (int r = lo + gw; r < hi; r += NGW) {
        const int cg = r >> 4, kc = r & 15; const float* W; int ldw, cc;
        if (cg < 72) { W = in[2]; ldw = NMOD; cc = cg * 256; } else if (cg < 144) { W = in[2] + (size_t)DM * NMOD; ldw = NMOD; cc = (cg - 72) * 256; } else { W = in[17]; ldw = 4096; cc = (cg - 144) * 256; }
        const int kb = kc * 128;
        float ca[2][2];
#pragma unroll
        for (int b = 0; b < 2; ++b)
#pragma unroll
            for (int hh = 0; hh < 2; ++hh) ca[b][hh] = silu_f(in[1][b * DM + kb + hh * 64 + X.lane]);
        f32x4 acc0 = {0.f, 0.f, 0.f, 0.f}, acc1 = {0.f, 0.f, 0.f, 0.f};
        const float* wp = W + (size_t)kb * ldw + cc + 4 * X.lane;
#pragma unroll
        for (int hh = 0; hh < 2; ++hh) {
#pragma unroll UNR
            for (int kk = 0; kk < 64; ++kk) {
                const f32x4 w = __builtin_nontemporal_load((const GAS f32x4*)(wp + (size_t)(hh * 64 + kk) * ldw));
                const float s0 = __uint_as_float(__builtin_amdgcn_readlane(__float_as_uint(ca[0][hh]), kk));
                const float s1 = __uint_as_float(__builtin_amdgcn_readlane(__float_as_uint(ca[1][hh]), kk));
                acc0 += w * s0; acc1 += w * s1; }
        }
        *(GAS f32x4*)((float*)(ws + WS_MODP) + (size_t)(kc * 2 + 0) * NMODT + cg * 256 + 4 * X.lane) = acc0;
        *(GAS f32x4*)((float*)(ws + WS_MODP) + (size_t)(kc * 2 + 1) * NMODT + cg * 256 + 4 * X.lane) = acc1;
    }
}
__device__ __forceinline__ void mod_partials_q(const Ctx& X, InTab in, unsigned char* ws, int lo_cg, int hi_cg, int gw, int NGW) {
    const int cl = X.lane & 15, rg = X.lane >> 4, sl = (rg & 1) * 32;
    for (int r = lo_cg * 64 + gw; r < hi_cg * 64; r += NGW) {
        const int cg = r >> 6, kc = (r >> 2) & 15, q = r & 3; const float* W; int ldw, cc;
        if (cg < 72) { W = in[2]; ldw = NMOD; cc = cg * 256; } else if (cg < 144) { W = in[2] + (size_t)DM * NMOD; ldw = NMOD; cc = (cg - 72) * 256; } else { W = in[17]; ldw = 4096; cc = (cg - 144) * 256; }
        const int kb = kc * 128;
        float c0[2], c1[2];
#pragma unroll
        for (int b = 0; b < 2; ++b) { c0[b] = silu_f(in[1][b * DM + kb + X.lane]); c1[b] = silu_f(in[1][b * DM + kb + 64 + X.lane]); }
        f32x4 acc0 = {0.f, 0.f, 0.f, 0.f}, acc1 = {0.f, 0.f, 0.f, 0.f};
        const float* wp = W + (size_t)(kb + rg * 32) * ldw + cc + q * 64 + 4 * cl;
#pragma unroll 16
        for (int kk = 0; kk < 32; ++kk) {
            const f32x4 w = __builtin_nontemporal_load((const GAS f32x4*)(wp + (size_t)kk * ldw));
            const float a0 = __shfl(c0[0], sl + kk), a1 = __shfl(c1[0], sl + kk), b0 = __shfl(c0[1], sl + kk), b1 = __shfl(c1[1], sl + kk);
            const float s0 = rg < 2 ? a0 : a1, s1 = rg < 2 ? b0 : b1;
            acc0 += w * s0; acc1 += w * s1; }
#pragma unroll
        for (int e = 0; e < 4; ++e) { acc0[e] += __shfl_xor(acc0[e], 16); acc0[e] += __shfl_xor(acc0[e], 32); acc1[e] += __shfl_xor(acc1[e], 16); acc1[e] += __shfl_xor(acc1[e], 32); }
        if (rg == 0) {
            *(GAS f32x4*)((float*)(ws + WS_MODP) + (size_t)(kc * 2 + 0) * NMODT + cg * 256 + q * 64 + 4 * cl) = acc0;
            *(GAS f32x4*)((float*)(ws + WS_MODP) + (size_t)(kc * 2 + 1) * NMODT + cg * 256 + q * 64 + 4 * cl) = acc1; }
    }
}
__device__ __forceinline__ void p0_prologue(const Ctx& X, InTab in, unsigned char* ws) {
    mod_partials_q(X, in, ws, 0, 16, X.wave * X.G + X.vcu, X.NGW);
}
__device__ __forceinline__ void mod_reduce(const Ctx& X, const float* modp, const float* b_mod, const float* kv_b_mod, float* mod, int col_lo, int ncol) {
    for (int idx = blockIdx.x * (NWAVES * 64) + X.tid; idx < 2 * ncol; idx += X.G * NWAVES * 64) {
        const int b = idx >= ncol ? 1 : 0, col = col_lo + idx - b * ncol;
        float s = col < 2 * NMOD ? b_mod[col] : kv_b_mod[col - 2 * NMOD];
#pragma unroll
        for (int kc = 0; kc < 16; ++kc) s += modp[(size_t)(kc * 2 + b) * NMODT + col];
        mod[(size_t)b * NMODT + col] = s;
    }
}
__device__ __forceinline__ void p1_modreduce(const Ctx& X, const float* modp, const float* b_mod, const float* kv_b_mod, float* mod,
                                             const float* b_a, const float* b_x, const float* lam, float* gc) {
    mod_reduce(X, modp, b_mod, kv_b_mod, mod, 0, 2 * DM);
    for (int ch = blockIdx.x * (NWAVES * 64) + X.tid; ch < DM; ch += X.G * NWAVES * 64) {
        const float z = -lam[ch];
        gc[ch] = b_a[ch]; gc[DM + ch] = b_x[ch]; gc[2 * DM + ch] = 8.0f * (fmaxf(z, 0.f) + log1pf(expf(-fabsf(z))));
    }
}

struct NormArgs { const float* xin; const float* y; float* xout; bf16* h1; bf16* h2; float wgt;
                  const float *gpost, *gate;
                  const float *gpre1, *scale1, *shift1, *gpre2, *scale2, *shift2; };
__device__ __forceinline__ void norm_phase(const Ctx& X, const NormArgs& a) {
    LAS float* V = (LAS float*)(X.lds + RING_OFF);
    for (int it = blockIdx.x; it < M / 32; it += X.G) {
        const int b = (it * 32) / SEQ;
        for (int c = X.tid; c < DM; c += NWAVES * 64) {
            if (a.y)  V[c] = a.wgt * a.gate[(size_t)b * NMODT + c] * a.gpost[c];
            if (a.h1) { V[DM + c] = a.gpre1[c] * (1.0f + a.scale1[(size_t)b * NMODT + c]); V[2 * DM + c] = a.shift1[(size_t)b * NMODT + c]; }
            if (a.h2) { V[3 * DM + c] = a.gpre2[c] * (1.0f + a.scale2[(size_t)b * NMODT + c]); V[4 * DM + c] = a.shift2[(size_t)b * NMODT + c]; }
        }
        __syncthreads();
#pragma unroll 1
        for (int rr = 0; rr < 4; ++rr) {
            const size_t row = (size_t)it * 32 + X.wave * 4 + rr;
            f32x4 xv[8];
#pragma unroll
            for (int j = 0; j < 8; ++j) xv[j] = *(const GAS f32x4*)(a.xin + row * DM + 256 * j + 4 * X.lane);
            if (a.y) {
                f32x4 yv[8]; float ss = 0.f;
#pragma unroll
                for (int j = 0; j < 8; ++j) { yv[j] = *(const GAS f32x4*)(a.y + row * DM + 256 * j + 4 * X.lane); ss += (yv[j].x * yv[j].x + yv[j].y * yv[j].y) + (yv[j].z * yv[j].z + yv[j].w * yv[j].w); }
                const float rs = 1.0f / sqrtf(wave_sum(ss) * (1.0f / DM) + NORM_EPS);
#pragma unroll
                for (int j = 0; j < 8; ++j) { const f32x4 ca = *(const LAS f32x4*)(V + 256 * j + 4 * X.lane); xv[j] += ca * (yv[j] * rs); }
            }
            asm volatile("" ::: "memory");
            if (a.xout) {
#pragma unroll
                for (int j = 0; j < 8; ++j) *(GAS f32x4*)(a.xout + row * DM + 256 * j + 4 * X.lane) = xv[j];
            }
            if (a.h1 || a.h2) {
                float ss = 0.f;
#pragma unroll
                for (int j = 0; j < 8; ++j) ss += (xv[j].x * xv[j].x + xv[j].y * xv[j].y) + (xv[j].z * xv[j].z + xv[j].w * xv[j].w);
                const float rs = 1.0f / sqrtf(wave_sum(ss) * (1.0f / DM) + NORM_EPS);
                asm volatile("" ::: "memory");
                if (a.h1) {
#pragma unroll
                    for (int j = 0; j < 8; ++j) { const f32x4 cb = *(const LAS f32x4*)(V + DM + 256 * j + 4 * X.lane), cc = *(const LAS f32x4*)(V + 2 * DM + 256 * j + 4 * X.lane);
                        const f32x4 h = xv[j] * rs * cb + cc; v2u o; o.x = pk2(h.x, h.y); o.y = pk2(h.z, h.w);
                        *(GAS v2u*)(a.h1 + row * DM + 256 * j + 4 * X.lane) = o; }
                }
                asm volatile("" ::: "memory");
                if (a.h2) {
#pragma unroll
                    for (int j = 0; j < 8; ++j) { const f32x4 cb = *(const LAS f32x4*)(V + 3 * DM + 256 * j + 4 * X.lane), cc = *(const LAS f32x4*)(V + 4 * DM + 256 * j + 4 * X.lane);
                        const f32x4 h = xv[j] * rs * cb + cc; v2u o; o.x = pk2(h.x, h.y); o.y = pk2(h.z, h.w);
                        *(GAS v2u*)(a.h2 + row * DM + 256 * j + 4 * X.lane) = o; }
                }
            }
        }
        __syncthreads();
    }
}

__device__ __forceinline__ void norm0_phase(const Ctx& X, const float* xin, bf16* h1, const float* gpre1, const float* scale1, const float* shift1) {
    LAS float* V = (LAS float*)(X.lds + RING_OFF);
    for (int it = blockIdx.x; it < M / 32; it += X.G) {
        const int b = (it * 32) / SEQ;
        f32x4 xv[4][4][2];
#pragma unroll
        for (int rr = 0; rr < 4; ++rr) { const size_t row = (size_t)it * 32 + X.wave * 4 + rr;
#pragma unroll
            for (int j = 0; j < 4; ++j) { xv[rr][j][0] = *(const GAS f32x4*)(xin + row * DM + 512 * j + 8 * X.lane); xv[rr][j][1] = *(const GAS f32x4*)(xin + row * DM + 512 * j + 8 * X.lane + 4); } }
        for (int c = X.tid; c < DM; c += NWAVES * 64) { V[c] = gpre1[c] * (1.0f + scale1[(size_t)b * NMODT + c]); V[DM + c] = shift1[(size_t)b * NMODT + c]; }
        __syncthreads();
#pragma unroll
        for (int rr = 0; rr < 4; ++rr) { const size_t row = (size_t)it * 32 + X.wave * 4 + rr;
            float ss = 0.f;
#pragma unroll
            for (int j = 0; j < 4; ++j)
#pragma unroll
                for (int e = 0; e < 2; ++e) { const f32x4 v = xv[rr][j][e]; ss += (v.x * v.x + v.y * v.y) + (v.z * v.z + v.w * v.w); }
            const float rs = 1.0f / sqrtf(wave_sum(ss) * (1.0f / DM) + NORM_EPS);
#pragma unroll
            for (int j = 0; j < 4; ++j) { v4u o;
#pragma unroll
                for (int e = 0; e < 2; ++e) { const f32x4 cb = *(const LAS f32x4*)(V + 512 * j + 8 * X.lane + 4 * e), cc = *(const LAS f32x4*)(V + DM + 512 * j + 8 * X.lane + 4 * e);
                    const f32x4 h = xv[rr][j][e] * rs * cb + cc; if (e == 0) { o.x = pk2(h.x, h.y); o.y = pk2(h.z, h.w); } else { o.z = pk2(h.x, h.y); o.w = pk2(h.z, h.w); } }
                *(GAS v4u*)(h1 + row * DM + 512 * j + 8 * X.lane) = o; }
            asm volatile("" ::: "memory");
        }
        __syncthreads();
    }
}

__device__ __forceinline__ void conv_phase(const Ctx& X, const bf16* xr, const float* cw, const float* cb, bf16* xrc) {
    for (int w4 = X.gw; w4 < M / 4; w4 += X.NGW) {
        const int row0 = 4 * w4, t0 = row0 % SEQ;
#pragma unroll 1
        for (int j = 0; j < 4; ++j) {
            const int ch0 = j * 512 + 8 * X.lane;
            float wv[4][8], bv[8];
#pragma unroll
            for (int k = 0; k < 4; ++k) { const f32x4 w0 = *(const GAS f32x4*)(cw + k * DM + ch0), w1 = *(const GAS f32x4*)(cw + k * DM + ch0 + 4);
                wv[k][0] = w0.x; wv[k][1] = w0.y; wv[k][2] = w0.z; wv[k][3] = w0.w; wv[k][4] = w1.x; wv[k][5] = w1.y; wv[k][6] = w1.z; wv[k][7] = w1.w; }
            { const f32x4 b0 = *(const GAS f32x4*)(cb + ch0), b1 = *(const GAS f32x4*)(cb + ch0 + 4); bv[0] = b0.x; bv[1] = b0.y; bv[2] = b0.z; bv[3] = b0.w; bv[4] = b1.x; bv[5] = b1.y; bv[6] = b1.z; bv[7] = b1.w; }
            float xin[7][8];
#pragma unroll
            for (int i = 0; i < 7; ++i) {
                v4u w = {0u, 0u, 0u, 0u};
                if (t0 - 3 + i >= 0) w = *(const GAS v4u*)(xr + (size_t)(row0 - 3 + i) * DM + ch0);
                xin[i][0] = bflo(w.x); xin[i][1] = bfhi(w.x); xin[i][2] = bflo(w.y); xin[i][3] = bfhi(w.y); xin[i][4] = bflo(w.z); xin[i][5] = bfhi(w.z); xin[i][6] = bflo(w.w); xin[i][7] = bfhi(w.w); }
#pragma unroll
            for (int r = 0; r < 4; ++r) { float o[8];
#pragma unroll
                for (int e = 0; e < 8; ++e) { float s = bv[e];
#pragma unroll
                    for (int k = 0; k < 4; ++k) s += wv[k][e] * xin[r + k][e];
                    o[e] = s; }
                v4u w; w.x = pk2(o[0], o[1]); w.y = pk2(o[2], o[3]); w.z = pk2(o[4], o[5]); w.w = pk2(o[6], o[7]);
                *(GAS v4u*)(xrc + (size_t)(row0 + r) * DM + ch0) = w; }
        }
    }
}

__device__ __forceinline__ void scan_a_phase(const Ctx& X, const unsigned* AU, float* agp, float* agh, float* sagp, float* sagh) {
    LAS float* Pl = (LAS float*)(X.lds + RING_OFF); LAS float* Hl = Pl + 8 * 256;
    for (int bi = blockIdx.x; bi < 256; bi += X.G) {
        const int b = bi >> 7, sc = (bi >> 3) & 15, cg = bi & 7, chunk = sc * 8 + X.wave, ch = cg * 256 + 4 * X.lane;
        const size_t row0 = (size_t)b * SEQ + chunk * 32;
        f32x4 P = {1.f, 1.f, 1.f, 1.f}, H = {0.f, 0.f, 0.f, 0.f};
#pragma unroll 1
        for (int tb = 0; tb < 4; ++tb) {
            v4u wv[8];
#pragma unroll
            for (int i = 0; i < 8; ++i) wv[i] = *(const GAS v4u*)(AU + (row0 + tb * 8 + i) * DM + ch);
#pragma unroll
            for (int i = 0; i < 8; ++i) { const f32x4 a = {__builtin_amdgcn_exp2f(bflo(wv[i].x)), __builtin_amdgcn_exp2f(bflo(wv[i].y)), __builtin_amdgcn_exp2f(bflo(wv[i].z)), __builtin_amdgcn_exp2f(bflo(wv[i].w))};
                const f32x4 u = {bfhi(wv[i].x), bfhi(wv[i].y), bfhi(wv[i].z), bfhi(wv[i].w)}; H = a * H + u; P = P * a; }
        }
        *(GAS f32x4*)(agp + ((size_t)b * 128 + chunk) * DM + ch) = P; *(GAS f32x4*)(agh + ((size_t)b * 128 + chunk) * DM + ch) = H;
        *(LAS f32x4*)(Pl + X.wave * 256 + 4 * X.lane) = P; *(LAS f32x4*)(Hl + X.wave * 256 + 4 * X.lane) = H;
        __syncthreads();
        if (X.tid < 256) { float p = 1.f, h = 0.f;
#pragma unroll
            for (int w = 0; w < 8; ++w) { const float pw = Pl[w * 256 + X.tid], hw = Hl[w * 256 + X.tid]; h = pw * h + hw; p *= pw; }
            sagp[((size_t)b * 16 + sc) * DM + cg * 256 + X.tid] = p; sagh[((size_t)b * 16 + sc) * DM + cg * 256 + X.tid] = h; }
        __syncthreads();
    }
}
__device__ __forceinline__ void scan_b_phase(const Ctx& X, const unsigned* AU, const float* agp, const float* agh, const float* sagp, const float* sagh, const bf16* yg, bf16* hg) {
    for (int bi = blockIdx.x; bi < 256; bi += X.G) {
        const int b = bi >> 7, sc = (bi >> 3) & 15, cg = bi & 7, chunk = sc * 8 + X.wave, ch = cg * 256 + 4 * X.lane;
        const int chy = cg * 256 + (X.lane >> 3) * 32 + 8 * (X.lane & 3) + 4 * ((X.lane >> 2) & 1);
        const size_t row0 = (size_t)b * SEQ + chunk * 32;
        f32x4 h = {0.f, 0.f, 0.f, 0.f};
        {
            f32x4 pv[15], hv[15];
#pragma unroll
            for (int s = 0; s < 15; ++s) { const int ss = s < sc ? s : 0; pv[s] = *(const GAS f32x4*)(sagp + ((size_t)b * 16 + ss) * DM + ch); hv[s] = *(const GAS f32x4*)(sagh + ((size_t)b * 16 + ss) * DM + ch); }
#pragma unroll
            for (int s = 0; s < 15; ++s) if (s < sc) h = pv[s] * h + hv[s];
        }
        {
            f32x4 pv[7], hv[7];
#pragma unroll
            for (int w = 0; w < 7; ++w) { const int ww = w < X.wave ? w : 0; pv[w] = *(const GAS f32x4*)(agp + ((size_t)b * 128 + sc * 8 + ww) * DM + ch); hv[w] = *(const GAS f32x4*)(agh + ((size_t)b * 128 + sc * 8 + ww) * DM + ch); }
#pragma unroll
            for (int w = 0; w < 7; ++w) if (w < X.wave) h = pv[w] * h + hv[w];
        }
#pragma unroll 1
        for (int tb = 0; tb < 4; ++tb) {
            v4u wv[8]; v2u gv[8];
#pragma unroll
            for (int i = 0; i < 8; ++i) { const size_t o = (row0 + tb * 8 + i) * DM + ch; wv[i] = *(const GAS v4u*)(AU + o); gv[i] = *(const GAS v2u*)(yg + (row0 + tb * 8 + i) * DM + chy); }
#pragma unroll
            for (int i = 0; i < 8; ++i) { const f32x4 a = {__builtin_amdgcn_exp2f(bflo(wv[i].x)), __builtin_amdgcn_exp2f(bflo(wv[i].y)), __builtin_amdgcn_exp2f(bflo(wv[i].z)), __builtin_amdgcn_exp2f(bflo(wv[i].w))};
                const f32x4 u = {bfhi(wv[i].x), bfhi(wv[i].y), bfhi(wv[i].z), bfhi(wv[i].w)}; h = a * h + u;
                v2u o; o.x = pk2(h.x * bflo(gv[i].x), h.y * bfhi(gv[i].x)); o.y = pk2(h.z * bflo(gv[i].y), h.w * bfhi(gv[i].y));
                *(GAS v2u*)(hg + (row0 + tb * 8 + i) * DM + chy) = o; }
        }
    }
}

__device__ __forceinline__ void headnorm_phase(const Ctx& X, const bf16* oc, const float* lqk, const float* gsub, bf16* on) {
    float d01 = lqk[X.lane] * lqk[128 + X.lane] + lqk[64 + X.lane] * lqk[192 + X.lane];
    float d23 = lqk[256 + X.lane] * lqk[384 + X.lane] + lqk[320 + X.lane] * lqk[448 + X.lane];
    d01 = wave_sum(d01); d23 = wave_sum(d23);
    const float lam = expf(d01) - expf(d23) + LAM_INIT;
    const int l32 = X.lane & 31, hsel = X.lane >> 5;
    const f32x4 gs0 = *(const GAS f32x4*)(gsub + 8 * l32) * (1.0f - LAM_INIT), gs1 = *(const GAS f32x4*)(gsub + 8 * l32 + 4) * (1.0f - LAM_INIT);
    for (int w4 = X.gw; w4 < M / 4; w4 += X.NGW) {
#pragma unroll 1
        for (int rr = 0; rr < 4; ++rr) { const size_t row = (size_t)w4 * 4 + rr;
            v4u a0[4], a1[4];
#pragma unroll
            for (int hp = 0; hp < 4; ++hp) { const size_t o = row * 4096 + (size_t)(2 * hp + hsel) * 512 + 8 * l32; a0[hp] = *(const GAS v4u*)(oc + o); a1[hp] = *(const GAS v4u*)(oc + o + 256); }
#pragma unroll
            for (int hp = 0; hp < 4; ++hp) {
                f32x4 o0 = {bflo(a0[hp].x) - lam * bflo(a1[hp].x), bfhi(a0[hp].x) - lam * bfhi(a1[hp].x), bflo(a0[hp].y) - lam * bflo(a1[hp].y), bfhi(a0[hp].y) - lam * bfhi(a1[hp].y)};
                f32x4 o1 = {bflo(a0[hp].z) - lam * bflo(a1[hp].z), bfhi(a0[hp].z) - lam * bfhi(a1[hp].z), bflo(a0[hp].w) - lam * bflo(a1[hp].w), bfhi(a0[hp].w) - lam * bfhi(a1[hp].w)};
                float ss = ((o0.x * o0.x + o0.y * o0.y) + (o0.z * o0.z + o0.w * o0.w)) + ((o1.x * o1.x + o1.y * o1.y) + (o1.z * o1.z + o1.w * o1.w));
#pragma unroll
                for (int s = 1; s < 32; s <<= 1) ss += __shfl_xor(ss, s);
                const float rs = 1.0f / sqrtf(ss * (1.0f / VD) + NORM_EPS);
                o0 = o0 * rs * gs0; o1 = o1 * rs * gs1;
                v4u w; w.x = pk2(o0.x, o0.y); w.y = pk2(o0.z, o0.w); w.z = pk2(o1.x, o1.y); w.w = pk2(o1.z, o1.w);
                *(GAS v4u*)(on + row * DM + (size_t)(2 * hp + hsel) * VD + 8 * l32) = w; }
        }
    }
}

__device__ __forceinline__ void attn_phase(const Ctx& X, const bf16* Q, const bf16* K, const bf16* V, float* T, bf16* ON, const float* lqk, const float* gsub, char* lds) {
    float d01 = lqk[X.lane] * lqk[128 + X.lane] + lqk[64 + X.lane] * lqk[192 + X.lane];
    float d23 = lqk[256 + X.lane] * lqk[384 + X.lane] + lqk[320 + X.lane] * lqk[448 + X.lane];
    d01 = wave_sum(d01); d23 = wave_sum(d23);
    const float lam = expf(d01) - expf(d23) + LAM_INIT;
    for (int L = X.vcu; L < 512; L += X.G) {
        const int r = L >> 8, hd = (L >> 5) & 7, i = L & 31, b = r, qb = r ? 31 - i : i;
        attn_pc::Block it;
        it.V0 = (V + (size_t)((b * 8 + hd) * 2 + 0) * SEQ * 128);
        it.V1 = (V + (size_t)((b * 8 + hd) * 2 + 1) * SEQ * 128);
        it.O = (ON + ((size_t)b * SEQ + (size_t)qb * 128) * DM + hd * 256);
        it.P0 = qb * 128; it.T = T + (size_t)(((b * 8 + hd) * 32 + qb) * 4) * 8192; it.lam = lam; it.gsub = gsub;
        it.Q = (Q + ((size_t)((b * 8 + hd) * 2 + 0) * SEQ + (size_t)qb * 128) * 128); it.K = (K + (size_t)((b * 8 + hd) * 2 + 0) * SEQ * 128);
        attn_pc::block<0>(it, lds);
        it.Q = (Q + ((size_t)((b * 8 + hd) * 2 + 1) * SEQ + (size_t)qb * 128) * 128); it.K = (K + (size_t)((b * 8 + hd) * 2 + 1) * SEQ * 128);
        attn_pc::block<1>(it, lds);
    }
}
struct Args { const float* in[24]; float* out; unsigned char* ws; int ph_lo, ph_hi; };
typedef const Args __attribute__((address_space(4)))* ArgP;
__device__ __forceinline__ Ctx make_ctx(LAS unsigned char* lds) {
    Ctx X; X.lds = lds; int t = threadIdx.x; asm volatile("" : "+v"(t));
    X.tid = t; X.lane = t & 63; X.wave = __builtin_amdgcn_readfirstlane(t >> 6);
    X.G = gridDim.x; { const int bx = blockIdx.x; X.vcu = (X.G % 8 == 0) ? (bx % 8) * (X.G / 8) + bx / 8 : bx; }
    X.gw = X.vcu * NWAVES + X.wave; X.NGW = X.G * NWAVES; return X;
}
__global__ void __launch_bounds__(NWAVES * 64, 2) trunk_fwd(Args args_by_value) {
    extern __shared__ __attribute__((aligned(16))) unsigned char lds[];
    LAS unsigned char* const ldsb = (LAS unsigned char*)lds;
    volatile LAS unsigned* MISC = (volatile LAS unsigned*)(ldsb + MISC_OFF);
    ArgP ap0 = (ArgP)__builtin_amdgcn_kernarg_segment_ptr();
    for (int u = threadIdx.x; u < (LDS_BYTES - LDSCTL_OFF) / 4; u += NWAVES * 64) ((LAS unsigned*)(ldsb + LDSCTL_OFF))[u] = 0u;
    __syncthreads();
    const int lo = ap0->ph_lo; int hi = ap0->ph_hi;
    XcdBarrier bar; bar.bar = (unsigned*)(ap0->ws + WS_CTL) + CW_BAR; bar.x = 0; bar.st = nullptr;
    if (!MK_PER_PHASE) bar = xcd_barrier_post((unsigned*)(ap0->ws + WS_CTL) + CW_BAR, MISC + 8);
#define GRID_BAR() do { if (!MK_PER_PHASE) xcd_barrier(bar); } while (0)
#ifndef PH_MASK
#define PH_MASK 0xFFFFFFFFu
#endif
#define IN(k) (((PH_MASK >> (k)) & 1u) && lo <= (k) && (k) < hi)
#define SEAM(k) do { if (lo <= (k) + 1 && (k) + 1 < hi) GRID_BAR(); } while (0)
#ifndef REP_MASK
#define REP_MASK 0u
#endif
#ifdef PROBE_STAMP_LO
    unsigned long long pt0 = 0ull, pt1 = 0ull, pc0 = 0ull, pc1 = 0ull;
#define STAMP_BEGIN(k) do { if ((k) == PROBE_STAMP_LO && blockIdx.x == 0) { pt0 = __builtin_amdgcn_s_memrealtime(); pc0 = __builtin_amdgcn_s_memtime(); } } while (0)
#define STAMP_END(k) do { if ((k) == PROBE_STAMP_HI && blockIdx.x == 0) { pt1 = __builtin_amdgcn_s_memrealtime(); pc1 = __builtin_amdgcn_s_memtime(); } } while (0)
#else
#define STAMP_BEGIN(k) do { } while (0)
#define STAMP_END(k) do { } while (0)
#endif
#define PHASE(k, ...) STAMP_BEGIN(k); if (IN(k)) { PH_BEGIN(k); __VA_ARGS__ } if (((REP_MASK >> (k)) & 1u) && IN(k)) { GRID_BAR(); { PH_BEGIN(k); __VA_ARGS__ } } if ((k) + 1 < NPH) SEAM(k); STAMP_END(k);
#define PH_BEGIN(k) asm volatile("; ===PHASE " #k); const Ctx X = make_ctx(ldsb); ArgP ap = ap0; asm volatile("" : "+s"(ap)); InTab in = (InTab)ap; unsigned char* const ws = ap->ws; (void)in; (void)ws; (void)X
#define WSF(off) ((float*)(ws + (off)))
#define WSB(off) ((bf16*)(ws + (off)))
#define MODV(l, j, k) ((const float*)WSF(WS_MOD) + (size_t)(l) * NMOD + ((j) * 3 + (k)) * DM)
#define GAIN(l, i) (in[4] + ((l) * 6 + (i)) * DM)
#ifndef SWIGLU_SP2
#define SWIGLU_SP2 true
#endif
#define GEMM_SWIGLU(mi) do { pg8::Gemm g{WSB(WS_H), WSB(WS_WFIN) + (size_t)(mi) * 2 * DFF * DM, M, 2 * DFF, DM, DM, 0}; pg8::StaticOrder S; S.init(M, 2 * DFF, X.G, (int)blockIdx.x); \
        pg8::EpiSwiglu E{WSB(WS_ACT), DFF}; pg8::gemm_phase<pg8::EpiSwiglu, pg8::StaticOrder, true, SWIGLU_SP2>(X.lds + RING_OFF, g, S, E); } while (0)
#ifndef NSVC
#define NSVC 36
#endif
#ifdef PROBE_SVC_PART
#define SVC_T0(p_) unsigned long long svc_t0 = 0; if ((p_) == PROBE_SVC_PART && blockIdx.x == 0 && X.wave == 0) svc_t0 = __builtin_amdgcn_s_memtime()
#define SVC_T1(p_) do { if ((p_) == PROBE_SVC_PART && blockIdx.x == 0 && X.wave == 0 && X.lane == 0) { LAS unsigned* pw = (LAS unsigned*)(ldsb + 151552 + 512); *pw = *pw + (unsigned)(__builtin_amdgcn_s_memtime() - svc_t0); } } while (0)
#else
#define SVC_T0(p_) do { } while (0)
#define SVC_T1(p_) do { } while (0)
#endif
#define SVC_MOD_NONE(gw_, ngw_) do { } while (0)
#define SVC_MOD_C(gw_, ngw_) mod_partials(X, in, ws, 16 * 16, 72 * 16, gw_, ngw_)
#define SVC_MOD_A(gw_, ngw_) do { mod_partials<4>(X, in, ws, 72 * 16, 96 * 16, gw_, ngw_); mod_partials<4>(X, in, ws, 144 * 16, 160 * 16, gw_, ngw_); } while (0)
#define SVC_MOD_B(gw_, ngw_) mod_partials<4>(X, in, ws, 96 * 16, 144 * 16, gw_, ngw_)
#define MOD_REDUCE(col_lo_, ncol_) mod_reduce(X, WSF(WS_MODP), in[3], in[18], WSF(WS_MOD), col_lo_, ncol_)
#define GEMM_SWIGLU_SVC(mi, part_, MODF) do { if (X.G > 2 * NSVC && NSVC > 0) { \
        if ((int)blockIdx.x < NSVC) { SVC_T0(part_); MODF((int)blockIdx.x * NWAVES + X.wave, NSVC * NWAVES); weight_copies<part_>(X, in, ws, (int)blockIdx.x * NWAVES + X.wave, NSVC * NWAVES); SVC_T1(part_); } \
        else { pg8::Gemm g{WSB(WS_H), WSB(WS_WFIN) + (size_t)(mi) * 2 * DFF * DM, M, 2 * DFF, DM, DM, 0}; pg8::StaticOrder S; S.init(M, 2 * DFF, X.G - NSVC, (int)blockIdx.x - NSVC); \
               pg8::EpiSwiglu E{WSB(WS_ACT), DFF}; pg8::gemm_phase<pg8::EpiSwiglu, pg8::StaticOrder, true, SWIGLU_SP2>(X.lds + RING_OFF, g, S, E); } } \
        else { MODF(X.gw, X.NGW); weight_copies<part_>(X, in, ws, X.gw, X.NGW); GEMM_SWIGLU(mi); } } while (0)
#define GEMM_F32(Aop, Wt, Kdim) do { pg8::Gemm g{Aop, Wt, M, DM, Kdim, Kdim, 0}; pg8::StaticOrder S; S.init(M, DM, X.G, (int)blockIdx.x); \
        pg8::EpiF32 E{WSF(WS_Y), DM}; pg8::gemm_phase<pg8::EpiF32, pg8::StaticOrder, false>(X.lds + RING_OFF, g, S, E); } while (0)
#define NORM(xin_, y_, xout_, h1_, h2_, wgt_, gpost_, gate_, gpre1_, scale1_, shift1_, gpre2_, scale2_, shift2_) do { \
        NormArgs a{xin_, y_, xout_, h1_, h2_, wgt_, gpost_, gate_, gpre1_, scale1_, shift1_, gpre2_, scale2_, shift2_}; norm_phase(X, a); } while (0)

#define OFFP(p_, bo_) ((p_) ? (p_) + (bo_) : nullptr)
#define GEMM_NORM(bank, XBF, Aop, Wt, Kdim, xin_, xout_, h1_, h2_, wgt_, gpost_, gate_, gpre1_, scale1_, shift1_, gpre2_, scale2_, shift2_) do { \
        if (X.G == 256) { pg8::Gemm g{Aop, Wt, M, DM, Kdim, Kdim, 0}; pg8::StaticOrder S; S.init(M, DM, X.G, (int)blockIdx.x); \
            pg8::Unit u0; (void)S.next(0, u0); const size_t bo = (size_t)(u0.pm >> 4) * NMODT; \
            pg8::RowStats s1{WSF(WS_XSLOT) + (size_t)(2 * (bank)) * 65536, bar}; \
            pg8::RowStats s2{WSF(WS_XSLOT) + (size_t)(2 * (bank) + 1) * 65536, bar}; \
            pg8::EpiNormT<XBF> E{xin_, xout_, h1_, h2_, wgt_, gpost_, (gate_) + bo, gpre1_, OFFP(scale1_, bo), OFFP(shift1_, bo), gpre2_, OFFP(scale2_, bo), OFFP(shift2_, bo), s1, s2}; \
            pg8::gemm_phase<pg8::EpiNormT<XBF>, pg8::StaticOrder, false>(X.lds + RING_OFF, g, S, E); } \
        else { GEMM_F32(Aop, Wt, Kdim); GRID_BAR(); NORM(xin_, WSF(WS_Y), xout_, h1_, h2_, wgt_, gpost_, gate_, gpre1_, scale1_, shift1_, gpre2_, scale2_, shift2_); } } while (0)
#define NOF ((const float*)nullptr)
#define NOB ((bf16*)nullptr)

#ifdef PROBE_HI2
    for (int pass = 0; pass < 2; ++pass) { if (pass == 1) { GRID_BAR(); hi = PROBE_HI2; }
#endif
    PHASE(0, p0_prologue(X, in, ws);)
    PHASE(1, p1_modreduce(X, WSF(WS_MODP), in[3], in[18], WSF(WS_MOD), in[11], in[13], in[14], WSF(WS_GC)); weight_copies<0>(X, in, ws, X.gw, X.NGW);)
    PHASE(2, norm0_phase(X, in[0], WSB(WS_H), GAIN(0, 0), MODV(0, 0, 1), MODV(0, 0, 0));)
#ifdef PROBE_IDLE_TICKS
    { const unsigned long long te = __builtin_amdgcn_s_memrealtime(); while (__builtin_amdgcn_s_memrealtime() - te < (unsigned long long)PROBE_IDLE_TICKS) __builtin_amdgcn_s_sleep(32); }
#endif
    PHASE(3, GEMM_SWIGLU_SVC(0, 1, SVC_MOD_C);)
    PHASE(4, MOD_REDUCE(2 * DM, 3 * DM);
        GEMM_NORM(0, false, WSB(WS_ACT), WSB(WS_WFOUT) + (size_t)0 * DM * DFF, DFF, in[0], WSF(WS_XS), WSB(WS_H), NOB, 0.5f, GAIN(0, 1), MODV(0, 0, 2), GAIN(0, 2), MODV(0, 1, 1), MODV(0, 1, 0), NOF, NOF, NOF);)
    PHASE(5, pg8::Gemm g{WSB(WS_H), WSB(WS_WLIN), M, 2 * DM, DM, DM, 0}; pg8::StaticOrder S; S.init(M, 2 * DM, X.G, (int)blockIdx.x);
        pg8::EpiLruIn E{WSB(WS_YG), WSB(WS_XR), DM, DM / 256}; pg8::gemm_phase<pg8::EpiLruIn, pg8::StaticOrder, true>(X.lds + RING_OFF, g, S, E);)
    PHASE(6, conv_phase(X, WSB(WS_XR), in[8], in[9], WSB(WS_XRC));)
    PHASE(7, int kdim = LRUB; asm volatile("" : "+s"(kdim));
        pg8::Gemm g{WSB(WS_XRC), WSB(WS_WG), M, 2 * DM, kdim, DM, LRUB}; pg8::StaticOrder S; S.init(M, 2 * DM, X.G, (int)blockIdx.x);
        pg8::EpiGates E{WSB(WS_XRC), (unsigned*)(ws + WS_A), DM, WSF(WS_GC)}; pg8::gemm_phase<pg8::EpiGates, pg8::StaticOrder, true>(X.lds + RING_OFF, g, S, E);)
    PHASE(8, scan_a_phase(X, (const unsigned*)(ws + WS_A), WSF(WS_AGP), WSF(WS_AGH), WSF(WS_SAGP), WSF(WS_SAGH));)
    PHASE(9, scan_b_phase(X, (const unsigned*)(ws + WS_A), WSF(WS_AGP), WSF(WS_AGH), WSF(WS_SAGP), WSF(WS_SAGH), WSB(WS_YG), WSB(WS_HG));)
    PHASE(10, MOD_REDUCE(5 * DM, 4 * DM);
        GEMM_NORM(1, true, WSB(WS_HG), WSB(WS_WLOUT), DM, WSF(WS_XS), WSF(WS_XS), WSB(WS_H), NOB, 1.0f, GAIN(0, 3), MODV(0, 1, 2), GAIN(0, 4), MODV(0, 2, 1), MODV(0, 2, 0), NOF, NOF, NOF);)
    PHASE(11, GEMM_SWIGLU_SVC(1, 2, SVC_MOD_A);)
    PHASE(12, MOD_REDUCE(NMOD, 3 * DM); MOD_REDUCE(2 * NMOD, 4096);
        GEMM_NORM(2, true, WSB(WS_ACT), WSB(WS_WFOUT) + (size_t)1 * DM * DFF, DFF, WSF(WS_XS), WSF(WS_XS), WSB(WS_H), WSB(WS_HKV), 0.5f, GAIN(0, 5), MODV(0, 2, 2), GAIN(1, 0), MODV(1, 0, 1), MODV(1, 0, 0),
                        in[16], WSF(WS_MOD) + 2 * NMOD + DM, WSF(WS_MOD) + 2 * NMOD);)
    PHASE(13, { pg8::Gemm g{WSB(WS_HKV), WSB(WS_WKV), M, 2 * DM, DM, DM, 0}; pg8::StaticOrder S; S.init(M, 2 * DM, X.G, (int)blockIdx.x);
          pg8::EpiHead E{WSB(WS_K), WSB(WS_V), 8, SEQ}; pg8::gemm_phase<pg8::EpiHead, pg8::StaticOrder, true>(X.lds + RING_OFF, g, S, E); }
        GEMM_SWIGLU_SVC(2, 3, SVC_MOD_B);)
    PHASE(14, MOD_REDUCE(NMOD + 3 * DM, 6 * DM);
        GEMM_NORM(3, true, WSB(WS_ACT), WSB(WS_WFOUT) + (size_t)2 * DM * DFF, DFF, WSF(WS_XS), WSF(WS_XS), WSB(WS_H), NOB, 0.5f, GAIN(1, 1), MODV(1, 0, 2), GAIN(1, 2), MODV(1, 1, 1), MODV(1, 1, 0), NOF, NOF, NOF);)
    PHASE(15, pg8::Gemm g{WSB(WS_H), WSB(WS_WQ), M, DM, DM, DM, 0}; pg8::StaticOrder S; S.init(M, DM, X.G, (int)blockIdx.x);
        pg8::EpiHead E{WSB(WS_Q), WSB(WS_Q), 8, SEQ}; pg8::gemm_phase<pg8::EpiHead, pg8::StaticOrder, false>(X.lds + RING_OFF, g, S, E);)
    PHASE(16, attn_phase(X, WSB(WS_Q), WSB(WS_K), WSB(WS_V), WSF(WS_OC), WSB(WS_ON), in[21], in[22], (char*)lds + RING_OFF);)
    PHASE(18, GEMM_NORM(4, true, WSB(WS_ON), WSB(WS_WO), DM, WSF(WS_XS), WSF(WS_XS), WSB(WS_H), NOB, 1.0f, GAIN(1, 3), MODV(1, 1, 2), GAIN(1, 4), MODV(1, 2, 1), MODV(1, 2, 0), NOF, NOF, NOF);)
    PHASE(19, GEMM_SWIGLU(3);)
    PHASE(20, GEMM_NORM(5, true, WSB(WS_ACT), WSB(WS_WFOUT) + (size_t)3 * DM * DFF, DFF, WSF(WS_XS), ap->out, NOB, NOB, 0.5f, GAIN(1, 5), MODV(1, 2, 2), NOF, NOF, NOF, NOF, NOF, NOF);)
#ifdef PROBE_HI2
    }
#endif
#ifdef PROBE_STAMP_LO
#ifdef PROBE_ATTN_SEG
    if (blockIdx.x == 0 && threadIdx.x == 0) { const unsigned long long w = (unsigned long long)(*(LAS unsigned*)(ldsb + 151552 + 512)) / 8ull, te = __builtin_amdgcn_s_memrealtime();
#elif defined(PROBE_CLOCK)
    if (blockIdx.x == 0 && threadIdx.x == 0) { const unsigned long long w = ((pc1 - pc0) * 100ull / (pt1 - pt0)) * 50ull, te = __builtin_amdgcn_s_memrealtime();
#else
    if (blockIdx.x == 0 && threadIdx.x == 0) { const unsigned long long w = (pt1 - pt0) * (unsigned long long)PROBE_MULT, te = __builtin_amdgcn_s_memrealtime();
#endif
        while (__builtin_amdgcn_s_memrealtime() - te < w) __builtin_amdgcn_s_sleep(16); }
#endif
#ifdef PROBE_EXTRA_BARRIERS
    for (int eb = 0; eb < PROBE_EXTRA_BARRIERS; ++eb) GRID_BAR();
#endif
#undef IN
#undef SEAM
#undef GRID_BAR
}

extern "C" void kernel_launch(void* const* d_in, const int* in_sizes, int n_in, void* d_out, int out_size, void* d_ws, size_t ws_size, hipStream_t stream) {
    static int grid = 0;
    if (grid == 0) {
        if (n_in != 24 || in_sizes[0] != M * DM || out_size != M * DM || ws_size < WS_END) { fprintf(stderr, "kernel_launch: unexpected shapes (n_in %d, in0 %d, out %d, ws %zu)\n", n_in, n_in > 0 ? in_sizes[0] : -1, out_size, ws_size); grid = -1; return; }
        int dev = 0, cus = 0, per_cu = 0;
        if (hipGetDevice(&dev) != hipSuccess || hipDeviceGetAttribute(&cus, hipDeviceAttributeMultiprocessorCount, dev) != hipSuccess) { fprintf(stderr, "kernel_launch: device query failed\n"); grid = -1; return; }
        if (hipFuncSetAttribute((const void*)trunk_fwd, hipFuncAttributeMaxDynamicSharedMemorySize, LDS_BYTES) != hipSuccess) { fprintf(stderr, "kernel_launch: hipFuncSetAttribute failed\n"); grid = -1; return; }
        if (hipOccupancyMaxActiveBlocksPerMultiprocessor(&per_cu, (const void*)trunk_fwd, NWAVES * 64, LDS_BYTES) != hipSuccess || per_cu < 1) { fprintf(stderr, "kernel_launch: occupancy query reports %d workgroups per CU\n", per_cu); }
        (void)hipGetLastError();
        grid = cus;
    }
    if (grid < 0) return;
    if (hipMemsetAsync((char*)d_ws + WS_CTL, 0, CTL_ZERO_BYTES, stream) != hipSuccess) { fprintf(stderr, "kernel_launch: hipMemsetAsync failed\n"); return; }
    Args a{};
    for (int i = 0; i < 24; ++i) a.in[i] = (const float*)d_in[i];
    a.out = (float*)d_out; a.ws = (unsigned char*)d_ws;
#if MK_PER_PHASE
    for (int p = 0; p <= MK_STOP_AFTER; ++p) { a.ph_lo = p; a.ph_hi = p + 1; hipLaunchKernelGGL(trunk_fwd, dim3(grid), dim3(NWAVES * 64), LDS_BYTES, stream, a); }
#else
    a.ph_lo = 0; a.ph_hi = MK_STOP_AFTER + 1;
    hipLaunchKernelGGL(trunk_fwd, dim3(grid), dim3(NWAVES * 64), LDS_BYTES, stream, a);
#endif
    const hipError_t le = hipPeekAtLastError();
    if (le != hipSuccess) fprintf(stderr, "kernel_launch: launch failed: %s\n", hipGetErrorName(le));
}
```
